# Optimizing an MI355X kernel written in HIP

```python
import math
import jax, jax.numpy as jnp
from jax import lax
import numpy as np

D_MODEL = 1024
BATCH = 4
SEQ = 8192
DEPTH = 4
DEC_BATCH = 8
DEC_SEQ = 4096
PAST_LEN = 128

N_MIXERS = 3
ROPE_THETA = 500000.0
NORM_EPS = 1e-6

A_HEADS = 8
A_HEAD_DIM = D_MODEL // (2 * A_HEADS)
A_V_DIM = 2 * A_HEAD_DIM
A_QK_WIDTH = 2 * A_HEADS * A_HEAD_DIM
A_V_WIDTH = A_HEADS * A_V_DIM
A_Q_BLOCK = 128
A_LAYERS = (DEPTH + 2) // N_MIXERS

B_HEADS = 16
B_HEAD_DIM = D_MODEL // B_HEADS
B_PATTERNS = ((128, 1), (512, 4), (2048, 16))
B_GROUPS = len(B_PATTERNS)
B_LAYERS = (DEPTH + 1) // N_MIXERS

C_EXPAND = 128
C_HEADS = D_MODEL // C_EXPAND
C_KEY_DIM = C_EXPAND
C_VAL_DIM = D_MODEL // C_HEADS
C_WIDTH = C_HEADS * C_KEY_DIM
C_VWIDTH = C_HEADS * C_VAL_DIM
C_CHUNK = 64
C_LAYERS = DEPTH // N_MIXERS

D_FF = 2816
CONV_WIDTH = 3

kernel_name = 'hybrid_diffattn_dilated_hgrn2_encoder'


def rms_norm(x, g, eps=NORM_EPS):
    xf = x.astype(jnp.float32)
    y = xf * lax.rsqrt(jnp.mean(xf * xf, axis=-1, keepdims=True) + eps)
    return (y * g.astype(jnp.float32)).astype(x.dtype)


def rope_partial(x, pos):
    hd = x.shape[-1]
    rot = hd // 4
    half = rot // 2
    inv_freq = ROPE_THETA ** (-jnp.arange(half, dtype=jnp.float32) / half)
    ang = pos[:, None] * inv_freq[None, :]
    cos = jnp.cos(ang)[:, None, :]
    sin = jnp.sin(ang)[:, None, :]
    xf = x.astype(jnp.float32)
    x1, x2, rest = xf[..., :half], xf[..., half:rot], xf[..., rot:]
    out = jnp.concatenate([x1 * cos - x2 * sin, x2 * cos + x1 * sin, rest], axis=-1)
    return out.astype(x.dtype)


def diff_lambda_init(layer):
    return 0.8 - 0.6 * math.exp(-0.3 * layer)


def diff_attention(h, w_qkv, lam_vecs, subln_g, w_o, pos, lam_init):
    B, S, _ = h.shape
    q, k, v = jnp.split(h @ w_qkv, [A_QK_WIDTH, 2 * A_QK_WIDTH], axis=-1)
    q = rope_partial(q.reshape(B, S, 2 * A_HEADS, A_HEAD_DIM), pos)
    k = rope_partial(k.reshape(B, S, 2 * A_HEADS, A_HEAD_DIM), pos)
    q = q.reshape(B, S, A_HEADS, 2, A_HEAD_DIM).transpose(0, 2, 3, 1, 4) * (A_HEAD_DIM ** -0.5)
    k = k.reshape(B, S, A_HEADS, 2, A_HEAD_DIM).transpose(0, 2, 3, 1, 4)
    v = v.reshape(B, S, A_HEADS, A_V_DIM).transpose(0, 2, 1, 3)
    lf = lam_vecs.astype(jnp.float32)
    lam = jnp.exp(jnp.sum(lf[0] * lf[1])) - jnp.exp(jnp.sum(lf[2] * lf[3])) + lam_init
    n_blk = S // A_Q_BLOCK
    q_blocks = jnp.moveaxis(q.reshape(B, A_HEADS, 2, n_blk, A_Q_BLOCK, A_HEAD_DIM), 3, 0)

    def attend(qb):
        s = jnp.einsum('bhiqd,bhikd->bhiqk', qb, k).astype(jnp.float32)
        p = jax.nn.softmax(s, axis=-1)
        a = p[:, :, 0] - lam * p[:, :, 1]
        return jnp.einsum('bhqk,bhkv->bhqv', a.astype(v.dtype), v)

    o = lax.map(attend, q_blocks)
    o = jnp.moveaxis(o, 0, 2).reshape(B, A_HEADS, S, A_V_DIM)
    o = rms_norm(o, subln_g, 1e-5) * (1.0 - lam_init)
    o = o.transpose(0, 2, 1, 3).reshape(B, S, A_V_WIDTH)
    return o @ w_o


def dilated_band_attention(q, k, v, dilation, half_w):
    B, S, H, hd = q.shape
    L = S // dilation
    nb = -(-L // half_w)
    Lp = nb * half_w

    def to_residue(t):
        t = t.reshape(B, L, dilation, H, t.shape[-1]).transpose(0, 2, 3, 1, 4)
        return jnp.pad(t, ((0, 0), (0, 0), (0, 0), (0, Lp - L), (0, 0)))

    qb = to_residue(q).reshape(B, dilation, H, nb, half_w, hd)

    def band(t):
        tp = jnp.pad(t, ((0, 0), (0, 0), (0, 0), (half_w, half_w), (0, 0)))
        tp = tp.reshape(B, dilation, H, nb + 2, half_w, hd)
        return jnp.concatenate([tp[:, :, :, :-2], tp[:, :, :, 1:-1], tp[:, :, :, 2:]], axis=4)

    kb = band(to_residue(k))
    vb = band(to_residue(v))
    s = jnp.einsum('brhnqe,brhnke->brhnqk', qb, kb).astype(jnp.float32) * (hd ** -0.5)
    qi = jnp.arange(nb)[:, None] * half_w + jnp.arange(half_w)[None, :]
    ki = jnp.arange(nb)[:, None] * half_w - half_w + jnp.arange(3 * half_w)[None, :]
    valid = ((jnp.abs(qi[:, :, None] - ki[:, None, :]) <= half_w)
             & (ki[:, None, :] >= 0) & (ki[:, None, :] < L))
    s = jnp.where(valid, s, -jnp.inf)
    lse = jax.nn.logsumexp(s, axis=-1)
    p = jnp.exp(s - lse[..., None])
    o = jnp.einsum('brhnqk,brhnke->brhnqe', p.astype(v.dtype), vb)

    def from_residue(t):
        c = t.shape[-1]
        t = t.reshape(B, dilation, H, Lp, c)[:, :, :, :L]
        return t.transpose(0, 3, 1, 2, 4).reshape(B, S, H, c)

    return from_residue(o), from_residue(lse[..., None])[..., 0]


def dilated_mixture_attention(h, w_qkv, w_o, pos):
    B, S, _ = h.shape
    qkv = (h @ w_qkv).reshape(B, S, B_GROUPS, 3, B_HEADS, B_HEAD_DIM)
    outs, lses = [], []
    for g, (window, dilation) in enumerate(B_PATTERNS):
        q = rope_partial(qkv[:, :, g, 0], pos)
        k = rope_partial(qkv[:, :, g, 1], pos)
        o, lse = dilated_band_attention(q, k, qkv[:, :, g, 2], dilation, window // (2 * dilation))
        outs.append(o)
        lses.append(lse)
    wts = jax.nn.softmax(jnp.stack(lses, axis=0), axis=0)
    o = jnp.einsum('gbsh,gbshe->bshe', wts, jnp.stack(outs, axis=0).astype(jnp.float32))
    return o.reshape(B, S, B_HEADS * B_HEAD_DIM).astype(h.dtype) @ w_o


def hgrn_lower_bounds(lb_logits):
    p = jax.nn.softmax(lb_logits.astype(jnp.float32), axis=0)
    return jnp.cumsum(p, axis=0) - p[0]


def gla_chunk_scan(q, k, v, log_f):
    B, T, H, K = q.shape
    V = v.shape[-1]
    n = T // C_CHUNK

    def split(t):
        return t.reshape(B, n, C_CHUNK, H, t.shape[-1]).transpose(1, 0, 3, 2, 4)

    causal = jnp.tril(jnp.ones((C_CHUNK, C_CHUNK), dtype=bool))[:, :, None]

    def step(state, blk):
        qb, kb, vb, gb = blk
        G = jnp.cumsum(gb, axis=2)
        o_inter = jnp.einsum('bhtk,bhkv->bhtv', qb * jnp.exp(G), state)
        decay = jnp.exp(jnp.where(causal, G[:, :, :, None, :] - G[:, :, None, :, :], -jnp.inf))
        scores = jnp.einsum('bhtk,bhsk,bhtsk->bhts', qb, kb, decay)
        o_intra = jnp.einsum('bhts,bhsv->bhtv', scores, vb)
        G_end = G[:, :, -1]
        state = (jnp.exp(G_end)[..., None] * state
                 + jnp.einsum('bhsk,bhsv->bhkv', kb * jnp.exp(G_end[:, :, None] - G), vb))
        return state, o_inter + o_intra

    state0 = jnp.zeros((B, H, K, V), jnp.float32)
    _, o = lax.scan(step, state0, (split(q), split(k), split(v), split(log_f)))
    return o.transpose(1, 0, 3, 2, 4).reshape(B, T, H, V)


def hgrn2_bidirectional(h, w_in, lb, gnorm_g, w_o):
    B, S, _ = h.shape
    q, f_fw, f_bw, i, g = jnp.split(
        (h @ w_in).astype(jnp.float32),
        [C_WIDTH, 2 * C_WIDTH, 3 * C_WIDTH, 3 * C_WIDTH + C_VWIDTH], axis=-1)

    def heads(t, d):
        return t.reshape(B, S, C_HEADS, d)

    q = heads(jax.nn.silu(q), C_KEY_DIM) * (C_KEY_DIM ** -0.5)
    v = heads(i, C_VAL_DIM)
    log_lb = jnp.log(lb)
    log_1m_lb = jnp.log1p(-lb)

    def scan_dir(fz, reverse):
        log_f = heads(jnp.logaddexp(log_lb, log_1m_lb + jax.nn.log_sigmoid(fz)), C_KEY_DIM)
        k = -jnp.expm1(log_f)
        flip = (lambda t: t[:, ::-1]) if reverse else (lambda t: t)
        return flip(gla_chunk_scan(flip(q), flip(k), flip(v), flip(log_f)))

    o = scan_dir(f_fw, False) + scan_dir(f_bw, True)
    o = rms_norm(o, gnorm_g) * jax.nn.silu(heads(g, C_VAL_DIM))
    return o.reshape(B, S, C_VWIDTH).astype(h.dtype) @ w_o


def conv_glu_ffn(x, w_in, conv_w, conv_b, w_out):
    S = x.shape[1]
    u = x @ w_in
    pad = CONV_WIDTH // 2
    up = jnp.pad(u, ((0, 0), (pad, pad), (0, 0)))
    acc = conv_b
    for t in range(CONV_WIDTH):
        acc = acc + up[:, t:t + S] * conv_w[t]
    a, b = jnp.split(acc, 2, axis=-1)
    return (jax.nn.gelu(a, approximate=True) * b) @ w_out


def trunk(x, norm_g, a_w_qkv, a_lambda, a_subln_g, a_w_o, b_w_qkv, b_w_o,
          c_w_in, c_lb_logits, c_gnorm_g, c_w_o, f_w_in, f_conv_w, f_conv_b, f_w_out):
    S = x.shape[1]
    pos = jnp.arange(S, dtype=jnp.float32)
    lbs = hgrn_lower_bounds(c_lb_logits)
    for layer in range(DEPTH):
        kind = layer % N_MIXERS
        j = layer // N_MIXERS
        h = rms_norm(x, norm_g[layer, 0])
        if kind == 0:
            h = diff_attention(h, a_w_qkv[j], a_lambda[j], a_subln_g[j], a_w_o[j], pos,
                               diff_lambda_init(layer))
        elif kind == 1:
            h = dilated_mixture_attention(h, b_w_qkv[j], b_w_o[j], pos)
        else:
            h = hgrn2_bidirectional(h, c_w_in[j], lbs[layer], c_gnorm_g[j], c_w_o[j])
        x = x + rms_norm(h, norm_g[layer, 1])
        h = rms_norm(x, norm_g[layer, 2])
        h = conv_glu_ffn(h, f_w_in[layer], f_conv_w[layer], f_conv_b[layer], f_w_out[layer])
        x = x + rms_norm(h, norm_g[layer, 3])
    return x


def setup_inputs(seed: int = 0) -> dict:
    key = jax.random.key(seed)
    ks = jax.random.split(key, 17)

    def nrm(k, shape, scale):
        return jax.random.normal(k, shape, jnp.float32) * scale

    return {
        'x_prompt': nrm(ks[0], (BATCH, SEQ, D_MODEL), 1.0),
        'x_sample': nrm(ks[1], (DEC_BATCH, DEC_SEQ, D_MODEL), 1.0),
        'norm_g': 1.0 + nrm(ks[2], (DEPTH, 4, D_MODEL), 0.02),
        'a_w_qkv': nrm(ks[3], (A_LAYERS, D_MODEL, 2 * A_QK_WIDTH + A_V_WIDTH), D_MODEL ** -0.5),
        'a_lambda': nrm(ks[4], (A_LAYERS, 4, A_HEAD_DIM), 0.1),
        'a_subln_g': 1.0 + nrm(ks[5], (A_LAYERS, A_V_DIM), 0.02),
        'a_w_o': nrm(ks[6], (A_LAYERS, A_V_WIDTH, D_MODEL), A_V_WIDTH ** -0.5),
        'b_w_qkv': nrm(ks[7], (B_LAYERS, D_MODEL, B_GROUPS * 3 * B_HEADS * B_HEAD_DIM), D_MODEL ** -0.5),
        'b_w_o': nrm(ks[8], (B_LAYERS, B_HEADS * B_HEAD_DIM, D_MODEL), (B_HEADS * B_HEAD_DIM) ** -0.5),
        'c_w_in': nrm(ks[9], (C_LAYERS, D_MODEL, 3 * C_WIDTH + 2 * C_VWIDTH), D_MODEL ** -0.5),
        'c_lb_logits': nrm(ks[10], (DEPTH, C_WIDTH), 0.1),
        'c_gnorm_g': 1.0 + nrm(ks[11], (C_LAYERS, C_VAL_DIM), 0.02),
        'c_w_o': nrm(ks[12], (C_LAYERS, C_VWIDTH, D_MODEL), C_VWIDTH ** -0.5),
        'f_w_in': nrm(ks[13], (DEPTH, D_MODEL, 2 * D_FF), D_MODEL ** -0.5),
        'f_conv_w': nrm(ks[14], (DEPTH, CONV_WIDTH, 2 * D_FF), CONV_WIDTH ** -0.5),
        'f_conv_b': nrm(ks[15], (DEPTH, 2 * D_FF), 0.01),
        'f_w_out': nrm(ks[16], (DEPTH, D_FF, D_MODEL), D_FF ** -0.5),
    }


def reference(x_prompt, x_sample, norm_g, a_w_qkv, a_lambda, a_subln_g, a_w_o, b_w_qkv, b_w_o,
              c_w_in, c_lb_logits, c_gnorm_g, c_w_o, f_w_in, f_conv_w, f_conv_b, f_w_out):
    y_prompt = trunk(x_prompt, norm_g, a_w_qkv, a_lambda, a_subln_g, a_w_o, b_w_qkv, b_w_o,
                     c_w_in, c_lb_logits, c_gnorm_g, c_w_o, f_w_in, f_conv_w, f_conv_b, f_w_out)
    y_sample = trunk(x_sample, norm_g, a_w_qkv, a_lambda, a_subln_g, a_w_o, b_w_qkv, b_w_o,
                     c_w_in, c_lb_logits, c_gnorm_g, c_w_o, f_w_in, f_conv_w, f_conv_b, f_w_out)
    return (y_prompt, y_sample)
```

```cpp
#include <hip/hip_runtime.h>
#include <hip/hip_cooperative_groups.h>
#include <cstdio>
#include <cstdint>
#include <cmath>
namespace cg = cooperative_groups;
namespace pg8 {
#define PG8_LAS __attribute__((address_space(3)))
typedef unsigned short bf16_t;
typedef short bf16x8 __attribute__((ext_vector_type(8)));
typedef float f32x4 __attribute__((ext_vector_type(4)));
typedef unsigned u32x4 __attribute__((ext_vector_type(4)));
constexpr int BM = 256, BK = 64, HALF = 128, HTB = HALF * BK * 2  , STAGE_BYTES = 8 * HTB, NXCD = 8, WGM = 8;

__host__ __device__ __forceinline__ int lds_byte(int r, int c) { const int st = (r >> 4) * 2 + (c >> 5), rr = r & 15, cc = c & 31, ob = rr * 64 + cc * 2; return st * 1024 + (ob ^ (((ob >> 9) & 1) << 5)); }
__host__ __device__ __forceinline__ void stage_rc(int b, int& R, int& C) { const int st = b / 1024, sb = b % 1024, swz = sb ^ (((sb >> 9) & 1) << 5); R = (st >> 1) * 16 + swz / 64; C = (st & 1) * 32 + (swz % 64) / 2; }
__host__ __device__ __forceinline__ int perm32(int rho) { const int n = rho >> 4, i = rho & 15; return 8 * (i >> 2) + 4 * n + (i & 3); }

struct Unit { int pm, pn; };
struct Gemm { const bf16_t* A; const bf16_t* Bt; int M, N, K; };

struct StaticOrder {
    int nM, nN, nwg, G, c;
    __host__ __device__ void init(int M, int N, int G_, int c_) { nM = M / BM; nN = N / BM; nwg = nM * nN; G = G_; c = c_; }
    __host__ __device__ bool next(int i, Unit& u) const {
        const int L = i * G + c; if (L >= nwg) return false;
        int wgid = L; { const int q = nwg / NXCD, r = nwg % NXCD, xcd = wgid % NXCD, off = wgid / NXCD; wgid = (xcd < r ? xcd * (q + 1) : r * (q + 1) + (xcd - r) * q) + off; }
        const int nig = WGM * nN, gid = wgid / nig, fm = gid * WGM, gsz = (nM - fm) < WGM ? (nM - fm) : WGM;
        u.pm = fm + ((wgid % nig) % gsz); u.pn = (wgid % nig) / gsz; return true;
    }
    __device__ __forceinline__ void a_ready(const Unit&) const {}
    __device__ __forceinline__ void done(const Unit&) const {}
};

__device__ __forceinline__ unsigned cvt_pk_bf16(float lo, float hi) { unsigned r; asm volatile("v_cvt_pk_bf16_f32 %0, %1, %2" : "=v"(r) : "v"(lo), "v"(hi)); return r; }
typedef float f32x2 __attribute__((ext_vector_type(2)));
__device__ __forceinline__ f32x2 gelu_pk(f32x2 v) {
    const f32x2 av = __builtin_elementwise_abs(v), d = av * 0.2316418882f + 1.0f;
    f32x2 t; t.x = __builtin_amdgcn_rcpf(d.x); t.y = __builtin_amdgcn_rcpf(d.y);
    f32x2 q = t * 0.5307027145f + (-0.7265760135f); q = q * t + 0.7107068705f; q = q * t + (-0.142248368f); q = q * t + 0.127414796f; q = q * t;
    const f32x2 s = (v * v) * (-0.72134752044f);
    f32x2 e; e.x = __builtin_amdgcn_exp2f(s.x); e.y = __builtin_amdgcn_exp2f(s.y);
    const f32x2 m = v * (q * e), r = v - m;
    f32x2 o; o.x = v.x < 0.f ? m.x : r.x; o.y = v.y < 0.f ? m.y : r.y; return o;
}

template <int ACT  > struct EpiBf16 {
    static constexpr bool PERM = true, AFTER_DRAIN = false; static_assert(ACT == 0 || ACT == 1, "EpiBf16: ACT is 0 (none) or 1 (gelu_pk)");
    bf16_t* O; int ldc; const float* bias; int split_cols; size_t split_stride; float scale0;
    __device__ __forceinline__ void operator()(const f32x4 (&acc)[2][2][4][2], const Unit& u, int wr, int wc, int fr, int fq) const {
        const int row0 = u.pm * BM + wr * 64 + fr; int colt = u.pn * BM; bf16_t* base = O;
        float sc = 1.f; if (split_cols) { const int t = colt / split_cols; base += (size_t)t * split_stride; colt -= t * split_cols; if (t == 0) sc = scale0; }
        const int col0 = colt + wc * 32 + 8 * fq, bcol0 = u.pn * BM + wc * 32 + 8 * fq;
        f32x4 bv[2][2];
#pragma unroll
        for (int bj = 0; bj < 2; ++bj)
#pragma unroll
            for (int n = 0; n < 2; ++n) bv[bj][n] = bias ? *(const f32x4*)(bias + bcol0 + bj * HALF + 4 * n) : (f32x4){0.f, 0.f, 0.f, 0.f};
#pragma unroll
        for (int ai = 0; ai < 2; ++ai)
#pragma unroll
            for (int m = 0; m < 4; ++m) { bf16_t* rowp = base + (size_t)(row0 + ai * HALF + m * 16) * ldc + col0;
#pragma unroll
                for (int bj = 0; bj < 2; ++bj) { f32x4 v0 = acc[ai][bj][m][0] + bv[bj][0], v1 = acc[ai][bj][m][1] + bv[bj][1];
                    if (ACT == 1) { f32x2 a = gelu_pk((f32x2){v0[0], v0[1]}), b = gelu_pk((f32x2){v0[2], v0[3]}), c = gelu_pk((f32x2){v1[0], v1[1]}), d = gelu_pk((f32x2){v1[2], v1[3]});
                        v0 = (f32x4){a.x, a.y, b.x, b.y}; v1 = (f32x4){c.x, c.y, d.x, d.y}; }
                    v0 = v0 * sc; v1 = v1 * sc; u32x4 w; w.x = cvt_pk_bf16(v0[0], v0[1]); w.y = cvt_pk_bf16(v0[2], v0[3]); w.z = cvt_pk_bf16(v1[0], v1[1]); w.w = cvt_pk_bf16(v1[2], v1[3]);
                    *(u32x4*)(rowp + bj * HALF) = w; } }
    }
};


struct EpiAct {
    static constexpr bool PERM = true, AFTER_DRAIN = false;
    bf16_t* O; int ldc; int split_cols; size_t split_stride; int mode; const float* rope; int tok0; float qscale;
    __device__ __forceinline__ void operator()(const f32x4 (&acc)[2][2][4][2], const Unit& u, int wr, int wc, int fr, int fq) const {
        const int row0 = u.pm * BM + wr * 64 + fr; int colt = u.pn * BM; bf16_t* base = O; asm volatile("" : "+s"(base));
        const float* rope_ = rope; asm volatile("" : "+s"(rope_));
        int act = 0;
        if (mode == 1) { const int seg = colt % 3072; act = seg < 1024 ? 1 : (seg < 2048 ? 2 : 0); }
        else if (mode == 2) { act = colt < 1024 ? 3 : (colt < 3072 ? 4 : 0); }
        if (split_cols) { const int t = colt / split_cols; base += (size_t)t * split_stride; colt -= t * split_cols; }
        const int col0 = colt + wc * 32 + 8 * fq;
        const bool rope_wave = (act == 1 || act == 2) && ((wc & 1) == 0);
        const float sc = (act == 1) ? qscale : 1.f;
        const float sgn = (fq == 0) ? -1.f : 1.f; const bool rot = fq < 2;
#pragma unroll
        for (int ai = 0; ai < 2; ++ai)
#pragma unroll
            for (int m = 0; m < 4; ++m) {
                const int row = row0 + ai * HALF + m * 16; bf16_t* rowp = base + (size_t)row * ldc + col0;
                f32x4 c0 = {1.f, 1.f, 1.f, 1.f}, c1 = c0, s0 = {0.f, 0.f, 0.f, 0.f}, s1 = s0;
                if (rope_wave) { const int tok = tok0 + row; const int pos = (tok < 32768) ? (tok & 8191) : (tok & 4095); const float* cs = rope_ + (size_t)pos * 16;
                    c0 = *(const f32x4*)cs; c1 = *(const f32x4*)(cs + 4); s0 = *(const f32x4*)(cs + 8) * sgn; s1 = *(const f32x4*)(cs + 12) * sgn; }
#pragma unroll
                for (int bj = 0; bj < 2; ++bj) {
                    f32x4 v0 = acc[ai][bj][m][0], v1 = acc[ai][bj][m][1];
                    if (rope_wave) {
                        f32x4 p0, p1;
#pragma unroll
                        for (int e = 0; e < 4; ++e) { float a0 = v0[e], b0 = v0[e], a1 = v1[e], b1 = v1[e];
                            asm volatile("s_nop 1\n\tv_permlane16_swap_b32 %0, %1" : "+v"(a0), "+v"(b0));
                            asm volatile("s_nop 1\n\tv_permlane16_swap_b32 %0, %1" : "+v"(a1), "+v"(b1));
                            p0[e] = (fq & 1) ? a0 : b0; p1[e] = (fq & 1) ? a1 : b1; }
                        const f32x4 r0 = v0 * c0 + p0 * s0, r1 = v1 * c1 + p1 * s1;
                        if (rot) { v0 = r0; v1 = r1; }
                    }
                    if (act == 3) {
#pragma unroll
                        for (int e = 0; e < 4; ++e) { v0[e] = v0[e] * __builtin_amdgcn_rcpf(1.f + __builtin_amdgcn_exp2f(-1.4426950409f * v0[e])) * 0.08838834764831845f;
                                                       v1[e] = v1[e] * __builtin_amdgcn_rcpf(1.f + __builtin_amdgcn_exp2f(-1.4426950409f * v1[e])) * 0.08838834764831845f; }
                    } else if (act == 4) {
#pragma unroll
                        for (int e = 0; e < 4; ++e) { v0[e] = __builtin_amdgcn_rcpf(1.f + __builtin_amdgcn_exp2f(1.4426950409f * v0[e])); v1[e] = __builtin_amdgcn_rcpf(1.f + __builtin_amdgcn_exp2f(1.4426950409f * v1[e])); }
                    }
                    v0 = v0 * sc; v1 = v1 * sc;
                    u32x4 w; w.x = cvt_pk_bf16(v0[0], v0[1]); w.y = cvt_pk_bf16(v0[2], v0[3]); w.z = cvt_pk_bf16(v1[0], v1[1]); w.w = cvt_pk_bf16(v1[2], v1[3]);
                    *(u32x4*)(rowp + bj * HALF) = w;
                }
            }
    }
};

struct EpiConvGlu {
    static constexpr bool PERM = true, AFTER_DRAIN = false;
    bf16_t* G; const float* cw; const float* cb;
    __device__ __forceinline__ void operator()(f32x4 (&acc)[2][2][4][2], const Unit& u, int wr, int wc, int fr, int fq) const {
        const int chb = u.pn * 128 + wc * 32 + 8 * fq;
        bf16_t* G_ = G; const float* cw_ = cw; const float* cb_ = cb; asm volatile("" : "+s"(G_), "+s"(cw_), "+s"(cb_));
        f32x4 w0[2][2], w1[2][2], w2[2][2], bb[2][2];
#pragma unroll
        for (int bj = 0; bj < 2; ++bj)
#pragma unroll
            for (int n = 0; n < 2; ++n) { const int col = bj * 2816 + chb + 4 * n;
                w0[bj][n] = *(const f32x4*)(cw_ + col); w1[bj][n] = *(const f32x4*)(cw_ + 5632 + col); w2[bj][n] = *(const f32x4*)(cw_ + 2 * 5632 + col); bb[bj][n] = *(const f32x4*)(cb_ + col); }
#pragma unroll
        for (int ai = 0; ai < 2; ++ai) {
            const int tokb = 62 * (4 * u.pm + 2 * ai + wr) - 1 + 4 * fr;
            float pm_[4], nm_[4];
#pragma unroll
            for (int m = 0; m < 4; ++m) { const int t = tokb + m; const int msk = (t < 32768) ? 8191 : 4095; pm_[m] = ((t & msk) == 0) ? 0.f : 1.f; nm_[m] = ((t & msk) == msk) ? 0.f : 1.f; }
#pragma unroll
            for (int bj = 0; bj < 2; ++bj)
#pragma unroll
                for (int n = 0; n < 2; ++n) {
                    const f32x4 x0 = acc[ai][bj][0][n], x1 = acc[ai][bj][1][n], x2 = acc[ai][bj][2][n], x3 = acc[ai][bj][3][n];
                    f32x4 pv, nx;
#pragma unroll
                    for (int e = 0; e < 4; ++e) { float a_, b_;
                        asm volatile("s_nop 1\n\tv_mov_b32_dpp %0, %1 row_shr:1 row_mask:0xf bank_mask:0xf bound_ctrl:1" : "=&v"(a_) : "v"(x3[e]));
                        asm volatile("s_nop 1\n\tv_mov_b32_dpp %0, %1 row_shl:1 row_mask:0xf bank_mask:0xf bound_ctrl:1" : "=&v"(b_) : "v"(x0[e]));
                        pv[e] = a_; nx[e] = b_; }
                    acc[ai][bj][0][n] = bb[bj][n] + w0[bj][n] * (pv * pm_[0]) + w1[bj][n] * x0 + w2[bj][n] * (x1 * nm_[0]);
                    acc[ai][bj][1][n] = bb[bj][n] + w0[bj][n] * (x0 * pm_[1]) + w1[bj][n] * x1 + w2[bj][n] * (x2 * nm_[1]);
                    acc[ai][bj][2][n] = bb[bj][n] + w0[bj][n] * (x1 * pm_[2]) + w1[bj][n] * x2 + w2[bj][n] * (x3 * nm_[2]);
                    acc[ai][bj][3][n] = bb[bj][n] + w0[bj][n] * (x2 * pm_[3]) + w1[bj][n] * x3 + w2[bj][n] * (nx * nm_[3]);
                }
#pragma unroll
            for (int m = 0; m < 4; ++m) {
                const int pos = 4 * fr + m, t = tokb + m;
                unsigned wv[4];
#pragma unroll
                for (int n = 0; n < 2; ++n) { float o[4];
#pragma unroll
                    for (int e = 0; e < 4; ++e) { const float x = acc[ai][0][m][n][e]; const float z = -2.302208198f * (x + 0.044715f * x * x * x);
                        o[e] = x * __builtin_amdgcn_rcpf(1.f + __builtin_amdgcn_exp2f(z)) * acc[ai][1][m][n][e]; }
                    wv[2 * n] = cvt_pk_bf16(o[0], o[1]); wv[2 * n + 1] = cvt_pk_bf16(o[2], o[3]); }
                if (pos >= 1 && pos <= 62 && t < 65536) *(u32x4*)(G_ + (size_t)t * 2816 + chb) = (u32x4){wv[0], wv[1], wv[2], wv[3]};
            }
        }
    }
};
template <class Epi, class Sched, bool ALIGN_EPI = false, bool SP2 = false, bool APERM = false>
__device__ __forceinline__ void gemm_phase(PG8_LAS unsigned char* lds, const Gemm g, const Sched& S, const Epi& E) {
    int tid_l = threadIdx.x; asm volatile("" : "+v"(tid_l));
    const int tid = tid_l, wid = __builtin_amdgcn_readfirstlane(tid >> 6), lane = tid & 63, wr = wid >> 2, wc = wid & 3, fr = lane & 15, fq = lane >> 4;
    const int K = g.K, nt = K / BK;
    unsigned voffA[2], voffB[2];
#pragma unroll
    for (int i = 0; i < 2; ++i) { int R, C; stage_rc(tid * 16 + i * 8192, R, C); const int Rb = Epi::PERM ? ((R & ~31) + perm32(R & 31)) : R;
        const int Ra = APERM ? (62 * (R >> 6) + 4 * (R & 15) + ((R >> 4) & 3)) : R;
        voffA[i] = (unsigned)(Ra * K + C) * 2u; voffB[i] = (unsigned)(Rb * K + C) * 2u; }
    const size_t kstep = (size_t)(BK * 2);
    const size_t hstep = (size_t)HALF * K * 2;
    const size_t tstep = 2 * hstep;
    const size_t hstepA = APERM ? (size_t)124 * K * 2 : hstep, tstepA = 2 * hstepA;
    const unsigned ldsw = (unsigned)wid * 1024u;
    const int aoff = lds_byte(wr * 64 + fr, fq * 8), boff = lds_byte(wc * 32 + fr, fq * 8);
#define PG8_SA(b, h) (((b) * 2 + (h)) * HTB)
#define PG8_SB(b, h) ((4 + (b) * 2 + (h)) * HTB)
#define PG8_STAGE(bufoff, gbase, voff) do { _Pragma("unroll") for (int _i = 0; _i < 2; ++_i) \
        __builtin_amdgcn_global_load_lds((const unsigned*)((const char*)(gbase) + (voff)[_i]), (PG8_LAS unsigned*)(lds + (bufoff) + ldsw + _i * 8192), 16, 0, 0); } while (0)
#define PG8_LDA(dst, b, h) do { _Pragma("unroll") for (int m = 0; m < 4; ++m) _Pragma("unroll") for (int k = 0; k < 2; ++k) dst[m][k] = *(const PG8_LAS bf16x8*)(lds + PG8_SA(b, h) + aoff + m * 2048 + k * 1024); } while (0)
#define PG8_LDB(dst, b, h) do { _Pragma("unroll") for (int n = 0; n < 2; ++n) _Pragma("unroll") for (int k = 0; k < 2; ++k) dst[n][k] = *(const PG8_LAS bf16x8*)(lds + PG8_SB(b, h) + boff + n * 2048 + k * 1024); } while (0)
#define PG8_MMA(ai, bj, At, Bt) do { __builtin_amdgcn_s_setprio(1); _Pragma("unroll") for (int m = 0; m < 4; ++m) _Pragma("unroll") for (int n = 0; n < 2; ++n) _Pragma("unroll") for (int k = 0; k < 2; ++k) \
        acc[ai][bj][m][n] = __builtin_amdgcn_mfma_f32_16x16x32_bf16(Bt[n][k], At[m][k], acc[ai][bj][m][n], 0, 0, 0); __builtin_amdgcn_s_setprio(0); } while (0)
#define PG8_WAIT_V(n) asm volatile("s_waitcnt vmcnt(" #n ")" ::: "memory")
#define PG8_WAIT_L(n) asm volatile("s_waitcnt lgkmcnt(" #n ")" ::: "memory")
#define PG8_BAR __builtin_amdgcn_s_barrier()
#define PG8_SCHED __builtin_amdgcn_sched_barrier(0)
    Unit cur, nxt; int ui = 0;
    if (!S.next(0, cur)) return;
    f32x4 acc[2][2][4][2];
#pragma unroll
    for (int a = 0; a < 2; ++a)
#pragma unroll
        for (int b = 0; b < 2; ++b)
#pragma unroll
            for (int m = 0; m < 4; ++m)
#pragma unroll
                for (int n = 0; n < 2; ++n) acc[a][b][m][n] = (f32x4){0.f, 0.f, 0.f, 0.f};
    bf16x8 At[4][2], B0[2][2], B1[2][2];
    const char* cA = (const char*)g.A + (size_t)cur.pm * tstepA; const char* cB = (const char*)g.Bt + (size_t)cur.pn * tstep;
    S.a_ready(cur);
    if constexpr (SP2) {
        PG8_STAGE(PG8_SB(0, 0), cB, voffB); PG8_STAGE(PG8_SB(0, 1), cB + hstep, voffB); PG8_STAGE(PG8_SA(0, 0), cA, voffA); PG8_STAGE(PG8_SA(0, 1), cA + hstepA, voffA);
        if (wr == 1) PG8_BAR;
        PG8_WAIT_V(2); PG8_BAR;
        PG8_STAGE(PG8_SB(1, 0), cB + kstep, voffB); PG8_STAGE(PG8_SA(1, 0), cA + kstep, voffA); PG8_STAGE(PG8_SB(1, 1), cB + hstep + kstep, voffB);
        PG8_WAIT_V(6); PG8_BAR;
    } else {
        PG8_STAGE(PG8_SB(0, 0), cB, voffB); PG8_STAGE(PG8_SA(0, 0), cA, voffA); PG8_STAGE(PG8_SB(0, 1), cB + hstep, voffB); PG8_STAGE(PG8_SA(0, 1), cA + hstepA, voffA);
        if (wr == 1) PG8_BAR;
        PG8_WAIT_V(4); PG8_BAR;
        PG8_STAGE(PG8_SB(1, 0), cB + kstep, voffB); PG8_STAGE(PG8_SA(1, 0), cA + kstep, voffA); PG8_STAGE(PG8_SB(1, 1), cB + hstep + kstep, voffB);
        PG8_WAIT_V(6); PG8_BAR;
    }
    for (;;) {
        const bool has_next = S.next(ui + 1, nxt);
        const char* nA = has_next ? (const char*)g.A + (size_t)nxt.pm * tstepA : cA; const char* nB = has_next ? (const char*)g.Bt + (size_t)nxt.pn * tstep : cB;
        for (int t = 0; t < nt; t += 2) {
            const bool last = (t == nt - 2);
            const char* a1 = cA + (size_t)(t + 1) * kstep;
            const char* a2 = last ? nA : cA + (size_t)(t + 2) * kstep; const char* b2 = last ? nB : cB + (size_t)(t + 2) * kstep;
            const char* a3 = a2 + kstep; const char* b3 = b2 + kstep;
            if (last && has_next) S.a_ready(nxt);
            if constexpr (SP2) {
            PG8_LDB(B0, 0, 0); PG8_LDB(B1, 0, 1); PG8_SCHED; PG8_LDA(At, 0, 0); PG8_STAGE(PG8_SA(1, 1), a1 + hstepA, voffA);
            PG8_WAIT_V(8); PG8_WAIT_L(0); PG8_BAR; PG8_MMA(0, 0, At, B0); PG8_MMA(0, 1, At, B1); PG8_BAR; PG8_SCHED;
            PG8_LDA(At, 0, 1); PG8_STAGE(PG8_SB(0, 0), b2, voffB); PG8_STAGE(PG8_SB(0, 1), b2 + hstep, voffB); PG8_STAGE(PG8_SA(0, 0), a2, voffA);
            PG8_WAIT_V(8); PG8_WAIT_L(0); PG8_BAR; PG8_MMA(1, 0, At, B0); PG8_MMA(1, 1, At, B1); PG8_BAR; PG8_SCHED;
            PG8_LDB(B0, 1, 0); PG8_LDB(B1, 1, 1); PG8_SCHED; PG8_LDA(At, 1, 0); PG8_STAGE(PG8_SA(0, 1), a2 + hstepA, voffA);
            PG8_WAIT_V(8); PG8_WAIT_L(0); PG8_BAR; PG8_MMA(0, 0, At, B0); PG8_MMA(0, 1, At, B1); PG8_BAR; PG8_SCHED;
            PG8_LDA(At, 1, 1); PG8_STAGE(PG8_SB(1, 0), b3, voffB); PG8_STAGE(PG8_SB(1, 1), b3 + hstep, voffB); PG8_STAGE(PG8_SA(1, 0), a3, voffA);
            PG8_WAIT_V(8); PG8_WAIT_L(0); PG8_BAR; PG8_MMA(1, 0, At, B0); PG8_MMA(1, 1, At, B1); PG8_BAR; PG8_SCHED;
            } else {
            PG8_LDB(B0, 0, 0); PG8_SCHED; PG8_LDA(At, 0, 0); PG8_STAGE(PG8_SA(1, 1), a1 + hstepA, voffA);
            PG8_WAIT_L(8); PG8_BAR; PG8_WAIT_L(0); PG8_MMA(0, 0, At, B0); PG8_BAR; PG8_SCHED;
            PG8_LDB(B1, 0, 1); PG8_STAGE(PG8_SB(0, 0), b2, voffB);
            PG8_BAR; PG8_WAIT_L(0); PG8_MMA(0, 1, At, B1); PG8_BAR;
            PG8_LDA(At, 0, 1); PG8_STAGE(PG8_SA(0, 0), a2, voffA);
            PG8_BAR; PG8_WAIT_L(0); PG8_MMA(1, 0, At, B0); PG8_BAR; PG8_SCHED;
            PG8_STAGE(PG8_SB(0, 1), b2 + hstep, voffB);
            PG8_WAIT_V(6); PG8_BAR; PG8_MMA(1, 1, At, B1); PG8_BAR;
            PG8_LDB(B0, 1, 0); PG8_SCHED; PG8_LDA(At, 1, 0); PG8_STAGE(PG8_SA(0, 1), a2 + hstepA, voffA);
            PG8_WAIT_L(8); PG8_BAR; PG8_WAIT_L(0); PG8_MMA(0, 0, At, B0); PG8_BAR; PG8_SCHED;
            PG8_LDB(B1, 1, 1); PG8_STAGE(PG8_SB(1, 0), b3, voffB);
            PG8_BAR; PG8_WAIT_L(0); PG8_MMA(0, 1, At, B1); PG8_BAR;
            PG8_LDA(At, 1, 1); PG8_STAGE(PG8_SA(1, 0), a3, voffA);
            PG8_BAR; PG8_WAIT_L(0); PG8_MMA(1, 0, At, B0); PG8_BAR; PG8_SCHED;
            PG8_STAGE(PG8_SB(1, 1), b3 + hstep, voffB);
            PG8_WAIT_V(6); PG8_BAR; PG8_MMA(1, 1, At, B1); PG8_BAR;
            }
        }
        if constexpr (ALIGN_EPI) { if (wr == 0) PG8_BAR; }
        if constexpr (!Epi::AFTER_DRAIN) { E(acc, cur, wr, wc, fr, fq); S.done(cur); }
        if (!has_next) break;
#pragma unroll
        for (int a = 0; a < 2; ++a)
#pragma unroll
            for (int b = 0; b < 2; ++b)
#pragma unroll
                for (int m = 0; m < 4; ++m)
#pragma unroll
                    for (int n = 0; n < 2; ++n) acc[a][b][m][n] = (f32x4){0.f, 0.f, 0.f, 0.f};
        cur = nxt; cA = nA; cB = nB; ++ui;
        if constexpr (ALIGN_EPI) { if (wr == 1) PG8_BAR; }
    }
    PG8_WAIT_V(0);
    if constexpr (!ALIGN_EPI) { if (wr == 0) PG8_BAR; }
    PG8_BAR;
    if constexpr (Epi::AFTER_DRAIN) { E.fused(acc, cur, wr, wc, fr, fq, lds, wid, lane); S.done(cur); }
#undef PG8_SA
#undef PG8_SB
#undef PG8_STAGE
#undef PG8_LDA
#undef PG8_LDB
#undef PG8_MMA
#undef PG8_WAIT_V
#undef PG8_WAIT_L
#undef PG8_BAR
#undef PG8_SCHED
}
}

#define LAS __attribute__((address_space(3)))
typedef unsigned short bf16_t;
typedef short bf16x8 __attribute__((ext_vector_type(8)));
typedef short s16x4 __attribute__((ext_vector_type(4)));
typedef float f32x16 __attribute__((ext_vector_type(16)));
typedef float f32x4 __attribute__((ext_vector_type(4)));
typedef float f32x2 __attribute__((ext_vector_type(2)));
typedef unsigned u32x4 __attribute__((ext_vector_type(4)));
typedef unsigned u32x2 __attribute__((ext_vector_type(2)));
typedef __bf16 bf16x2_t __attribute__((ext_vector_type(2)));
typedef LAS unsigned char* ldsp;

constexpr int M_TOK = 65536, MH = 32768, DM = 1024, DFF = 2816;
constexpr float C2 = 0.125f * 1.4426950408889634f;
constexpr size_t MiB = 1u << 20;
constexpr size_t WS_ROPE = 0;
constexpr size_t WS_OML = 512 * 1024;
constexpr size_t WS_BAR = 768 * 1024;
constexpr size_t WS_W = 1 * MiB;
constexpr size_t WS_H = 117 * MiB;
constexpr size_t WS_Y = 245 * MiB;
constexpr size_t WS_BIG = 373 * MiB;
constexpr size_t WS_END = 1013 * MiB;
constexpr size_t WE_AQKV = 0, WE_AO = WE_AQKV + 2ull * 3072 * 1024, WE_BQKV = WE_AO + 2ull * 1024 * 1024, WE_BO = WE_BQKV + 9216ull * 1024,
                 WE_CIN = WE_BO + 1024ull * 1024, WE_CO = WE_CIN + 5120ull * 1024, WE_FIN = WE_CO + 1024ull * 1024, WE_FOUT = WE_FIN + 4ull * 5632 * 1024,
                 WE_END = WE_FOUT + 4ull * 2816 * 1024;
static_assert(WE_END * 2 <= 116 * MiB, "weights fit");

struct Params { const float* in[17]; float* out; unsigned char* ws; double invf[8]; int pad0, pad1; };

__device__ __forceinline__ float bflo(unsigned u) { return __uint_as_float(u << 16); }
__device__ __forceinline__ float bfhi(unsigned u) { return __uint_as_float(u & 0xffff0000u); }
__device__ __forceinline__ unsigned pkbf(float lo, float hi) { f32x2 v = {lo, hi}; bf16x2_t b = __builtin_convertvector(v, bf16x2_t); return __builtin_bit_cast(unsigned, b); }
__device__ __forceinline__ float dppf(float v, int ctrl_xor1) { return v; }
#define DPPF(v, ctrl) __builtin_bit_cast(float, __builtin_amdgcn_update_dpp(0, __builtin_bit_cast(int, (v)), (ctrl), 0xf, 0xf, false))
__device__ __forceinline__ float swap16_sum(float m) { auto rr = __builtin_amdgcn_permlane16_swap(__float_as_uint(m), __float_as_uint(m), false, false); return __uint_as_float(rr[0]) + __uint_as_float(rr[1]); }
__device__ __forceinline__ float swap32_sum(float m) { auto rr = __builtin_amdgcn_permlane32_swap(__float_as_uint(m), __float_as_uint(m), false, false); return __uint_as_float(rr[0]) + __uint_as_float(rr[1]); }
__device__ __forceinline__ float wave_sum(float v) {
  v += DPPF(v, 0xB1); v += DPPF(v, 0x4E); v += DPPF(v, 0x124); v += DPPF(v, 0x128);
  v = swap16_sum(v); v = swap32_sum(v);
  return v;
}
__device__ __forceinline__ int fresh_tid() { int t = threadIdx.x; asm volatile("" : "+v"(t)); return t; }
typedef const Params __attribute__((address_space(4)))* CParamsPtr;
__device__ __forceinline__ CParamsPtr kargs() { CParamsPtr kp = (CParamsPtr)__builtin_amdgcn_kernarg_segment_ptr(); asm volatile("" : "+s"(kp)); return kp; }
__device__ __forceinline__ float half_swap_max(float m) { auto rr = __builtin_amdgcn_permlane32_swap(__float_as_uint(m), __float_as_uint(m), false, false); return fmaxf(__uint_as_float(rr[0]), __uint_as_float(rr[1])); }
__device__ __forceinline__ float half_swap_sum(float m) { auto rr = __builtin_amdgcn_permlane32_swap(__float_as_uint(m), __float_as_uint(m), false, false); return __uint_as_float(rr[0]) + __uint_as_float(rr[1]); }

__device__ __forceinline__ void transpose_item(const float* W, int K, int N, bf16_t* WT, LAS float* scr, int item, int lane, bool glu) {
  const int nblk = N / 32, kb = item / nblk, nb = item % nblk, k0 = 64 * kb, n0 = 32 * nb;
#pragma unroll
  for (int i = 0; i < 8; ++i) { const int kk = 8 * i + (lane >> 3), nq = 4 * (lane & 7); const f32x4 v = *(const f32x4*)(W + (size_t)(k0 + kk) * N + n0 + nq);
    scr[kk * 33 + nq] = v.x; scr[kk * 33 + nq + 1] = v.y; scr[kk * 33 + nq + 2] = v.z; scr[kk * 33 + nq + 3] = v.w; }
  asm volatile("s_waitcnt lgkmcnt(0)" ::: "memory");
  const int c = lane & 7;
#pragma unroll
  for (int j = 0; j < 4; ++j) { const int n = (lane >> 3) + 8 * j; const LAS float* s = scr + (8 * c) * 33 + n;
    u32x4 o; o.x = pkbf(s[0 * 33], s[1 * 33]); o.y = pkbf(s[2 * 33], s[3 * 33]); o.z = pkbf(s[4 * 33], s[5 * 33]); o.w = pkbf(s[6 * 33], s[7 * 33]);
    int nr = n0 + n; if (glu) { const int bj = nr >= 2816 ? 1 : 0, cc = nr - 2816 * bj; nr = 256 * (cc >> 7) + 128 * bj + (cc & 127); }
    *(u32x4*)(WT + (size_t)nr * K + k0 + 8 * c) = o; }
  asm volatile("s_waitcnt lgkmcnt(0)" ::: "memory");
}
__device__ __forceinline__ void transpose_mat(const float* W, int K, int N, bf16_t* WT, LAS float* scr, int gw, int ngw, int lane, bool glu) {
  const int items = (K / 64) * (N / 32);
  for (int it = gw; it < items; it += ngw) transpose_item(W, K, N, WT, scr, it, lane, glu);
}

__device__ __forceinline__ float row_rstd(const f32x4 (&v)[4], float eps) {
  float s = 0.f;
#pragma unroll
  for (int j = 0; j < 4; ++j) s += (v[j].x * v[j].x + v[j].y * v[j].y) + (v[j].z * v[j].z + v[j].w * v[j].w);
  return rsqrtf(wave_sum(s) * (1.f / 1024.f) + eps);
}
__device__ __forceinline__ void store_h_row(bf16_t* hrow, const f32x4 (&v)[4], float rstd, const float* g, int lane) {
#pragma unroll
  for (int j = 0; j < 4; ++j) { const f32x4 gg = *(const f32x4*)(g + 4 * lane + 256 * j);
    u32x2 w; w.x = pkbf(v[j].x * rstd * gg.x, v[j].y * rstd * gg.y); w.y = pkbf(v[j].z * rstd * gg.z, v[j].w * rstd * gg.w);
    *(u32x2*)(hrow + 4 * lane + 256 * j) = w; }
}
__device__ __forceinline__ void phase_init_norm(const float* xp, const float* xs, float* x, bf16_t* H, const float* g, int gw, int ngw, int lane) {
  for (int m = gw; m < M_TOK; m += ngw) {
    const float* src = (m < MH) ? xp + (size_t)m * DM : xs + (size_t)(m - MH) * DM;
    f32x4 v[4];
#pragma unroll
    for (int j = 0; j < 4; ++j) v[j] = *(const f32x4*)(src + 4 * lane + 256 * j);
    store_h_row(H + (size_t)m * DM, v, row_rstd(v, 1e-6f), g, lane);
  }
}
__device__ __forceinline__ void phase_res_norm(const bf16_t* Y, float* x, bf16_t* H, const float* gA, const float* gB, int gw, int ngw, int lane, const float* xp, const float* xs) {
  for (int m = gw; m < M_TOK; m += ngw) {
    bf16_t* xb = (bf16_t*)((char*)x + (size_t)m * 4096 + 2048);
    f32x4 y[4], v[4];
#pragma unroll
    for (int j = 0; j < 4; ++j) { const u32x2 w = *(const u32x2*)(Y + (size_t)m * DM + 4 * lane + 256 * j); y[j] = (f32x4){bflo(w.x), bfhi(w.x), bflo(w.y), bfhi(w.y)}; }
    if (xp) { const float* xsrc = (m < MH) ? xp + (size_t)m * DM : xs + (size_t)(m - MH) * DM;
#pragma unroll
      for (int j = 0; j < 4; ++j) v[j] = *(const f32x4*)(xsrc + 4 * lane + 256 * j);
    } else {
#pragma unroll
      for (int j = 0; j < 4; ++j) { const u32x2 w = *(const u32x2*)(xb + 4 * lane + 256 * j); v[j] = (f32x4){bflo(w.x), bfhi(w.x), bflo(w.y), bfhi(w.y)}; }
    }
    const float ry = row_rstd(y, 1e-6f);
#pragma unroll
    for (int j = 0; j < 4; ++j) { const f32x4 gg = *(const f32x4*)(gA + 4 * lane + 256 * j); v[j] = v[j] + y[j] * ry * gg; }
    if (gB) {
#pragma unroll
      for (int j = 0; j < 4; ++j) { u32x2 w; w.x = pkbf(v[j].x, v[j].y); w.y = pkbf(v[j].z, v[j].w); *(u32x2*)(xb + 4 * lane + 256 * j) = w; }
      store_h_row(H + (size_t)m * DM, v, row_rstd(v, 1e-6f), gB, lane);
    } else {
#pragma unroll
      for (int j = 0; j < 4; ++j) *(f32x4*)(x + (size_t)m * DM + 4 * lane + 256 * j) = v[j];
    }
  }
}

__device__ __forceinline__ void rope_seg(bf16_t* pp, int pos, float sc, const float* rope, int lane) {
  u32x4 a = *(const u32x4*)pp, b = *(const u32x4*)(pp + 8);
  float x1[8] = {bflo(a.x), bfhi(a.x), bflo(a.y), bfhi(a.y), bflo(a.z), bfhi(a.z), bflo(a.w), bfhi(a.w)};
  float x2[8] = {bflo(b.x), bfhi(b.x), bflo(b.y), bfhi(b.y), bflo(b.z), bfhi(b.z), bflo(b.w), bfhi(b.w)};
  if ((lane & 3) == 0) { const float* cs = rope + (size_t)pos * 16;
#pragma unroll
    for (int i = 0; i < 8; ++i) { const float c = cs[i], s = cs[8 + i]; const float u = x1[i] * c - x2[i] * s, w = x2[i] * c + x1[i] * s; x1[i] = u; x2[i] = w; } }
  a.x = pkbf(x1[0] * sc, x1[1] * sc); a.y = pkbf(x1[2] * sc, x1[3] * sc); a.z = pkbf(x1[4] * sc, x1[5] * sc); a.w = pkbf(x1[6] * sc, x1[7] * sc);
  b.x = pkbf(x2[0] * sc, x2[1] * sc); b.y = pkbf(x2[2] * sc, x2[3] * sc); b.z = pkbf(x2[4] * sc, x2[5] * sc); b.w = pkbf(x2[6] * sc, x2[7] * sc);
  *(u32x4*)pp = a; *(u32x4*)(pp + 8) = b;
}

__device__ __forceinline__ s16x4 vtr(ldsp p) { typedef short v4i16_t __attribute__((ext_vector_type(4))); return __builtin_bit_cast(s16x4, __builtin_amdgcn_ds_read_tr16_b64_v4i16((LAS v4i16_t*)p)); }
__device__ __forceinline__ int voffa(int row, int ch) { return 2048 * (row >> 3) + 512 * (ch >> 2) + 64 * (row & 7) + 16 * ((ch & 3) ^ ((row >> 2) & 3)); }
__device__ __forceinline__ int koff(int row, int ch) { return 128 * row + ((ch ^ ((row >> 1) & 7)) << 4); }
__device__ __forceinline__ f32x16 qk_block(ldsp Kt, const int (&ko)[4], const bf16x8 (&qf)[4]) {
  f32x16 acc = {0.f, 0.f, 0.f, 0.f, 0.f, 0.f, 0.f, 0.f, 0.f, 0.f, 0.f, 0.f, 0.f, 0.f, 0.f, 0.f};
#pragma unroll
  for (int ds = 0; ds < 4; ++ds) { const bf16x8 kf = *(const LAS bf16x8*)(Kt + ko[ds]); acc = __builtin_amdgcn_mfma_f32_32x32x16_bf16(kf, qf[ds], acc, 0, 0, 0); }
  return acc;
}
__device__ __forceinline__ void k_load(bf16x8 (&kf)[4], ldsp Kt, const int (&ko)[4]) {
#pragma unroll
  for (int ds = 0; ds < 4; ++ds) kf[ds] = *(const LAS bf16x8*)(Kt + ko[ds]);
}
__device__ __forceinline__ f32x16 qk_frag(const bf16x8 (&kf)[4], const bf16x8 (&qf)[4]) {
  f32x16 acc = {0.f, 0.f, 0.f, 0.f, 0.f, 0.f, 0.f, 0.f, 0.f, 0.f, 0.f, 0.f, 0.f, 0.f, 0.f, 0.f};
#pragma unroll
  for (int ds = 0; ds < 4; ++ds) acc = __builtin_amdgcn_mfma_f32_32x32x16_bf16(kf[ds], qf[ds], acc, 0, 0, 0);
  return acc;
}
constexpr float BIGSUM = 1.0995116e12f;
template <int NDB> __device__ __forceinline__ void softmax_block(f32x16& s, float& m, float& l, f32x16 (&o)[NDB], bf16x8 (&p)[2]) {
  if (__all(m == 0.f)) {
#pragma unroll
    for (int r = 0; r < 16; ++r) s[r] = __builtin_amdgcn_exp2f(s[r]);
  } else {
#pragma unroll
    for (int r = 0; r < 16; ++r) s[r] = __builtin_amdgcn_exp2f(s[r] - m);
  }
  float sum = 0.f;
#pragma unroll
  for (int r = 0; r < 16; ++r) sum += s[r];
  const float tot = half_swap_sum(sum);
  if (__any(!(tot <= BIGSUM))) {
    float mx = s[0];
#pragma unroll
    for (int r = 1; r < 16; ++r) mx = fmaxf(mx, s[r]);
    mx = half_swap_max(mx);
    const float dl = (tot <= BIGSUM) ? 0.f : __log2f(fminf(mx, 3.0e38f)); m += dl;
    const float f = __builtin_amdgcn_exp2f(-dl); l *= f; sum *= f;
#pragma unroll
    for (int r = 0; r < 16; ++r) s[r] *= f;
#pragma unroll
    for (int d = 0; d < NDB; ++d)
#pragma unroll
      for (int r = 0; r < 16; ++r) o[d][r] *= f;
  }
  l += sum;
  u32x4 w0, w1;
  w0.x = pkbf(s[0], s[1]); w0.y = pkbf(s[2], s[3]); w0.z = pkbf(s[4], s[5]); w0.w = pkbf(s[6], s[7]);
  w1.x = pkbf(s[8], s[9]); w1.y = pkbf(s[10], s[11]); w1.z = pkbf(s[12], s[13]); w1.w = pkbf(s[14], s[15]);
  p[0] = __builtin_bit_cast(bf16x8, w0); p[1] = __builtin_bit_cast(bf16x8, w1);
}
template <int DV, bool TWO> __device__ __forceinline__ void pv_block(ldsp Vt, int vb0, int vb1, const bf16x8 (&p0)[2], const bf16x8 (&p1)[2], f32x16 (&o0)[DV / 32], f32x16 (&o1)[DV / 32]) {
  constexpr int NDB = DV / 32, NST = 2 * NDB;
#define PV_I0(i) ((DV == 128) ? 2048 * (2 * ((i) / NDB)) + 512 * ((i) % NDB) : 128 * (16 * ((i) / NDB)) + 64 * ((i) % NDB))
#define PV_I1(i) ((DV == 128) ? 2048 * (2 * ((i) / NDB) + 1) + 512 * ((i) % NDB) : 128 * (16 * ((i) / NDB) + 8) + 64 * ((i) % NDB))
#define PV_RD(dl, dh, i) do { asm volatile("ds_read_b64_tr_b16 %0, %1 offset:%c2" : "=&v"(dl) : "v"(a0), "i"(PV_I0(i)) : "memory"); \
                              asm volatile("ds_read_b64_tr_b16 %0, %1 offset:%c2" : "=&v"(dh) : "v"(a1), "i"(PV_I1(i)) : "memory"); } while (0)
  const unsigned a0 = (unsigned)(unsigned long)(Vt + vb0), a1 = (unsigned)(unsigned long)(Vt + vb1);
  s16x4 lo[2], hh[2];
  PV_RD(lo[0], hh[0], 0);
#pragma unroll
  for (int i = 0; i < NST; ++i) {
    if (i + 1 < NST) { PV_RD(lo[(i + 1) & 1], hh[(i + 1) & 1], i + 1); asm volatile("s_waitcnt lgkmcnt(2)" ::: "memory"); }
    else asm volatile("s_waitcnt lgkmcnt(0)" ::: "memory");
    __builtin_amdgcn_sched_barrier(0);
    const s16x4 l_ = lo[i & 1], h_ = hh[i & 1];
    const bf16x8 a = {l_[0], l_[1], l_[2], l_[3], h_[0], h_[1], h_[2], h_[3]};
    const int s = i / NDB, db = i % NDB;
    o0[db] = __builtin_amdgcn_mfma_f32_32x32x16_bf16(a, p0[s], o0[db], 0, 0, 0);
    if (TWO) o1[db] = __builtin_amdgcn_mfma_f32_32x32x16_bf16(a, p1[s], o1[db], 0, 0, 0);
    __builtin_amdgcn_sched_barrier(0);
  }
#undef PV_I0
#undef PV_I1
#undef PV_RD
}

__device__ __forceinline__ void sm_pv(f32x16& s, float& m, float& l, f32x16 (&oself)[4], bf16x8 (&pout)[2], ldsp Vt, int vb0, int vb1, const bf16x8 (&pin)[2], f32x16 (&oacc)[4]) {
  if (!__all(m == 0.f)) {
#pragma unroll
    for (int r = 0; r < 16; ++r) s[r] -= m;
  }
#define SP_I0(i) (2048 * (2 * ((i) / 4)) + 512 * ((i) % 4))
#define SP_I1(i) (2048 * (2 * ((i) / 4) + 1) + 512 * ((i) % 4))
#define SP_RD(dl, dh, i) do { asm volatile("ds_read_b64_tr_b16 %0, %1 offset:%c2" : "=&v"(dl) : "v"(a0), "i"(SP_I0(i)) : "memory"); \
                              asm volatile("ds_read_b64_tr_b16 %0, %1 offset:%c2" : "=&v"(dh) : "v"(a1), "i"(SP_I1(i)) : "memory"); } while (0)
  const unsigned a0 = (unsigned)(unsigned long)(Vt + vb0), a1 = (unsigned)(unsigned long)(Vt + vb1);
  s16x4 lo[2], hh[2];
  SP_RD(lo[0], hh[0], 0);
#pragma unroll
  for (int i = 0; i < 8; ++i) {
    if (i + 1 < 8) { SP_RD(lo[(i + 1) & 1], hh[(i + 1) & 1], i + 1); asm volatile("s_waitcnt lgkmcnt(2)" ::: "memory"); }
    else asm volatile("s_waitcnt lgkmcnt(0)" ::: "memory");
    __builtin_amdgcn_sched_barrier(0);
    const s16x4 l_ = lo[i & 1], h_ = hh[i & 1];
    const bf16x8 a = {l_[0], l_[1], l_[2], l_[3], h_[0], h_[1], h_[2], h_[3]};
    oacc[i % 4] = __builtin_amdgcn_mfma_f32_32x32x16_bf16(a, pin[i / 4], oacc[i % 4], 0, 0, 0);
    s[2 * i] = __builtin_amdgcn_exp2f(s[2 * i]); s[2 * i + 1] = __builtin_amdgcn_exp2f(s[2 * i + 1]);
    __builtin_amdgcn_sched_barrier(0);
  }
#undef SP_I0
#undef SP_I1
#undef SP_RD
  float sum = 0.f;
#pragma unroll
  for (int r = 0; r < 16; ++r) sum += s[r];
  const float tot = half_swap_sum(sum);
  if (__any(!(tot <= BIGSUM))) {
    float mx = s[0];
#pragma unroll
    for (int r = 1; r < 16; ++r) mx = fmaxf(mx, s[r]);
    mx = half_swap_max(mx);
    const float dl = (tot <= BIGSUM) ? 0.f : __log2f(fminf(mx, 3.0e38f)); m += dl;
    const float f = __builtin_amdgcn_exp2f(-dl); l *= f; sum *= f;
#pragma unroll
    for (int r = 0; r < 16; ++r) s[r] *= f;
#pragma unroll
    for (int d = 0; d < 4; ++d)
#pragma unroll
      for (int r = 0; r < 16; ++r) oself[d][r] *= f;
  }
  l += sum;
  u32x4 w0, w1;
  w0.x = pkbf(s[0], s[1]); w0.y = pkbf(s[2], s[3]); w0.z = pkbf(s[4], s[5]); w0.w = pkbf(s[6], s[7]);
  w1.x = pkbf(s[8], s[9]); w1.y = pkbf(s[10], s[11]); w1.z = pkbf(s[12], s[13]); w1.w = pkbf(s[14], s[15]);
  pout[0] = __builtin_bit_cast(bf16x8, w0); pout[1] = __builtin_bit_cast(bf16x8, w1);
}

__device__ __forceinline__ void sm_finish(f32x16& s, float& m, float& l, f32x16 (&oself)[4], bf16x8 (&pout)[2]) {
  float sum = 0.f;
#pragma unroll
  for (int r = 0; r < 16; ++r) sum += s[r];
  const float tot = half_swap_sum(sum);
  if (__any(!(tot <= BIGSUM))) {
    float mx = s[0];
#pragma unroll
    for (int r = 1; r < 16; ++r) mx = fmaxf(mx, s[r]);
    mx = half_swap_max(mx);
    const float dl = (tot <= BIGSUM) ? 0.f : __log2f(fminf(mx, 3.0e38f)); m += dl;
    const float f = __builtin_amdgcn_exp2f(-dl); l *= f; sum *= f;
#pragma unroll
    for (int r = 0; r < 16; ++r) s[r] *= f;
#pragma unroll
    for (int d = 0; d < 4; ++d)
#pragma unroll
      for (int r = 0; r < 16; ++r) oself[d][r] *= f;
  }
  l += sum;
  u32x4 w0, w1;
  w0.x = pkbf(s[0], s[1]); w0.y = pkbf(s[2], s[3]); w0.z = pkbf(s[4], s[5]); w0.w = pkbf(s[6], s[7]);
  w1.x = pkbf(s[8], s[9]); w1.y = pkbf(s[10], s[11]); w1.z = pkbf(s[12], s[13]); w1.w = pkbf(s[14], s[15]);
  pout[0] = __builtin_bit_cast(bf16x8, w0); pout[1] = __builtin_bit_cast(bf16x8, w1);
}
__device__ __forceinline__ void pv2_sm2(f32x16& s0, f32x16& s1, float m0, float m1, ldsp Vt, int vb0, int vb1, const bf16x8 (&p0)[2], const bf16x8 (&p1)[2], f32x16 (&o0)[4], f32x16 (&o1)[4]) {
  if (!__all((m0 == 0.f) && (m1 == 0.f))) {
#pragma unroll
    for (int r = 0; r < 16; ++r) { s0[r] -= m0; s1[r] -= m1; }
  }
#define SP_I0(i) (2048 * (2 * ((i) / 4)) + 512 * ((i) % 4))
#define SP_I1(i) (2048 * (2 * ((i) / 4) + 1) + 512 * ((i) % 4))
#define SP_RD(dl, dh, i) do { asm volatile("ds_read_b64_tr_b16 %0, %1 offset:%c2" : "=&v"(dl) : "v"(a0), "i"(SP_I0(i)) : "memory"); \
                              asm volatile("ds_read_b64_tr_b16 %0, %1 offset:%c2" : "=&v"(dh) : "v"(a1), "i"(SP_I1(i)) : "memory"); } while (0)
  const unsigned a0 = (unsigned)(unsigned long)(Vt + vb0), a1 = (unsigned)(unsigned long)(Vt + vb1);
  s16x4 lo[2], hh[2];
  SP_RD(lo[0], hh[0], 0);
#pragma unroll
  for (int i = 0; i < 8; ++i) {
    if (i + 1 < 8) { SP_RD(lo[(i + 1) & 1], hh[(i + 1) & 1], i + 1); asm volatile("s_waitcnt lgkmcnt(2)" ::: "memory"); }
    else asm volatile("s_waitcnt lgkmcnt(0)" ::: "memory");
    __builtin_amdgcn_sched_barrier(0);
    const s16x4 l_ = lo[i & 1], h_ = hh[i & 1];
    const bf16x8 a = {l_[0], l_[1], l_[2], l_[3], h_[0], h_[1], h_[2], h_[3]};
    o0[i % 4] = __builtin_amdgcn_mfma_f32_32x32x16_bf16(a, p0[i / 4], o0[i % 4], 0, 0, 0);
    s0[2 * i] = __builtin_amdgcn_exp2f(s0[2 * i]); s0[2 * i + 1] = __builtin_amdgcn_exp2f(s0[2 * i + 1]);
    __builtin_amdgcn_sched_barrier(0);
    o1[i % 4] = __builtin_amdgcn_mfma_f32_32x32x16_bf16(a, p1[i / 4], o1[i % 4], 0, 0, 0);
    s1[2 * i] = __builtin_amdgcn_exp2f(s1[2 * i]); s1[2 * i + 1] = __builtin_amdgcn_exp2f(s1[2 * i + 1]);
    __builtin_amdgcn_sched_barrier(0);
  }
#undef SP_I0
#undef SP_I1
#undef SP_RD
}

__device__ __forceinline__ void pv2_sm2p(f32x16& s0, f32x16& s1, float& m0, float& l0, float& m1, float& l1, ldsp Vt, int vb0, int vb1,
                                         const bf16x8 (&p0)[2], const bf16x8 (&p1)[2], f32x16 (&o0)[4], f32x16 (&o1)[4], bf16x8 (&q0)[2], bf16x8 (&q1)[2]) {
  if (!__all((m0 == 0.f) && (m1 == 0.f))) {
#pragma unroll
    for (int r = 0; r < 16; ++r) { s0[r] -= m0; s1[r] -= m1; }
  }
#define SP_I0(i) (2048 * (2 * ((i) / 4)) + 512 * ((i) % 4))
#define SP_I1(i) (2048 * (2 * ((i) / 4) + 1) + 512 * ((i) % 4))
#define SP_RD(dl, dh, i) do { asm volatile("ds_read_b64_tr_b16 %0, %1 offset:%c2" : "=&v"(dl) : "v"(a0), "i"(SP_I0(i)) : "memory"); \
                              asm volatile("ds_read_b64_tr_b16 %0, %1 offset:%c2" : "=&v"(dh) : "v"(a1), "i"(SP_I1(i)) : "memory"); } while (0)
  const unsigned a0 = (unsigned)(unsigned long)(Vt + vb0), a1 = (unsigned)(unsigned long)(Vt + vb1);
  s16x4 lo[2], hh[2];
  unsigned w0[8], w1[8];
  float sum0 = 0.f, sum1 = 0.f;
  SP_RD(lo[0], hh[0], 0);
#pragma unroll
  for (int i = 0; i < 8; ++i) {
    if (i + 1 < 8) { SP_RD(lo[(i + 1) & 1], hh[(i + 1) & 1], i + 1); asm volatile("s_waitcnt lgkmcnt(2)" ::: "memory"); }
    else asm volatile("s_waitcnt lgkmcnt(0)" ::: "memory");
    __builtin_amdgcn_sched_barrier(0);
    const s16x4 l_ = lo[i & 1], h_ = hh[i & 1];
    const bf16x8 a = {l_[0], l_[1], l_[2], l_[3], h_[0], h_[1], h_[2], h_[3]};
    o0[i % 4] = __builtin_amdgcn_mfma_f32_32x32x16_bf16(a, p0[i / 4], o0[i % 4], 0, 0, 0);
    { const float e0 = __builtin_amdgcn_exp2f(s0[2 * i]), e1 = __builtin_amdgcn_exp2f(s0[2 * i + 1]); sum0 += e0; sum0 += e1; w0[i] = pkbf(e0, e1); }
    __builtin_amdgcn_sched_barrier(0);
    o1[i % 4] = __builtin_amdgcn_mfma_f32_32x32x16_bf16(a, p1[i / 4], o1[i % 4], 0, 0, 0);
    { const float e0 = __builtin_amdgcn_exp2f(s1[2 * i]), e1 = __builtin_amdgcn_exp2f(s1[2 * i + 1]); sum1 += e0; sum1 += e1; w1[i] = pkbf(e0, e1); }
    __builtin_amdgcn_sched_barrier(0);
  }
#undef SP_I0
#undef SP_I1
#undef SP_RD
  const float tot0 = half_swap_sum(sum0), tot1 = half_swap_sum(sum1);
  if (__any(!(tot0 <= BIGSUM) || !(tot1 <= BIGSUM))) {
    float mx0 = 0.f, mx1 = 0.f;
#pragma unroll
    for (int i = 0; i < 8; ++i) { mx0 = fmaxf(mx0, fmaxf(bflo(w0[i]), bfhi(w0[i]))); mx1 = fmaxf(mx1, fmaxf(bflo(w1[i]), bfhi(w1[i]))); }
    mx0 = half_swap_max(mx0); mx1 = half_swap_max(mx1);
    const float d0 = (tot0 <= BIGSUM) ? 0.f : __log2f(fminf(mx0, 3.0e38f)), d1 = (tot1 <= BIGSUM) ? 0.f : __log2f(fminf(mx1, 3.0e38f));
    m0 += d0; m1 += d1;
    const float f0 = __builtin_amdgcn_exp2f(-d0), f1 = __builtin_amdgcn_exp2f(-d1); l0 *= f0; l1 *= f1; sum0 *= f0; sum1 *= f1;
#pragma unroll
    for (int i = 0; i < 8; ++i) { w0[i] = pkbf(bflo(w0[i]) * f0, bfhi(w0[i]) * f0); w1[i] = pkbf(bflo(w1[i]) * f1, bfhi(w1[i]) * f1); }
#pragma unroll
    for (int d = 0; d < 4; ++d)
#pragma unroll
      for (int r = 0; r < 16; ++r) { o0[d][r] *= f0; o1[d][r] *= f1; }
  }
  l0 += sum0; l1 += sum1;
  q0[0] = __builtin_bit_cast(bf16x8, (u32x4){w0[0], w0[1], w0[2], w0[3]}); q0[1] = __builtin_bit_cast(bf16x8, (u32x4){w0[4], w0[5], w0[6], w0[7]});
  q1[0] = __builtin_bit_cast(bf16x8, (u32x4){w1[0], w1[1], w1[2], w1[3]}); q1[1] = __builtin_bit_cast(bf16x8, (u32x4){w1[4], w1[5], w1[6], w1[7]});
}

__device__ __forceinline__ void diff_unit(ldsp lds, const bf16_t* Q, const bf16_t* K, const bf16_t* V, bf16_t* O, int tok0, int S, int h, int qb, float lam, float osc, const float* subg) {
  const int tid = fresh_tid(), lane = tid & 63, wid = tid >> 6, r32 = lane & 31, hi = lane >> 5;
  const int NT = S / 64;
  const bf16_t* kbase = K + (size_t)tok0 * DM + 128 * h; const bf16_t* vbase = V + (size_t)tok0 * DM + 128 * h;
#define DIFF_DMA(t, bo) do { const int ln_ = fresh_tid() & 63, wv_ = __builtin_amdgcn_readfirstlane(fresh_tid() >> 6); \
    { const int row_ = 8 * wv_ + (ln_ >> 3), ch_ = (ln_ & 7) ^ ((row_ >> 1) & 7); const bf16_t* g_ = kbase + (size_t)((t) * 64 + row_) * DM + 8 * ch_; \
      __builtin_amdgcn_global_load_lds((const unsigned*)g_, (LAS unsigned*)(lds + (bo) + 1024 * wv_), 16, 0, 0); \
      __builtin_amdgcn_global_load_lds((const unsigned*)(g_ + 64), (LAS unsigned*)(lds + (bo) + 8192 + 1024 * wv_), 16, 0, 0); } \
    _Pragma("unroll") for (int hq_ = 0; hq_ < 2; ++hq_) { const int o_ = 1024 * hq_ + 16 * ln_, row_ = 8 * wv_ + ((o_ >> 6) & 7), ch_ = 4 * (o_ >> 9) + (((o_ >> 4) & 3) ^ ((row_ >> 2) & 3)); \
      __builtin_amdgcn_global_load_lds((const unsigned*)(vbase + (size_t)((t) * 64 + row_) * DM + 8 * ch_), (LAS unsigned*)(lds + (bo) + 16384 + 2048 * wv_ + 1024 * hq_), 16, 0, 0); } } while (0)
  DIFF_DMA(0, 0);
  const size_t qrow = (size_t)(tok0 + 256 * qb + 32 * wid + r32) * DM;
  bf16x8 q0[4], q1[4];
#pragma unroll
  for (int ds = 0; ds < 4; ++ds) { q0[ds] = *(const bf16x8*)(Q + qrow + (2 * h) * 64 + 16 * ds + 8 * hi); q1[ds] = *(const bf16x8*)(Q + qrow + (2 * h + 1) * 64 + 16 * ds + 8 * hi); }
  f32x16 o0[4], o1[4];
#pragma unroll
  for (int d = 0; d < 4; ++d)
#pragma unroll
    for (int r = 0; r < 16; ++r) { o0[d][r] = 0.f; o1[d][r] = 0.f; }
  float m0 = 0.f, l0 = 0.f, m1 = 0.f, l1 = 0.f;
  int ko[4];
#pragma unroll
  for (int ds = 0; ds < 4; ++ds) ko[ds] = 128 * r32 + (((2 * ds + hi) ^ ((r32 >> 1) & 7)) << 4);
  const int q4 = (lane & 15) >> 2, p4 = lane & 3, gi = (lane >> 4) & 1;
  int vb0 = 64 * (4 * hi + q4) + 16 * ((2 * gi + (p4 >> 1)) ^ hi) + 8 * (p4 & 1);
  int vb1 = 64 * (4 * hi + q4) + 16 * ((2 * gi + (p4 >> 1)) ^ (2 + hi)) + 8 * (p4 & 1);
  __syncthreads();
  bf16x8 pa[2], pb[2];
  pb[0] = (bf16x8){0, 0, 0, 0, 0, 0, 0, 0}; pb[1] = pb[0]; pa[0] = pb[0]; pa[1] = pb[0];
  int bcur = 0, bnext = 32768;
  ldsp prevV = lds + 16384;
#pragma unroll 1
  for (int t = 0; t < NT; ++t) {
    asm volatile("" : "+v"(ko[0]), "+v"(ko[1]), "+v"(ko[2]), "+v"(ko[3]), "+v"(vb0), "+v"(vb1));
    if (t + 1 < NT) DIFF_DMA(t + 1, bnext);
    ldsp base = lds + bcur;
    {
      f32x16 sc0 = qk_block(base, ko, q0);
      __builtin_amdgcn_sched_barrier(0);
      f32x16 sc1 = qk_block(base + 8192, ko, q1);
      __builtin_amdgcn_sched_barrier(0);
      bf16x8 pc[2], pd[2];
      pv2_sm2p(sc0, sc1, m0, l0, m1, l1, prevV, vb0, vb1, pa, pb, o0, o1, pc, pd);
      sc0 = qk_block(base + 4096, ko, q0);
      __builtin_amdgcn_sched_barrier(0);
      sc1 = qk_block(base + 8192 + 4096, ko, q1);
      __builtin_amdgcn_sched_barrier(0);
      pv2_sm2p(sc0, sc1, m0, l0, m1, l1, base + 16384, vb0, vb1, pc, pd, o0, o1, pa, pb);
      prevV = base + 16384 + 8192;
    }
    __syncthreads();
    bcur = bnext; bnext = (bnext == 65536) ? 0 : bnext + 32768;
  }
  pv_block<128, true>(prevV, vb0, vb1, pa, pb, o0, o1);
  __syncthreads();
#undef DIFF_DMA
  l0 = half_swap_sum(l0); l1 = half_swap_sum(l1);
  const float i0 = 1.f / l0, i1 = lam / l1;
  float ssq = 0.f;
#pragma unroll
  for (int d = 0; d < 4; ++d)
#pragma unroll
    for (int r = 0; r < 16; ++r) { const float v = o0[d][r] * i0 - o1[d][r] * i1; o0[d][r] = v; ssq += v * v; }
  ssq = half_swap_sum(ssq);
  const float rs = rsqrtf(ssq * (1.f / 128.f) + 1e-5f) * osc;
  bf16_t* orow = O + (size_t)(tok0 + 256 * qb + 32 * (fresh_tid() >> 6) + (fresh_tid() & 31)) * DM + 128 * h;
#pragma unroll
  for (int d = 0; d < 4; ++d)
#pragma unroll
    for (int g4 = 0; g4 < 4; ++g4) { const int dd = 32 * d + 8 * g4 + 4 * hi; const f32x4 gg = *(const f32x4*)(subg + dd);
      u32x2 w; w.x = pkbf(o0[d][4 * g4] * rs * gg.x, o0[d][4 * g4 + 1] * rs * gg.y); w.y = pkbf(o0[d][4 * g4 + 2] * rs * gg.z, o0[d][4 * g4 + 3] * rs * gg.w);
      *(u32x2*)(orow + dd) = w; }
}
__device__ __forceinline__ void phase_diff_attn(ldsp lds, const bf16_t* Q, const bf16_t* K, const bf16_t* V, bf16_t* O, const float* lamv, const float* subg, float lam_init, float osc_l) {
  const int lane = fresh_tid() & 63;
  const float t0 = wave_sum(lamv[lane] * lamv[64 + lane]), t1 = wave_sum(lamv[128 + lane] * lamv[192 + lane]);
  const float lam = __expf(t0) - __expf(t1) + lam_init;
  const int G = gridDim.x, bx = blockIdx.x;
  const bool xmap = (G == 256); const int x = bx & 7, c = bx >> 3;
  const int nu = xmap ? 8 : (2048 - bx + G - 1) / G;
#pragma unroll 1
  for (int i = 0; i < nu; ++i) {
    int bh, qb, S, tok0;
    if (xmap) { if (i < 4) { bh = 4 * x + i; qb = c; S = 8192; tok0 = (bh >> 3) * 8192; } else { bh = 8 * x + 2 * (i - 4) + (c >> 4); qb = c & 15; S = 4096; tok0 = MH + (bh >> 3) * 4096; } }
    else { const int u = bx + i * G; if (u < 1024) { bh = u >> 5; qb = u & 31; S = 8192; tok0 = (bh >> 3) * 8192; } else { const int v = u - 1024; bh = v >> 4; qb = v & 15; S = 4096; tok0 = MH + (bh >> 3) * 4096; } }
    diff_unit(lds, Q, K, V, O, tok0, S, bh & 7, qb, lam, osc_l, subg);
  }
}

__device__ __forceinline__ void dil_unit(ldsp lds, bf16_t* QKV, float* LSE, int half, int u) {
  const int tid = fresh_tid(), lane = tid & 63, wid = tid >> 6, r32 = lane & 31, hi = lane >> 5;
  const int g = u / 2048, rem = u % 2048, head = rem & 15, blk = rem >> 4;
  const int S = half ? 4096 : 8192, nbs = S / 256, seq = blk / nbs, wi = blk % nbs;
  const int dsh = 2 * g, dil = 1 << dsh, L = S >> dsh, nq = L / 256, r = wi / nq, qb = wi % nq, m0 = 256 * qb;
  const int seqrow = seq * S;
  const int colq = g * 3072 + head * 64, colk = colq + 1024, colv = colq + 2048;
  ldsp Kt = lds, Vt = lds + 49152;
#pragma unroll
  for (int i = 0; i < 6; ++i) { const int idx = tid + 512 * i, j = idx >> 3, ch = idx & 7, mk = m0 - 64 + j;
    u32x4 kv = {0u, 0u, 0u, 0u}, vv = {0u, 0u, 0u, 0u};
    if (mk >= 0 && mk < L) { const size_t rowo = (size_t)(seqrow + mk * dil + r) * 9216; kv = *(const u32x4*)(QKV + rowo + colk + 8 * ch); vv = *(const u32x4*)(QKV + rowo + colv + 8 * ch); }
    *(LAS u32x4*)(Kt + koff(j, ch)) = kv; *(LAS u32x4*)(Vt + 128 * j + 16 * ch) = vv; }
  const int mq = m0 + 32 * wid + r32; const size_t qrowo = (size_t)(seqrow + mq * dil + r) * 9216 + colq;
  bf16x8 qf[4];
#pragma unroll
  for (int ds = 0; ds < 4; ++ds) qf[ds] = *(const bf16x8*)(QKV + qrowo + 16 * ds + 8 * hi);
  f32x16 o[2];
#pragma unroll
  for (int d = 0; d < 2; ++d)
#pragma unroll
    for (int rr = 0; rr < 16; ++rr) o[d][rr] = 0.f;
  float m = 0.f, l = 0.f;
  int ko[4];
#pragma unroll
  for (int ds = 0; ds < 4; ++ds) ko[ds] = 128 * r32 + (((2 * ds + hi) ^ ((r32 >> 1) & 7)) << 4);
  const int q4 = (lane & 15) >> 2, p4 = lane & 3, gi = (lane >> 4) & 1;
  const int vb = 128 * (4 * hi + q4) + 32 * gi + 8 * p4;
  __syncthreads();
#pragma unroll 1
  for (int b = 0; b < 5; ++b) {
    const int kr0 = 32 * wid + 32 * b;
    f32x16 s = qk_block(Kt + 128 * kr0, ko, qf);
#pragma unroll
    for (int rr = 0; rr < 16; ++rr) { const int kvr = (rr & 3) + 8 * (rr >> 2) + 4 * hi; const int mk = m0 - 64 + kr0 + kvr; const int dlt = mk - mq;
      const bool ok = (dlt >= -64) && (dlt <= 64) && (mk >= 0) && (mk < L); s[rr] = ok ? s[rr] : -INFINITY; }
    bf16x8 p[2];
    softmax_block<2>(s, m, l, o, p);
    pv_block<64, false>(Vt + 128 * kr0, vb, vb, p, p, o, o);
  }
  l = half_swap_sum(l);
  const float il = 1.f / l;
  bf16_t* orow = QKV + qrowo;
#pragma unroll
  for (int d = 0; d < 2; ++d)
#pragma unroll
    for (int g4 = 0; g4 < 4; ++g4) { const int dd = 32 * d + 8 * g4 + 4 * hi;
      u32x2 w; w.x = pkbf(o[d][4 * g4] * il, o[d][4 * g4 + 1] * il); w.y = pkbf(o[d][4 * g4 + 2] * il, o[d][4 * g4 + 3] * il);
      *(u32x2*)(orow + dd) = w; }
  if (hi == 0) LSE[((size_t)g * MH + (seqrow + mq * dil + r)) * 16 + head] = m + __log2f(l);
  __syncthreads();
}
__device__ __forceinline__ void phase_dil_combine(const bf16_t* QKV, const float* LSE, bf16_t* O  , int gw, int ngw, int lane) {
  for (int t = gw; t < MH; t += ngw) {
    const int head = lane >> 2, d0 = 16 * (lane & 3);
    float ls[3], mx = -INFINITY;
#pragma unroll
    for (int g = 0; g < 3; ++g) { ls[g] = LSE[((size_t)g * MH + t) * 16 + head]; mx = fmaxf(mx, ls[g]); }
    float w[3], ws = 0.f;
#pragma unroll
    for (int g = 0; g < 3; ++g) { w[g] = __builtin_amdgcn_exp2f(ls[g] - mx); ws += w[g]; }
    const float iw = 1.f / ws; float acc[16];
#pragma unroll
    for (int i = 0; i < 16; ++i) acc[i] = 0.f;
#pragma unroll
    for (int g = 0; g < 3; ++g) { const bf16_t* p = QKV + (size_t)t * 9216 + g * 3072 + head * 64 + d0; const u32x4 a = *(const u32x4*)p, b = *(const u32x4*)(p + 8); const float wg = w[g] * iw;
      acc[0] += wg * bflo(a.x); acc[1] += wg * bfhi(a.x); acc[2] += wg * bflo(a.y); acc[3] += wg * bfhi(a.y); acc[4] += wg * bflo(a.z); acc[5] += wg * bfhi(a.z); acc[6] += wg * bflo(a.w); acc[7] += wg * bfhi(a.w);
      acc[8] += wg * bflo(b.x); acc[9] += wg * bfhi(b.x); acc[10] += wg * bflo(b.y); acc[11] += wg * bfhi(b.y); acc[12] += wg * bflo(b.z); acc[13] += wg * bfhi(b.z); acc[14] += wg * bflo(b.w); acc[15] += wg * bfhi(b.w); }
    u32x4 a, b; a.x = pkbf(acc[0], acc[1]); a.y = pkbf(acc[2], acc[3]); a.z = pkbf(acc[4], acc[5]); a.w = pkbf(acc[6], acc[7]);
    b.x = pkbf(acc[8], acc[9]); b.y = pkbf(acc[10], acc[11]); b.z = pkbf(acc[12], acc[13]); b.w = pkbf(acc[14], acc[15]);
    bf16_t* op = O + (size_t)t * DM + head * 64 + d0; *(u32x4*)op = a; *(u32x4*)(op + 8) = b;
  }
}

__device__ __forceinline__ void phase_hgrn_gates(bf16_t* QF, int gt, int ngt) {
  const size_t total = (size_t)M_TOK * 384;
  for (size_t it = gt; it < total; it += ngt) {
    const int row = (int)(it / 384), c8 = (int)(it % 384); bf16_t* p = QF + (size_t)row * 5120 + 8 * c8; const bool isq = c8 < 128;
    u32x4 a = *(const u32x4*)p; float v[8] = {bflo(a.x), bfhi(a.x), bflo(a.y), bfhi(a.y), bflo(a.z), bfhi(a.z), bflo(a.w), bfhi(a.w)};
#pragma unroll
    for (int i = 0; i < 8; ++i) { const float z = v[i]; v[i] = isq ? z / (1.f + __expf(-z)) * 0.08838834764831845f : 1.f / (1.f + __expf(z)); }
    a.x = pkbf(v[0], v[1]); a.y = pkbf(v[2], v[3]); a.z = pkbf(v[4], v[5]); a.w = pkbf(v[6], v[7]); *(u32x4*)p = a;
  }
}
__device__ __forceinline__ int rowimg(int row, int ch) { return 256 * row + ((ch ^ (row & 15)) << 4); }
__device__ __forceinline__ void hgrn_chain(ldsp lds, const bf16_t* QF, bf16_t* Ofw, bf16_t* Obw, const float* oml, int c) {
  const int tid = fresh_tid(), lane = tid & 63, wid = tid >> 6, r32 = lane & 31, hi = lane >> 5;
  const int dir = c & 1, head = (c >> 1) & 7, sq = c >> 4;
  const int T = (sq < 4) ? 8192 : 4096, NC = T / 64; const int seqrow = (sq < 4) ? sq * 8192 : MH + (sq - 4) * 4096;
  bf16_t* Od = dir ? Obw : Ofw;
  constexpr int RAWQ = 0, RAWS = 16384, IMG_V = 32768, IMG_QT = 49152, IMG_KT = 65536, IMG_KH = 81920, OUTB = 98304, TOT = 114688, DEC = 118784;
  const int vblk = wid & 3, tblk = wid >> 2;
  const int kp = tid & 63, e8 = tid >> 6;
  const float om0 = oml[head * 128 + 2 * kp], om1 = oml[head * 128 + 2 * kp + 1];
  f32x16 Sacc[4];
#pragma unroll
  for (int kb = 0; kb < 4; ++kb)
#pragma unroll
    for (int r = 0; r < 16; ++r) Sacc[kb][r] = 0.f;
  const int lrow = tid >> 4, c16 = tid & 15;
  const int qcol = head * 128 + 8 * c16, fcol = 1024 + dir * 1024 + head * 128 + 8 * c16, vcol = 3072 + head * 128 + 8 * c16;
  u32x4 pq0, pq1, ps0, ps1, pv0, pv1;
#define HG_LOAD(n) do { const int t0_ = dir ? T - 64 * ((n) + 1) : 64 * (n); const int ra_ = dir ? 63 - lrow : lrow, rb_ = dir ? 31 - lrow : lrow + 32; \
    const bf16_t* pa_ = QF + (size_t)(seqrow + t0_ + ra_) * 5120; const bf16_t* pb_ = QF + (size_t)(seqrow + t0_ + rb_) * 5120; \
    pq0 = *(const u32x4*)(pa_ + qcol); pq1 = *(const u32x4*)(pb_ + qcol); ps0 = *(const u32x4*)(pa_ + fcol); ps1 = *(const u32x4*)(pb_ + fcol); pv0 = *(const u32x4*)(pa_ + vcol); pv1 = *(const u32x4*)(pb_ + vcol); } while (0)
#define HG_STORE() do { *(LAS u32x4*)(lds + RAWQ + 256 * lrow + 16 * c16) = pq0; *(LAS u32x4*)(lds + RAWQ + 256 * (lrow + 32) + 16 * c16) = pq1; \
    *(LAS u32x4*)(lds + RAWS + 256 * lrow + 16 * c16) = ps0; *(LAS u32x4*)(lds + RAWS + 256 * (lrow + 32) + 16 * c16) = ps1; \
    *(LAS u32x4*)(lds + IMG_V + voffa(lrow, c16)) = pv0; *(LAS u32x4*)(lds + IMG_V + voffa(lrow + 32, c16)) = pv1; } while (0)
  const int q4 = (lane & 15) >> 2, p4 = lane & 3, gi = (lane >> 4) & 1;
  const int vbp0 = 64 * (4 * hi + q4) + 16 * ((2 * gi + (p4 >> 1)) ^ hi) + 8 * (p4 & 1), vbp1 = 64 * (4 * hi + q4) + 16 * ((2 * gi + (p4 >> 1)) ^ (2 + hi)) + 8 * (p4 & 1);
  const int nb0 = 2048 * hi + 64 * q4 + 16 * ((2 * gi + (p4 >> 1)) ^ (2 * hi)) + 8 * (p4 & 1), nb1 = 2048 * hi + 64 * q4 + 16 * ((2 * gi + (p4 >> 1)) ^ (2 * hi + 1)) + 8 * (p4 & 1);
  HG_LOAD(0); HG_STORE(); __syncthreads();
#pragma unroll 1
  for (int n = 0; n < NC; ++n) {
    if (n + 1 < NC) HG_LOAD(n + 1);
    float kk0[8], kk1[8], g0[8], g1[8]; float c0 = 0.f, c1 = 0.f;
#pragma unroll
    for (int i = 0; i < 8; ++i) { const int row = 8 * e8 + i; const unsigned sw = *(const LAS unsigned*)(lds + RAWS + 256 * row + 4 * kp);
      kk0[i] = om0 * bflo(sw); kk1[i] = om1 * bfhi(sw); c0 += __log2f(1.f - kk0[i]); c1 += __log2f(1.f - kk1[i]); g0[i] = c0; g1[i] = c1; }
    *(LAS f32x2*)(lds + TOT + (e8 * 128 + 2 * kp) * 4) = (f32x2){c0, c1};
    __syncthreads();
    float off0 = 0.f, off1 = 0.f, ge0 = 0.f, ge1 = 0.f;
#pragma unroll
    for (int e = 0; e < 8; ++e) { const f32x2 t = *(const LAS f32x2*)(lds + TOT + (e * 128 + 2 * kp) * 4); ge0 += t.x; ge1 += t.y; if (e < e8) { off0 += t.x; off1 += t.y; } }
#pragma unroll
    for (int i = 0; i < 8; ++i) { const int row = 8 * e8 + i; const float G0 = off0 + g0[i], G1 = off1 + g1[i];
      const unsigned qw = *(const LAS unsigned*)(lds + RAWQ + 256 * row + 4 * kp);
      const float eq0 = __builtin_amdgcn_exp2f(G0), eq1 = __builtin_amdgcn_exp2f(G1), ek0 = __builtin_amdgcn_exp2f(-G0), ek1 = __builtin_amdgcn_exp2f(-G1);
      const float eh0 = __builtin_amdgcn_exp2f(ge0 - G0), eh1 = __builtin_amdgcn_exp2f(ge1 - G1);
      const int ro = rowimg(row, kp >> 2) + 4 * (kp & 3);
      *(LAS unsigned*)(lds + IMG_QT + ro) = pkbf(bflo(qw) * eq0, bfhi(qw) * eq1);
      *(LAS unsigned*)(lds + IMG_KT + ro) = pkbf(kk0[i] * ek0, kk1[i] * ek1);
      *(LAS unsigned*)(lds + IMG_KH + voffa(row, kp >> 2) + 4 * (kp & 3)) = pkbf(kk0[i] * eh0, kk1[i] * eh1); }
    if (e8 == 7) *(LAS f32x2*)(lds + DEC + 8 * kp) = (f32x2){__builtin_amdgcn_exp2f(ge0), __builtin_amdgcn_exp2f(ge1)};
    __syncthreads();
    bf16x8 px[2][2];
#pragma unroll
    for (int sb = 0; sb < 2; ++sb) {
      if (sb <= tblk) {
        f32x16 X;
#pragma unroll
        for (int r = 0; r < 16; ++r) X[r] = 0.f;
#pragma unroll
        for (int ds = 0; ds < 8; ++ds) { const bf16x8 a = *(const LAS bf16x8*)(lds + IMG_KT + rowimg(32 * sb + r32, 2 * ds + hi)), bq = *(const LAS bf16x8*)(lds + IMG_QT + rowimg(32 * tblk + r32, 2 * ds + hi));
          X = __builtin_amdgcn_mfma_f32_32x32x16_bf16(a, bq, X, 0, 0, 0); }
        if (sb == tblk) {
#pragma unroll
          for (int r = 0; r < 16; ++r) { const int sl = (r & 3) + 8 * (r >> 2) + 4 * hi; X[r] = (sl <= r32) ? X[r] : 0.f; } }
        u32x4 w0, w1;
        w0.x = pkbf(X[0], X[1]); w0.y = pkbf(X[2], X[3]); w0.z = pkbf(X[4], X[5]); w0.w = pkbf(X[6], X[7]);
        w1.x = pkbf(X[8], X[9]); w1.y = pkbf(X[10], X[11]); w1.z = pkbf(X[12], X[13]); w1.w = pkbf(X[14], X[15]);
        px[sb][0] = __builtin_bit_cast(bf16x8, w0); px[sb][1] = __builtin_bit_cast(bf16x8, w1);
      } else { px[sb][0] = (bf16x8){0, 0, 0, 0, 0, 0, 0, 0}; px[sb][1] = px[sb][0]; }
    }
    f32x16 acc;
#pragma unroll
    for (int r = 0; r < 16; ++r) acc[r] = 0.f;
#pragma unroll
    for (int sb = 0; sb < 2; ++sb)
#pragma unroll
      for (int s2 = 0; s2 < 2; ++s2) {
        const s16x4 lo = vtr(lds + IMG_V + vbp0 + 2048 * (4 * sb + 2 * s2) + 512 * vblk), hh = vtr(lds + IMG_V + vbp1 + 2048 * (4 * sb + 2 * s2 + 1) + 512 * vblk);
        const bf16x8 a = {lo[0], lo[1], lo[2], lo[3], hh[0], hh[1], hh[2], hh[3]};
        acc = __builtin_amdgcn_mfma_f32_32x32x16_bf16(a, px[sb][s2], acc, 0, 0, 0);
      }
#pragma unroll
    for (int kb = 0; kb < 4; ++kb)
#pragma unroll
      for (int s2 = 0; s2 < 2; ++s2) {
        u32x4 w; w.x = pkbf(Sacc[kb][8 * s2 + 0], Sacc[kb][8 * s2 + 1]); w.y = pkbf(Sacc[kb][8 * s2 + 2], Sacc[kb][8 * s2 + 3]); w.z = pkbf(Sacc[kb][8 * s2 + 4], Sacc[kb][8 * s2 + 5]); w.w = pkbf(Sacc[kb][8 * s2 + 6], Sacc[kb][8 * s2 + 7]);
        const u32x2 b0 = *(const LAS u32x2*)(lds + IMG_QT + rowimg(32 * tblk + r32, 4 * kb + 2 * s2) + 8 * hi), b1 = *(const LAS u32x2*)(lds + IMG_QT + rowimg(32 * tblk + r32, 4 * kb + 2 * s2 + 1) + 8 * hi);
        const u32x4 bw = {b0.x, b0.y, b1.x, b1.y};
        acc = __builtin_amdgcn_mfma_f32_32x32x16_bf16(__builtin_bit_cast(bf16x8, w), __builtin_bit_cast(bf16x8, bw), acc, 0, 0, 0);
      }
#pragma unroll
    for (int g4 = 0; g4 < 4; ++g4) { u32x2 w; w.x = pkbf(acc[4 * g4], acc[4 * g4 + 1]); w.y = pkbf(acc[4 * g4 + 2], acc[4 * g4 + 3]);
      *(LAS u32x2*)(lds + OUTB + rowimg(32 * tblk + r32, 4 * vblk + g4) + 8 * hi) = w; }
#pragma unroll
    for (int kb = 0; kb < 4; ++kb) {
#pragma unroll
      for (int g4 = 0; g4 < 4; ++g4) { const f32x4 d = *(const LAS f32x4*)(lds + DEC + 4 * (32 * kb + 8 * g4 + 4 * hi));
        Sacc[kb][4 * g4] *= d.x; Sacc[kb][4 * g4 + 1] *= d.y; Sacc[kb][4 * g4 + 2] *= d.z; Sacc[kb][4 * g4 + 3] *= d.w; }
#pragma unroll
      for (int s4 = 0; s4 < 4; ++s4) {
        const s16x4 a0 = vtr(lds + IMG_KH + nb0 + 4096 * s4 + 512 * kb), a1 = vtr(lds + IMG_KH + nb1 + 4096 * s4 + 256 + 512 * kb);
        const s16x4 b0 = vtr(lds + IMG_V + nb0 + 4096 * s4 + 512 * vblk), b1 = vtr(lds + IMG_V + nb1 + 4096 * s4 + 256 + 512 * vblk);
        const bf16x8 a = {a0[0], a0[1], a0[2], a0[3], a1[0], a1[1], a1[2], a1[3]}, bb = {b0[0], b0[1], b0[2], b0[3], b1[0], b1[1], b1[2], b1[3]};
        Sacc[kb] = __builtin_amdgcn_mfma_f32_32x32x16_bf16(a, bb, Sacc[kb], 0, 0, 0);
      }
    }
    __syncthreads();
    { const int t0_ = dir ? T - 64 * (n + 1) : 64 * n;
#pragma unroll
      for (int i = 0; i < 2; ++i) { const int tau = lrow + 32 * i; const int grow = dir ? 63 - tau : tau;
        *(u32x4*)(Od + (size_t)(seqrow + t0_ + grow) * 1024 + head * 128 + 8 * c16) = *(const LAS u32x4*)(lds + OUTB + rowimg(tau, c16)); } }
    if (n + 1 < NC) HG_STORE();
    __syncthreads();
  }
#undef HG_LOAD
#undef HG_STORE
}
__device__ __forceinline__ void phase_hgrn_combine(const bf16_t* QF, const bf16_t* Ofw, const bf16_t* Obw, bf16_t* O, const float* gn, int gw, int ngw, int lane) {
  for (int t = gw; t < M_TOK; t += ngw) {
    const int c0 = 16 * lane;
    float v[16], gv[16];
    { const bf16_t* a = Ofw + (size_t)t * 1024 + c0; const bf16_t* b = Obw + (size_t)t * 1024 + c0; const bf16_t* gp = QF + (size_t)t * 5120 + 4096 + c0;
#pragma unroll
      for (int j = 0; j < 2; ++j) { const u32x4 x = *(const u32x4*)(a + 8 * j), y = *(const u32x4*)(b + 8 * j), z = *(const u32x4*)(gp + 8 * j);
        v[8 * j + 0] = bflo(x.x) + bflo(y.x); v[8 * j + 1] = bfhi(x.x) + bfhi(y.x); v[8 * j + 2] = bflo(x.y) + bflo(y.y); v[8 * j + 3] = bfhi(x.y) + bfhi(y.y);
        v[8 * j + 4] = bflo(x.z) + bflo(y.z); v[8 * j + 5] = bfhi(x.z) + bfhi(y.z); v[8 * j + 6] = bflo(x.w) + bflo(y.w); v[8 * j + 7] = bfhi(x.w) + bfhi(y.w);
        gv[8 * j + 0] = bflo(z.x); gv[8 * j + 1] = bfhi(z.x); gv[8 * j + 2] = bflo(z.y); gv[8 * j + 3] = bfhi(z.y); gv[8 * j + 4] = bflo(z.z); gv[8 * j + 5] = bfhi(z.z); gv[8 * j + 6] = bflo(z.w); gv[8 * j + 7] = bfhi(z.w); } }
    float ss = 0.f;
#pragma unroll
    for (int i = 0; i < 16; ++i) ss += v[i] * v[i];
    ss += DPPF(ss, 0xB1); ss += DPPF(ss, 0x4E); ss += DPPF(ss, 0x141);
    const float rs = rsqrtf(ss * (1.f / 128.f) + 1e-6f);
    unsigned w[8];
#pragma unroll
    for (int i = 0; i < 8; ++i) { const int d = (c0 & 127) + 2 * i; const float g0 = gv[2 * i], g1 = gv[2 * i + 1];
      w[i] = pkbf(v[2 * i] * rs * gn[d] * (g0 / (1.f + __expf(-g0))), v[2 * i + 1] * rs * gn[d + 1] * (g1 / (1.f + __expf(-g1)))); }
    bf16_t* op = O + (size_t)t * DM + c0; *(u32x4*)op = (u32x4){w[0], w[1], w[2], w[3]}; *(u32x4*)(op + 8) = (u32x4){w[4], w[5], w[6], w[7]};
  }
}

__device__ __forceinline__ void phase_convglu(const bf16_t* U, bf16_t* G, const float* cw  , const float* cb  , int half, int gt, int ngt) {
  const size_t total = (size_t)MH * 352; const int S = half ? 4096 : 8192;
  for (size_t it = gt; it < total; it += ngt) {
    const int row = (int)(it / 352), c8 = (int)(it % 352), c = 8 * c8; const int pos = row & (S - 1);
    float a[8], b[8];
#pragma unroll
    for (int i = 0; i < 8; ++i) { a[i] = cb[c + i]; b[i] = cb[2816 + c + i]; }
#pragma unroll
    for (int tap = 0; tap < 3; ++tap) { const int pp = pos + tap - 1; if (pp < 0 || pp >= S) continue;
      const bf16_t* ur = U + (size_t)(row + tap - 1) * 5632; const u32x4 ua = *(const u32x4*)(ur + c), ub = *(const u32x4*)(ur + 2816 + c);
      const float fa[8] = {bflo(ua.x), bfhi(ua.x), bflo(ua.y), bfhi(ua.y), bflo(ua.z), bfhi(ua.z), bflo(ua.w), bfhi(ua.w)};
      const float fb[8] = {bflo(ub.x), bfhi(ub.x), bflo(ub.y), bfhi(ub.y), bflo(ub.z), bfhi(ub.z), bflo(ub.w), bfhi(ub.w)};
#pragma unroll
      for (int i = 0; i < 8; ++i) { a[i] += fa[i] * cw[tap * 5632 + c + i]; b[i] += fb[i] * cw[tap * 5632 + 2816 + c + i]; } }
    float o[8];
#pragma unroll
    for (int i = 0; i < 8; ++i) { const float x = a[i], z = 1.5957691216057308f * (x + 0.044715f * x * x * x); o[i] = x / (1.f + __expf(-z)) * b[i]; }
    u32x4 w; w.x = pkbf(o[0], o[1]); w.y = pkbf(o[2], o[3]); w.z = pkbf(o[4], o[5]); w.w = pkbf(o[6], o[7]);
    *(u32x4*)(G + (size_t)row * DFF + c) = w;
  }
}

#define XB_TMO      128
#define XB_XCNT(j)  (256  + 64 * (j))
#define XB_XSUB(j)  (1280 + 64 * (j))
#define XB_XGEN(j)  (2304 + 64 * (j))
#define XB_TOP      3328
#define XB_TOPGEN   3392
#define XCD_BAR_WORDS 3456
#define XB_SPIN_CAP (1u << 18)

__device__ __forceinline__ unsigned xb_ld(unsigned* p)              { return __hip_atomic_load(p, __ATOMIC_RELAXED, __HIP_MEMORY_SCOPE_AGENT); }
__device__ __forceinline__ unsigned xb_add(unsigned* p, unsigned v) { return __hip_atomic_fetch_add(p, v, __ATOMIC_RELAXED, __HIP_MEMORY_SCOPE_AGENT); }
__device__ __forceinline__ unsigned xb_xcc_id() { return (unsigned)__builtin_amdgcn_s_getreg((3 << 11) | 20) & 0xFu; }
#define XB_SPIN(cond, bar) do { unsigned _sp = 0; while (cond) { __builtin_amdgcn_s_sleep(1); \
    if ((++_sp & 255u) == 0u) { if (xb_ld(&(bar)[XB_TMO])) break; if (_sp > XB_SPIN_CAP) { atomicAdd(&(bar)[XB_TMO], 1u); break; } } } } while (0)

struct XcdBarrier {
    unsigned* bar; unsigned x;
    volatile LAS unsigned* st;
};

__device__ __forceinline__ XcdBarrier xcd_barrier_post(unsigned* bar, volatile LAS unsigned* st) {
    XcdBarrier b; b.bar = bar; b.x = xb_xcc_id(); b.st = st;
    if (threadIdx.x == 0) (void)xb_add(&bar[XB_XCNT(b.x)], 1u);
    return b;
}
__device__ __forceinline__ void xcd_barrier_complete(unsigned* bar, unsigned x, unsigned& nloc, unsigned& nx) {
    const unsigned G = gridDim.x * gridDim.y * gridDim.z;
    unsigned sum, cnt, mine, sp = 0u;
    for (;;) {
        sum = 0u; cnt = 0u; mine = 0u;
#pragma unroll
        for (unsigned j = 0; j < 16; ++j) { const unsigned c = xb_ld(&bar[XB_XCNT(j)]); sum += c; cnt += (c > 0u) ? 1u : 0u; mine = (j == x) ? c : mine; }
        if (sum == G) break;
        __builtin_amdgcn_s_sleep(1);
        if ((++sp & 255u) == 0u) { if (xb_ld(&bar[XB_TMO])) break; if (sp > XB_SPIN_CAP) { atomicAdd(&bar[XB_TMO], 1u); break; } }
    }
    nloc = mine > 0u ? mine : 1u; nx = cnt > 0u ? cnt : 1u;
}

__device__ __forceinline__ void xcd_barrier(const XcdBarrier& b) {
    asm volatile("s_waitcnt vmcnt(0)" ::: "memory");
    __syncthreads();
    if (threadIdx.x == 0) {
        unsigned* bar = b.bar;
        __builtin_amdgcn_s_waitcnt(0);
        unsigned nloc = b.st[0], nx = b.st[1];
        if (nloc == 0u) { xcd_barrier_complete(bar, b.x, nloc, nx); b.st[0] = nloc; b.st[1] = nx; }
        const unsigned old = xb_add(&bar[XB_XSUB(b.x)], 1u);
        const unsigned gen = old / nloc;
        if (old + 1u == (gen + 1u) * nloc) {
            __builtin_amdgcn_fence(__ATOMIC_RELEASE, "agent");
            asm volatile("s_waitcnt vmcnt(0)" ::: "memory");
            const unsigned og = xb_add(&bar[XB_TOP], 1u);
            const unsigned tg = og / nx;
            if (og + 1u == (tg + 1u) * nx) xb_add(&bar[XB_TOPGEN], 1u);
            else XB_SPIN(xb_ld(&bar[XB_TOPGEN]) == tg, bar);
            __builtin_amdgcn_fence(__ATOMIC_ACQUIRE, "agent");
            xb_add(&bar[XB_XGEN(b.x)], 1u);
            asm volatile("s_waitcnt vmcnt(0)" ::: "memory");
        } else {
            XB_SPIN(xb_ld(&bar[XB_XGEN(b.x)]) == gen, bar);
            __builtin_amdgcn_fence(__ATOMIC_ACQUIRE, "agent");
            asm volatile("s_waitcnt vmcnt(0)" ::: "memory");
        }
    }
    __syncthreads();
}

typedef pg8::EpiBf16<0> EpiP;
enum { OP_GEMM = 0, OP_ROPE_DIFF, OP_DIFF_ATTN, OP_RES_NORM, OP_ROPE_DIL, OP_DIL_ATTN, OP_DIL_COMB, OP_HG_GATES, OP_HG_SCAN, OP_HG_COMB, OP_CONVGLU, OP_GEMM_FFN, OP_END };
struct Step { int op; int half; const bf16_t* A; const bf16_t* Bt; bf16_t* O; int M, N, K, ldc, split; const bf16_t* Yin; int gA, gB; int mode, tok0; };
__device__ __forceinline__ Step get_step(int layer, int s, unsigned char* ws) {
  bf16_t* W = (bf16_t*)(ws + WS_W); bf16_t* H = (bf16_t*)(ws + WS_H); bf16_t* Y = (bf16_t*)(ws + WS_Y); bf16_t* BIG = (bf16_t*)(ws + WS_BIG);
  const int kind = layer % 3, j = layer / 3;
  Step st; st.op = OP_END; st.half = 0; st.A = H; st.Bt = W; st.O = Y; st.M = M_TOK; st.N = 1024; st.K = 1024; st.ldc = 1024; st.split = 0; st.Yin = Y; st.gA = 0; st.gB = -1; st.mode = 0; st.tok0 = 0;
  const int nmix = (kind == 0) ? 3 : (kind == 1) ? 7 : 4;
  if (s < nmix) {
    if (kind == 2) {
      if (s == 0) { st.op = OP_GEMM; st.A = H; st.Bt = W + WE_CIN; st.O = BIG; st.N = 5120; st.ldc = 5120; st.mode = 2; }
      else if (s == 1) st.op = OP_HG_SCAN;
      else if (s == 2) st.op = OP_HG_COMB;
      else { st.op = OP_GEMM; st.A = Y; st.Bt = W + WE_CO; st.O = H; }
    } else if (kind == 0) {
      if (s == 0) { st.op = OP_GEMM; st.A = H; st.Bt = W + WE_AQKV + (size_t)j * 3072 * 1024; st.O = BIG; st.N = 3072; st.split = 1024; st.mode = 1; }
      else if (s == 1) st.op = OP_DIFF_ATTN;
      else { st.op = OP_GEMM; st.A = H; st.Bt = W + WE_AO + (size_t)j * 1024 * 1024; st.O = Y; }
    } else {
      if (s == 6) { st.op = OP_GEMM; st.A = Y; st.Bt = W + WE_BO; st.O = H; }
      else { const int half = s / 3, q = s % 3; st.half = half;
        if (q == 0) { st.op = OP_GEMM; st.A = H + (size_t)half * MH * DM; st.Bt = W + WE_BQKV; st.O = BIG; st.M = MH; st.N = 9216; st.ldc = 9216; st.mode = 1; st.tok0 = half * MH; }
        else st.op = (q == 1) ? OP_DIL_ATTN : OP_DIL_COMB; }
    }
    return st;
  }
  const int f = s - nmix;
  bf16_t* U = Y; bf16_t* Gb = Y + 352ull * MiB / 2;
  if (f == 0) { st.op = OP_RES_NORM; st.Yin = (kind == 0) ? Y : H; st.gA = layer * 4 + 1; st.gB = layer * 4 + 2; }
  else if (f == 1) { st.op = OP_GEMM_FFN; st.A = H - 1024; st.Bt = W + WE_FIN + (size_t)layer * 5632 * 1024; st.O = Gb; st.M = 265 * 256; st.N = 5632; }
  else if (f == 2) { st.op = OP_GEMM; st.A = Gb; st.Bt = W + WE_FOUT + (size_t)layer * 1024 * 2816; st.O = Y; st.K = 2816; }
  else if (f == 3) { st.op = OP_RES_NORM; st.Yin = Y; st.gA = layer * 4 + 3; st.gB = (layer < 3) ? (layer + 1) * 4 : -1; }
  return st;
}

__global__ void __launch_bounds__(512) fwd_megakernel(Params p) {
  extern __shared__ __attribute__((aligned(16))) unsigned char lds_raw[];
  cg::grid_group grid = cg::this_grid();
  ldsp lds = (ldsp)lds_raw;
  const int G = gridDim.x, ngw = G * 8, ngt = G * 512;
  if (threadIdx.x < 2) *(LAS unsigned*)(lds + 131072 + 256 + 4 * threadIdx.x) = 0u;
  __syncthreads();
#define FRESH() const int tid = fresh_tid(), lane = tid & 63, wave = tid >> 6, gw = blockIdx.x * 8 + wave, gt = blockIdx.x * 512 + tid; (void)lane; (void)wave; (void)gw; (void)gt
  unsigned char* ws = kargs()->ws;
  float* x = kargs()->out;
  float* rope = (float*)(ws + WS_ROPE); float* oml = (float*)(ws + WS_OML);
  bf16_t* W = (bf16_t*)(ws + WS_W); bf16_t* H = (bf16_t*)(ws + WS_H); bf16_t* Y = (bf16_t*)(ws + WS_Y); bf16_t* BIG = (bf16_t*)(ws + WS_BIG);
#define norm_g (kargs()->in[2])

  {
    FRESH();
    LAS float* scr = (LAS float*)(lds + wave * 16384);
#pragma unroll 1
    for (int it = __builtin_amdgcn_readfirstlane(gw); it < 29184; it += ngw) {
      const float* src; bf16_t* dst; int K = 1024, N = 1024, li = it; bool glu = false;
      const CParamsPtr ka_ = kargs();
      if (li < 3072) { const int j = li / 1536; li -= j * 1536; src = ka_->in[3] + (size_t)j * 1024 * 3072; dst = W + WE_AQKV + (size_t)j * 3072 * 1024; N = 3072; }
      else if ((li -= 3072) < 1024) { const int j = li / 512; li -= j * 512; src = ka_->in[6] + (size_t)j * 1024 * 1024; dst = W + WE_AO + (size_t)j * 1024 * 1024; }
      else if ((li -= 1024) < 4608) { src = ka_->in[7]; dst = W + WE_BQKV; N = 9216; }
      else if ((li -= 4608) < 512) { src = ka_->in[8]; dst = W + WE_BO; }
      else if ((li -= 512) < 2560) { src = ka_->in[9]; dst = W + WE_CIN; N = 5120; }
      else if ((li -= 2560) < 512) { src = ka_->in[12]; dst = W + WE_CO; }
      else if ((li -= 512) < 11264) { const int l = li / 2816; li -= l * 2816; src = ka_->in[13] + (size_t)l * 1024 * 5632; dst = W + WE_FIN + (size_t)l * 5632 * 1024; N = 5632; glu = true; }
      else { li -= 11264; const int l = li / 1408; li -= l * 1408; src = ka_->in[16] + (size_t)l * 2816 * 1024; dst = W + WE_FOUT + (size_t)l * 1024 * 2816; K = 2816; }
      transpose_item(src, K, N, dst, scr, li, lane, glu);
    }
    for (int i = gt; i < 8192 * 8; i += ngt) { const int pos = i >> 3, f = i & 7; const double rev = (double)pos * kargs()->invf[f] * 0.15915494309189535; const float fr = (float)(rev - floor(rev));
      rope[pos * 16 + f] = __builtin_amdgcn_cosf(fr); rope[pos * 16 + 8 + f] = __builtin_amdgcn_sinf(fr); }
    for (int i = gt; i < 1024; i += ngt) { const float* lg = kargs()->in[10]; const float a0 = lg[i], a1 = lg[1024 + i], a2 = lg[2048 + i], a3 = lg[3072 + i]; const float mx = fmaxf(fmaxf(a0, a1), fmaxf(a2, a3));
      const float e0 = __expf(a0 - mx), e1 = __expf(a1 - mx), e2 = __expf(a2 - mx), e3 = __expf(a3 - mx); oml[i] = 1.f - (e1 + e2) / (e0 + e1 + e2 + e3); }
    phase_init_norm(kargs()->in[0], kargs()->in[1], x, H, norm_g, gw, ngw, lane);
  }
  grid.sync();
  XcdBarrier xbar = xcd_barrier_post((unsigned*)(ws + WS_BAR), (volatile LAS unsigned*)(lds + 131072 + 256));

#pragma unroll 1
  for (int layer = 0; layer < 4; ++layer) {
#pragma unroll 1
#ifdef PROBE_DUP_OP
    for (int s = 0, rep_ = 0; s < 16; ) {
#else
    for (int s = 0; s < 16; ++s) {
#endif
      const Step st = get_step(layer, s, ws);
      if (st.op == OP_END) break;
#ifdef PROBE_REPEAT_OP
      for (int rep_ = 0; rep_ < ((st.op == PROBE_REPEAT_OP) ? 2 : 1); ++rep_) {
#endif
      switch (st.op) {
        case OP_GEMM: {
          pg8::EpiAct E{st.O, st.ldc, st.split, (size_t)M_TOK * DM, st.mode, rope, st.tok0, C2};
          int gM = st.M, gN = st.N, gK = st.K, gG = G, gB = (int)blockIdx.x; asm volatile("" : "+s"(gM), "+s"(gN), "+s"(gK), "+s"(gG), "+s"(gB));
          pg8::Gemm g{st.A, st.Bt, gM, gN, gK}; pg8::StaticOrder S; S.init(gM, gN, gG, gB);
          pg8::gemm_phase<pg8::EpiAct, pg8::StaticOrder, true, true>(lds, g, S, E);
        } break;
        case OP_GEMM_FFN: {
          int ly = layer; asm volatile("" : "+s"(ly));
          pg8::EpiConvGlu E{st.O, kargs()->in[14] + (size_t)ly * 3 * 5632, kargs()->in[15] + (size_t)ly * 5632};
          int gM = st.M, gN = st.N, gK = st.K, gG = G, gB = (int)blockIdx.x; asm volatile("" : "+s"(gM), "+s"(gN), "+s"(gK), "+s"(gG), "+s"(gB));
          pg8::Gemm g{st.A, st.Bt, gM, gN, gK}; pg8::StaticOrder S; S.init(gM, gN, gG, gB);
          pg8::gemm_phase<pg8::EpiConvGlu, pg8::StaticOrder, true, true, true>(lds, g, S, E);
        } break;
        case OP_ROPE_DIFF: { FRESH(); bf16_t* Qb = BIG; bf16_t* Kb = BIG + (size_t)M_TOK * DM;
          for (int it = gw; it < M_TOK * 2; it += ngw) { const int row = it >> 1, sg = it & 1; const int pos = (row < MH) ? (row & 8191) : (row & 4095);
            rope_seg((sg ? Kb : Qb) + (size_t)row * DM + 16 * lane, pos, sg ? 1.f : C2, rope, lane); } } break;
        case OP_DIFF_ATTN: { int ly = layer; asm volatile("" : "+s"(ly)); const int j = ly / 3; const float lam_init = __builtin_bit_cast(float, (ly == 0) ? 0x3e4ccccd : 0x3f0e59d5), osc_l = __builtin_bit_cast(float, (ly == 0) ? 0x3f4ccccd : 0x3ee34c57);
          phase_diff_attn(lds, BIG, BIG + (size_t)M_TOK * DM, BIG + 2 * (size_t)M_TOK * DM, H, kargs()->in[4] + j * 256, kargs()->in[5] + j * 128, lam_init, osc_l); } break;
        case OP_RES_NORM: { FRESH(); const bool first_ = (st.gA == 1); phase_res_norm(st.Yin, x, H, norm_g + st.gA * 1024, st.gB >= 0 ? norm_g + st.gB * 1024 : nullptr, gw, ngw, lane, first_ ? kargs()->in[0] : nullptr, first_ ? kargs()->in[1] : nullptr); } break;
        case OP_ROPE_DIL: { FRESH();
          for (int it = gw; it < MH * 6; it += ngw) { const int row = it / 6, sg = it % 6; const int tok = st.half * MH + row; const int pos = (tok < MH) ? (tok & 8191) : (tok & 4095);
            rope_seg(BIG + (size_t)row * 9216 + (sg >> 1) * 3072 + (sg & 1) * 1024 + 16 * lane, pos, (sg & 1) ? 1.f : C2, rope, lane); } } break;
        case OP_DIL_ATTN: { float* LSE = (float*)(BIG + (size_t)MH * 9216);
#pragma unroll 1
          for (int u = blockIdx.x; u < 6144; u += G) dil_unit(lds, BIG, LSE, st.half, u); } break;
        case OP_DIL_COMB: { FRESH(); phase_dil_combine(BIG, (const float*)(BIG + (size_t)MH * 9216), Y + (size_t)st.half * MH * DM, gw, ngw, lane); } break;
        case OP_HG_GATES: { FRESH(); phase_hgrn_gates(BIG, gt, ngt); } break;
        case OP_HG_SCAN: {
#pragma unroll 1
          for (int c = blockIdx.x; c < 192; c += G) hgrn_chain(lds, BIG, Y, H, oml, c); } break;
        case OP_HG_COMB: { FRESH(); phase_hgrn_combine(BIG, Y, H, Y, kargs()->in[11], gw, ngw, lane); } break;
        case OP_CONVGLU: { FRESH(); phase_convglu(Y, Y + 352ull * MiB / 2 + (size_t)st.half * MH * DFF, kargs()->in[14] + (size_t)layer * 3 * 5632, kargs()->in[15] + (size_t)layer * 5632, st.half, gt, ngt); } break;
        default: break;
      }
      xcd_barrier(xbar);
#ifdef PROBE_DUP_OP
      if (st.op == PROBE_DUP_OP && rep_ == 0) rep_ = 1; else { rep_ = 0; ++s; }
#endif
#ifdef PROBE_REPEAT_OP
      }
#endif
    }
  }
}

constexpr int LDS_BYTES = 147456;
extern "C" void kernel_launch(void* const* d_in, const int* in_sizes, int n_in, void* d_out, int out_size, void* d_ws, size_t ws_size, hipStream_t stream) {
  static int grid = 0;
  if (grid == 0) {
    if (n_in != 17 || ws_size < WS_END) { fprintf(stderr, "kernel_launch: unexpected n_in %d / ws %zu\n", n_in, ws_size); grid = -1; return; }
    int dev = 0, cus = 0;
    if (hipGetDevice(&dev) != hipSuccess || hipDeviceGetAttribute(&cus, hipDeviceAttributeMultiprocessorCount, dev) != hipSuccess) { grid = -1; return; }
    if (hipFuncSetAttribute((const void*)fwd_megakernel, hipFuncAttributeMaxDynamicSharedMemorySize, LDS_BYTES) != hipSuccess) { fprintf(stderr, "hipFuncSetAttribute failed\n"); grid = -1; return; }
    grid = cus;
  }
  if (grid < 0) return;
  if (hipMemsetAsync((char*)d_ws + WS_BAR, 0, XCD_BAR_WORDS * 4, stream) != hipSuccess) { fprintf(stderr, "kernel_launch: memset of the barrier words failed\n"); return; }
  Params p{};
  for (int i = 0; i < 17; ++i) p.in[i] = (const float*)d_in[i];
  p.out = (float*)d_out; p.ws = (unsigned char*)d_ws;
  for (int i = 0; i < 8; ++i) p.invf[i] = pow(500000.0, -(double)i / 8.0);
  void* args[] = {&p};
  hipError_t e = hipLaunchCooperativeKernel((void*)fwd_megakernel, dim3(grid), dim3(512), args, LDS_BYTES, stream);
  if (e != hipSuccess) fprintf(stderr, "cooperative launch failed: %s (grid %d)\n", hipGetErrorString(e), grid);
}
```

```cpp
#include <hip/hip_runtime.h>
#include <hip/hip_cooperative_groups.h>
#include <cstdio>
#include <cstdint>
#include <cmath>
namespace cg = cooperative_groups;
namespace pg8 {
#define PG8_LAS __attribute__((address_space(3)))
typedef unsigned short bf16_t;
typedef short bf16x8 __attribute__((ext_vector_type(8)));
typedef float f32x4 __attribute__((ext_vector_type(4)));
typedef unsigned u32x4 __attribute__((ext_vector_type(4)));
constexpr int BM = 256, BK = 64, HALF = 128, HTB = HALF * BK * 2  , STAGE_BYTES = 8 * HTB, NXCD = 8, WGM = 8;

__host__ __device__ __forceinline__ int lds_byte(int r, int c) { const int st = (r >> 4) * 2 + (c >> 5), rr = r & 15, cc = c & 31, ob = rr * 64 + cc * 2; return st * 1024 + (ob ^ (((ob >> 9) & 1) << 5)); }
__host__ __device__ __forceinline__ void stage_rc(int b, int& R, int& C) { const int st = b / 1024, sb = b % 1024, swz = sb ^ (((sb >> 9) & 1) << 5); R = (st >> 1) * 16 + swz / 64; C = (st & 1) * 32 + (swz % 64) / 2; }
__host__ __device__ __forceinline__ int perm32(int rho) { const int n = rho >> 4, i = rho & 15; return 8 * (i >> 2) + 4 * n + (i & 3); }

struct Unit { int pm, pn; };
struct Gemm { const bf16_t* A; const bf16_t* Bt; int M, N, K; };

struct StaticOrder {
    int nM, nN, nwg, G, c;
    __host__ __device__ void init(int M, int N, int G_, int c_) { nM = M / BM; nN = N / BM; nwg = nM * nN; G = G_; c = c_; }
    __host__ __device__ bool next(int i, Unit& u) const {
        const int L = i * G + c; if (L >= nwg) return false;
        int wgid = L; { const int q = nwg / NXCD, r = nwg % NXCD, xcd = wgid % NXCD, off = wgid / NXCD; wgid = (xcd < r ? xcd * (q + 1) : r * (q + 1) + (xcd - r) * q) + off; }
        const int nig = WGM * nN, gid = wgid / nig, fm = gid * WGM, gsz = (nM - fm) < WGM ? (nM - fm) : WGM;
        u.pm = fm + ((wgid % nig) % gsz); u.pn = (wgid % nig) / gsz; return true;
    }
    __device__ __forceinline__ void a_ready(const Unit&) const {}
    __device__ __forceinline__ void done(const Unit&) const {}
};

__device__ __forceinline__ unsigned cvt_pk_bf16(float lo, float hi) { unsigned r; asm volatile("v_cvt_pk_bf16_f32 %0, %1, %2" : "=v"(r) : "v"(lo), "v"(hi)); return r; }
typedef float f32x2 __attribute__((ext_vector_type(2)));
__device__ __forceinline__ f32x2 gelu_pk(f32x2 v) {
    const f32x2 av = __builtin_elementwise_abs(v), d = av * 0.2316418882f + 1.0f;
    f32x2 t; t.x = __builtin_amdgcn_rcpf(d.x); t.y = __builtin_amdgcn_rcpf(d.y);
    f32x2 q = t * 0.5307027145f + (-0.7265760135f); q = q * t + 0.7107068705f; q = q * t + (-0.142248368f); q = q * t + 0.127414796f; q = q * t;
    const f32x2 s = (v * v) * (-0.72134752044f);
    f32x2 e; e.x = __builtin_amdgcn_exp2f(s.x); e.y = __builtin_amdgcn_exp2f(s.y);
    const f32x2 m = v * (q * e), r = v - m;
    f32x2 o; o.x = v.x < 0.f ? m.x : r.x; o.y = v.y < 0.f ? m.y : r.y; return o;
}

template <int ACT  > struct EpiBf16 {
    static constexpr bool PERM = true, AFTER_DRAIN = false; static_assert(ACT == 0 || ACT == 1, "EpiBf16: ACT is 0 (none) or 1 (gelu_pk)");
    bf16_t* O; int ldc; const float* bias; int split_cols; size_t split_stride; float scale0;
    __device__ __forceinline__ void operator()(const f32x4 (&acc)[2][2][4][2], const Unit& u, int wr, int wc, int fr, int fq) const {
        const int row0 = u.pm * BM + wr * 64 + fr; int colt = u.pn * BM; bf16_t* base = O;
        float sc = 1.f; if (split_cols) { const int t = colt / split_cols; base += (size_t)t * split_stride; colt -= t * split_cols; if (t == 0) sc = scale0; }
        const int col0 = colt + wc * 32 + 8 * fq, bcol0 = u.pn * BM + wc * 32 + 8 * fq;
        f32x4 bv[2][2];
#pragma unroll
        for (int bj = 0; bj < 2; ++bj)
#pragma unroll
            for (int n = 0; n < 2; ++n) bv[bj][n] = bias ? *(const f32x4*)(bias + bcol0 + bj * HALF + 4 * n) : (f32x4){0.f, 0.f, 0.f, 0.f};
#pragma unroll
        for (int ai = 0; ai < 2; ++ai)
#pragma unroll
            for (int m = 0; m < 4; ++m) { bf16_t* rowp = base + (size_t)(row0 + ai * HALF + m * 16) * ldc + col0;
#pragma unroll
                for (int bj = 0; bj < 2; ++bj) { f32x4 v0 = acc[ai][bj][m][0] + bv[bj][0], v1 = acc[ai][bj][m][1] + bv[bj][1];
                    if (ACT == 1) { f32x2 a = gelu_pk((f32x2){v0[0], v0[1]}), b = gelu_pk((f32x2){v0[2], v0[3]}), c = gelu_pk((f32x2){v1[0], v1[1]}), d = gelu_pk((f32x2){v1[2], v1[3]});
                        v0 = (f32x4){a.x, a.y, b.x, b.y}; v1 = (f32x4){c.x, c.y, d.x, d.y}; }
                    v0 = v0 * sc; v1 = v1 * sc; u32x4 w; w.x = cvt_pk_bf16(v0[0], v0[1]); w.y = cvt_pk_bf16(v0[2], v0[3]); w.z = cvt_pk_bf16(v1[0], v1[1]); w.w = cvt_pk_bf16(v1[2], v1[3]);
                    *(u32x4*)(rowp + bj * HALF) = w; } }
    }
};


struct EpiAct {
    static constexpr bool PERM = true, AFTER_DRAIN = false;
    bf16_t* O; int ldc; int split_cols; size_t split_stride; int mode; const float* rope; int tok0; float qscale;
    __device__ __forceinline__ void operator()(const f32x4 (&acc)[2][2][4][2], const Unit& u, int wr, int wc, int fr, int fq) const {
        const int row0 = u.pm * BM + wr * 64 + fr; int colt = u.pn * BM; bf16_t* base = O; asm volatile("" : "+s"(base));
        const float* rope_ = rope; asm volatile("" : "+s"(rope_));
        int act = 0;
        if (mode == 1) { const int seg = colt % 3072; act = seg < 1024 ? 1 : (seg < 2048 ? 2 : 0); }
        else if (mode == 2) { act = colt < 1024 ? 3 : (colt < 3072 ? 4 : 0); }
        if (split_cols) { const int t = colt / split_cols; base += (size_t)t * split_stride; colt -= t * split_cols; }
        const int col0 = colt + wc * 32 + 8 * fq;
        const bool rope_wave = (act == 1 || act == 2) && ((wc & 1) == 0);
        const float sc = (act == 1) ? qscale : 1.f;
        const float sgn = (fq == 0) ? -1.f : 1.f; const bool rot = fq < 2;
#pragma unroll
        for (int ai = 0; ai < 2; ++ai)
#pragma unroll
            for (int m = 0; m < 4; ++m) {
                const int row = row0 + ai * HALF + m * 16; bf16_t* rowp = base + (size_t)row * ldc + col0;
                f32x4 c0 = {1.f, 1.f, 1.f, 1.f}, c1 = c0, s0 = {0.f, 0.f, 0.f, 0.f}, s1 = s0;
                if (rope_wave) { const int tok = tok0 + row; const int pos = (tok < 32768) ? (tok & 8191) : (tok & 4095); const float* cs = rope_ + (size_t)pos * 16;
                    c0 = *(const f32x4*)cs; c1 = *(const f32x4*)(cs + 4); s0 = *(const f32x4*)(cs + 8) * sgn; s1 = *(const f32x4*)(cs + 12) * sgn; }
#pragma unroll
                for (int bj = 0; bj < 2; ++bj) {
                    f32x4 v0 = acc[ai][bj][m][0], v1 = acc[ai][bj][m][1];
                    if (rope_wave) {
                        f32x4 p0, p1;
#pragma unroll
                        for (int e = 0; e < 4; ++e) { float a0 = v0[e], b0 = v0[e], a1 = v1[e], b1 = v1[e];
                            asm volatile("s_nop 1\n\tv_permlane16_swap_b32 %0, %1" : "+v"(a0), "+v"(b0));
                            asm volatile("s_nop 1\n\tv_permlane16_swap_b32 %0, %1" : "+v"(a1), "+v"(b1));
                            p0[e] = (fq & 1) ? a0 : b0; p1[e] = (fq & 1) ? a1 : b1; }
                        const f32x4 r0 = v0 * c0 + p0 * s0, r1 = v1 * c1 + p1 * s1;
                        if (rot) { v0 = r0; v1 = r1; }
                    }
                    if (act == 3) {
#pragma unroll
                        for (int e = 0; e < 4; ++e) { v0[e] = v0[e] * __builtin_amdgcn_rcpf(1.f + __builtin_amdgcn_exp2f(-1.4426950409f * v0[e])) * 0.08838834764831845f;
                                                       v1[e] = v1[e] * __builtin_amdgcn_rcpf(1.f + __builtin_amdgcn_exp2f(-1.4426950409f * v1[e])) * 0.08838834764831845f; }
                    } else if (act == 4) {
#pragma unroll
                        for (int e = 0; e < 4; ++e) { v0[e] = __builtin_amdgcn_rcpf(1.f + __builtin_amdgcn_exp2f(1.4426950409f * v0[e])); v1[e] = __builtin_amdgcn_rcpf(1.f + __builtin_amdgcn_exp2f(1.4426950409f * v1[e])); }
                    }
                    v0 = v0 * sc; v1 = v1 * sc;
                    u32x4 w; w.x = cvt_pk_bf16(v0[0], v0[1]); w.y = cvt_pk_bf16(v0[2], v0[3]); w.z = cvt_pk_bf16(v1[0], v1[1]); w.w = cvt_pk_bf16(v1[2], v1[3]);
                    *(u32x4*)(rowp + bj * HALF) = w;
                }
            }
    }
};

struct EpiConvGlu {
    static constexpr bool PERM = true, AFTER_DRAIN = false;
    bf16_t* G; const float* cw; const float* cb;
    __device__ __forceinline__ void operator()(f32x4 (&acc)[2][2][4][2], const Unit& u, int wr, int wc, int fr, int fq) const {
        const int chb = u.pn * 128 + wc * 32 + 8 * fq;
        bf16_t* G_ = G; const float* cw_ = cw; const float* cb_ = cb; asm volatile("" : "+s"(G_), "+s"(cw_), "+s"(cb_));
        f32x4 w0[2][2], w1[2][2], w2[2][2], bb[2][2];
#pragma unroll
        for (int bj = 0; bj < 2; ++bj)
#pragma unroll
            for (int n = 0; n < 2; ++n) { const int col = bj * 2816 + chb + 4 * n;
                w0[bj][n] = *(const f32x4*)(cw_ + col); w1[bj][n] = *(const f32x4*)(cw_ + 5632 + col); w2[bj][n] = *(const f32x4*)(cw_ + 2 * 5632 + col); bb[bj][n] = *(const f32x4*)(cb_ + col); }
#pragma unroll
        for (int ai = 0; ai < 2; ++ai) {
            const int tokb = 62 * (4 * u.pm + 2 * ai + wr) - 1 + 4 * fr;
            float pm_[4], nm_[4];
#pragma unroll
            for (int m = 0; m < 4; ++m) { const int t = tokb + m; const int msk = (t < 32768) ? 8191 : 4095; pm_[m] = ((t & msk) == 0) ? 0.f : 1.f; nm_[m] = ((t & msk) == msk) ? 0.f : 1.f; }
#pragma unroll
            for (int bj = 0; bj < 2; ++bj)
#pragma unroll
                for (int n = 0; n < 2; ++n) {
                    const f32x4 x0 = acc[ai][bj][0][n], x1 = acc[ai][bj][1][n], x2 = acc[ai][bj][2][n], x3 = acc[ai][bj][3][n];
                    f32x4 pv, nx;
#pragma unroll
                    for (int e = 0; e < 4; ++e) { float a_, b_;
                        asm volatile("s_nop 1\n\tv_mov_b32_dpp %0, %1 row_shr:1 row_mask:0xf bank_mask:0xf bound_ctrl:1" : "=&v"(a_) : "v"(x3[e]));
                        asm volatile("s_nop 1\n\tv_mov_b32_dpp %0, %1 row_shl:1 row_mask:0xf bank_mask:0xf bound_ctrl:1" : "=&v"(b_) : "v"(x0[e]));
                        pv[e] = a_; nx[e] = b_; }
                    acc[ai][bj][0][n] = bb[bj][n] + w0[bj][n] * (pv * pm_[0]) + w1[bj][n] * x0 + w2[bj][n] * (x1 * nm_[0]);
                    acc[ai][bj][1][n] = bb[bj][n] + w0[bj][n] * (x0 * pm_[1]) + w1[bj][n] * x1 + w2[bj][n] * (x2 * nm_[1]);
                    acc[ai][bj][2][n] = bb[bj][n] + w0[bj][n] * (x1 * pm_[2]) + w1[bj][n] * x2 + w2[bj][n] * (x3 * nm_[2]);
                    acc[ai][bj][3][n] = bb[bj][n] + w0[bj][n] * (x2 * pm_[3]) + w1[bj][n] * x3 + w2[bj][n] * (nx * nm_[3]);
                }
#pragma unroll
            for (int m = 0; m < 4; ++m) {
                const int pos = 4 * fr + m, t = tokb + m;
                unsigned wv[4];
#pragma unroll
                for (int n = 0; n < 2; ++n) { float o[4];
#pragma unroll
                    for (int e = 0; e < 4; ++e) { const float x = acc[ai][0][m][n][e]; const float z = -2.302208198f * (x + 0.044715f * x * x * x);
                        o[e] = x * __builtin_amdgcn_rcpf(1.f + __builtin_amdgcn_exp2f(z)) * acc[ai][1][m][n][e]; }
                    wv[2 * n] = cvt_pk_bf16(o[0], o[1]); wv[2 * n + 1] = cvt_pk_bf16(o[2], o[3]); }
                if (pos >= 1 && pos <= 62 && t < 65536) *(u32x4*)(G_ + (size_t)t * 2816 + chb) = (u32x4){wv[0], wv[1], wv[2], wv[3]};
            }
        }
    }
};
template <class Epi, class Sched, bool ALIGN_EPI = false, bool SP2 = false, bool APERM = false>
__device__ __forceinline__ void gemm_phase(PG8_LAS unsigned char* lds, const Gemm g, const Sched& S, const Epi& E) {
    int tid_l = threadIdx.x; asm volatile("" : "+v"(tid_l));
    const int tid = tid_l, wid = __builtin_amdgcn_readfirstlane(tid >> 6), lane = tid & 63, wr = wid >> 2, wc = wid & 3, fr = lane & 15, fq = lane >> 4;
    const int K = g.K, nt = K / BK;
    unsigned voffA[2], voffB[2];
#pragma unroll
    for (int i = 0; i < 2; ++i) { int R, C; stage_rc(tid * 16 + i * 8192, R, C); const int Rb = Epi::PERM ? ((R & ~31) + perm32(R & 31)) : R;
        const int Ra = APERM ? (62 * (R >> 6) + 4 * (R & 15) + ((R >> 4) & 3)) : R;
        voffA[i] = (unsigned)(Ra * K + C) * 2u; voffB[i] = (unsigned)(Rb * K + C) * 2u; }
    const size_t kstep = (size_t)(BK * 2);
    const size_t hstep = (size_t)HALF * K * 2;
    const size_t tstep = 2 * hstep;
    const size_t hstepA = APERM ? (size_t)124 * K * 2 : hstep, tstepA = 2 * hstepA;
    const unsigned ldsw = (unsigned)wid * 1024u;
    const int aoff = lds_byte(wr * 64 + fr, fq * 8), boff = lds_byte(wc * 32 + fr, fq * 8);
#define PG8_SA(b, h) (((b) * 2 + (h)) * HTB)
#define PG8_SB(b, h) ((4 + (b) * 2 + (h)) * HTB)
#define PG8_STAGE(bufoff, gbase, voff) do { _Pragma("unroll") for (int _i = 0; _i < 2; ++_i) \
        __builtin_amdgcn_global_load_lds((const unsigned*)((const char*)(gbase) + (voff)[_i]), (PG8_LAS unsigned*)(lds + (bufoff) + ldsw + _i * 8192), 16, 0, 0); } while (0)
#define PG8_LDA(dst, b, h) do { _Pragma("unroll") for (int m = 0; m < 4; ++m) _Pragma("unroll") for (int k = 0; k < 2; ++k) dst[m][k] = *(const PG8_LAS bf16x8*)(lds + PG8_SA(b, h) + aoff + m * 2048 + k * 1024); } while (0)
#define PG8_LDB(dst, b, h) do { _Pragma("unroll") for (int n = 0; n < 2; ++n) _Pragma("unroll") for (int k = 0; k < 2; ++k) dst[n][k] = *(const PG8_LAS bf16x8*)(lds + PG8_SB(b, h) + boff + n * 2048 + k * 1024); } while (0)
#define PG8_MMA(ai, bj, At, Bt) do { __builtin_amdgcn_s_setprio(1); _Pragma("unroll") for (int m = 0; m < 4; ++m) _Pragma("unroll") for (int n = 0; n < 2; ++n) _Pragma("unroll") for (int k = 0; k < 2; ++k) \
        acc[ai][bj][m][n] = __builtin_amdgcn_mfma_f32_16x16x32_bf16(Bt[n][k], At[m][k], acc[ai][bj][m][n], 0, 0, 0); __builtin_amdgcn_s_setprio(0); } while (0)
#define PG8_WAIT_V(n) asm volatile("s_waitcnt vmcnt(" #n ")" ::: "memory")
#define PG8_WAIT_L(n) asm volatile("s_waitcnt lgkmcnt(" #n ")" ::: "memory")
#define PG8_BAR __builtin_amdgcn_s_barrier()
#define PG8_SCHED __builtin_amdgcn_sched_barrier(0)
    Unit cur, nxt; int ui = 0;
    if (!S.next(0, cur)) return;
    f32x4 acc[2][2][4][2];
#pragma unroll
    for (int a = 0; a < 2; ++a)
#pragma unroll
        for (int b = 0; b < 2; ++b)
#pragma unroll
            for (int m = 0; m < 4; ++m)
#pragma unroll
                for (int n = 0; n < 2; ++n) acc[a][b][m][n] = (f32x4){0.f, 0.f, 0.f, 0.f};
    bf16x8 At[4][2], B0[2][2], B1[2][2];
    const char* cA = (const char*)g.A + (size_t)cur.pm * tstepA; const char* cB = (const char*)g.Bt + (size_t)cur.pn * tstep;
    S.a_ready(cur);
    if constexpr (SP2) {
        PG8_STAGE(PG8_SB(0, 0), cB, voffB); PG8_STAGE(PG8_SB(0, 1), cB + hstep, voffB); PG8_STAGE(PG8_SA(0, 0), cA, voffA); PG8_STAGE(PG8_SA(0, 1), cA + hstepA, voffA);
        if (wr == 1) PG8_BAR;
        PG8_WAIT_V(2); PG8_BAR;
        PG8_STAGE(PG8_SB(1, 0), cB + kstep, voffB); PG8_STAGE(PG8_SA(1, 0), cA + kstep, voffA); PG8_STAGE(PG8_SB(1, 1), cB + hstep + kstep, voffB);
        PG8_WAIT_V(6); PG8_BAR;
    } else {
        PG8_STAGE(PG8_SB(0, 0), cB, voffB); PG8_STAGE(PG8_SA(0, 0), cA, voffA); PG8_STAGE(PG8_SB(0, 1), cB + hstep, voffB); PG8_STAGE(PG8_SA(0, 1), cA + hstepA, voffA);
        if (wr == 1) PG8_BAR;
        PG8_WAIT_V(4); PG8_BAR;
        PG8_STAGE(PG8_SB(1, 0), cB + kstep, voffB); PG8_STAGE(PG8_SA(1, 0), cA + kstep, voffA); PG8_STAGE(PG8_SB(1, 1), cB + hstep + kstep, voffB);
        PG8_WAIT_V(6); PG8_BAR;
    }
    for (;;) {
        const bool has_next = S.next(ui + 1, nxt);
        const char* nA = has_next ? (const char*)g.A + (size_t)nxt.pm * tstepA : cA; const char* nB = has_next ? (const char*)g.Bt + (size_t)nxt.pn * tstep : cB;
        for (int t = 0; t < nt; t += 2) {
            const bool last = (t == nt - 2);
            const char* a1 = cA + (size_t)(t + 1) * kstep;
            const char* a2 = last ? nA : cA + (size_t)(t + 2) * kstep; const char* b2 = last ? nB : cB + (size_t)(t + 2) * kstep;
            const char* a3 = a2 + kstep; const char* b3 = b2 + kstep;
            if (last && has_next) S.a_ready(nxt);
            if constexpr (SP2) {
            PG8_LDB(B0, 0, 0); PG8_LDB(B1, 0, 1); PG8_SCHED; PG8_LDA(At, 0, 0); PG8_STAGE(PG8_SA(1, 1), a1 + hstepA, voffA);
            PG8_WAIT_V(8); PG8_WAIT_L(0); PG8_BAR; PG8_MMA(0, 0, At, B0); PG8_MMA(0, 1, At, B1); PG8_BAR; PG8_SCHED;
            PG8_LDA(At, 0, 1); PG8_STAGE(PG8_SB(0, 0), b2, voffB); PG8_STAGE(PG8_SB(0, 1), b2 + hstep, voffB); PG8_STAGE(PG8_SA(0, 0), a2, voffA);
            PG8_WAIT_V(8); PG8_WAIT_L(0); PG8_BAR; PG8_MMA(1, 0, At, B0); PG8_MMA(1, 1, At, B1); PG8_BAR; PG8_SCHED;
            PG8_LDB(B0, 1, 0); PG8_LDB(B1, 1, 1); PG8_SCHED; PG8_LDA(At, 1, 0); PG8_STAGE(PG8_SA(0, 1), a2 + hstepA, voffA);
            PG8_WAIT_V(8); PG8_WAIT_L(0); PG8_BAR; PG8_MMA(0, 0, At, B0); PG8_MMA(0, 1, At, B1); PG8_BAR; PG8_SCHED;
            PG8_LDA(At, 1, 1); PG8_STAGE(PG8_SB(1, 0), b3, voffB); PG8_STAGE(PG8_SB(1, 1), b3 + hstep, voffB); PG8_STAGE(PG8_SA(1, 0), a3, voffA);
            PG8_WAIT_V(8); PG8_WAIT_L(0); PG8_BAR; PG8_MMA(1, 0, At, B0); PG8_MMA(1, 1, At, B1); PG8_BAR; PG8_SCHED;
            } else {
            PG8_LDB(B0, 0, 0); PG8_SCHED; PG8_LDA(At, 0, 0); PG8_STAGE(PG8_SA(1, 1), a1 + hstepA, voffA);
            PG8_WAIT_L(8); PG8_BAR; PG8_WAIT_L(0); PG8_MMA(0, 0, At, B0); PG8_BAR; PG8_SCHED;
            PG8_LDB(B1, 0, 1); PG8_STAGE(PG8_SB(0, 0), b2, voffB);
            PG8_BAR; PG8_WAIT_L(0); PG8_MMA(0, 1, At, B1); PG8_BAR;
            PG8_LDA(At, 0, 1); PG8_STAGE(PG8_SA(0, 0), a2, voffA);
            PG8_BAR; PG8_WAIT_L(0); PG8_MMA(1, 0, At, B0); PG8_BAR; PG8_SCHED;
            PG8_STAGE(PG8_SB(0, 1), b2 + hstep, voffB);
            PG8_WAIT_V(6); PG8_BAR; PG8_MMA(1, 1, At, B1); PG8_BAR;
            PG8_LDB(B0, 1, 0); PG8_SCHED; PG8_LDA(At, 1, 0); PG8_STAGE(PG8_SA(0, 1), a2 + hstepA, voffA);
            PG8_WAIT_L(8); PG8_BAR; PG8_WAIT_L(0); PG8_MMA(0, 0, At, B0); PG8_BAR; PG8_SCHED;
            PG8_LDB(B1, 1, 1); PG8_STAGE(PG8_SB(1, 0), b3, voffB);
            PG8_BAR; PG8_WAIT_L(0); PG8_MMA(0, 1, At, B1); PG8_BAR;
            PG8_LDA(At, 1, 1); PG8_STAGE(PG8_SA(1, 0), a3, voffA);
            PG8_BAR; PG8_WAIT_L(0); PG8_MMA(1, 0, At, B0); PG8_BAR; PG8_SCHED;
            PG8_STAGE(PG8_SB(1, 1), b3 + hstep, voffB);
            PG8_WAIT_V(6); PG8_BAR; PG8_MMA(1, 1, At, B1); PG8_BAR;
            }
        }
        if constexpr (ALIGN_EPI) { if (wr == 0) PG8_BAR; }
        if constexpr (!Epi::AFTER_DRAIN) { E(acc, cur, wr, wc, fr, fq); S.done(cur); }
        if (!has_next) break;
#pragma unroll
        for (int a = 0; a < 2; ++a)
#pragma unroll
            for (int b = 0; b < 2; ++b)
#pragma unroll
                for (int m = 0; m < 4; ++m)
#pragma unroll
                    for (int n = 0; n < 2; ++n) acc[a][b][m][n] = (f32x4){0.f, 0.f, 0.f, 0.f};
        cur = nxt; cA = nA; cB = nB; ++ui;
        if constexpr (ALIGN_EPI) { if (wr == 1) PG8_BAR; }
    }
    PG8_WAIT_V(0);
    if constexpr (!ALIGN_EPI) { if (wr == 0) PG8_BAR; }
    PG8_BAR;
    if constexpr (Epi::AFTER_DRAIN) { E.fused(acc, cur, wr, wc, fr, fq, lds, wid, lane); S.done(cur); }
#undef PG8_SA
#undef PG8_SB
#undef PG8_STAGE
#undef PG8_LDA
#undef PG8_LDB
#undef PG8_MMA
#undef PG8_WAIT_V
#undef PG8_WAIT_L
#undef PG8_BAR
#undef PG8_SCHED
}
}

#define LAS __attribute__((address_space(3)))
typedef unsigned short bf16_t;
typedef short bf16x8 __attribute__((ext_vector_type(8)));
typedef short s16x4 __attribute__((ext_vector_type(4)));
typedef float f32x16 __attribute__((ext_vector_type(16)));
typedef float f32x4 __attribute__((ext_vector_type(4)));
typedef float f32x2 __attribute__((ext_vector_type(2)));
typedef unsigned u32x4 __attribute__((ext_vector_type(4)));
typedef unsigned u32x2 __attribute__((ext_vector_type(2)));
typedef __bf16 bf16x2_t __attribute__((ext_vector_type(2)));
typedef LAS unsigned char* ldsp;

constexpr int M_TOK = 65536, MH = 32768, DM = 1024, DFF = 2816;
constexpr float C2 = 0.125f * 1.4426950408889634f;
constexpr size_t MiB = 1u << 20;
constexpr size_t WS_ROPE = 0;
constexpr size_t WS_OML = 512 * 1024;
constexpr size_t WS_BAR = 768 * 1024;
constexpr size_t WS_W = 1 * MiB;
constexpr size_t WS_H = 117 * MiB;
constexpr size_t WS_Y = 245 * MiB;
constexpr size_t WS_BIG = 373 * MiB;
constexpr size_t WS_END = 1013 * MiB;
constexpr size_t WE_AQKV = 0, WE_AO = WE_AQKV + 2ull * 3072 * 1024, WE_BQKV = WE_AO + 2ull * 1024 * 1024, WE_BO = WE_BQKV + 9216ull * 1024,
                 WE_CIN = WE_BO + 1024ull * 1024, WE_CO = WE_CIN + 5120ull * 1024, WE_FIN = WE_CO + 1024ull * 1024, WE_FOUT = WE_FIN + 4ull * 5632 * 1024,
                 WE_END = WE_FOUT + 4ull * 2816 * 1024;
static_assert(WE_END * 2 <= 116 * MiB, "weights fit");

struct Params { const float* in[17]; float* out; unsigned char* ws; double invf[8]; int pad0, pad1; };

__device__ __forceinline__ float bflo(unsigned u) { return __uint_as_float(u << 16); }
__device__ __forceinline__ float bfhi(unsigned u) { return __uint_as_float(u & 0xffff0000u); }
__device__ __forceinline__ unsigned pkbf(float lo, float hi) { f32x2 v = {lo, hi}; bf16x2_t b = __builtin_convertvector(v, bf16x2_t); return __builtin_bit_cast(unsigned, b); }
__device__ __forceinline__ float dppf(float v, int ctrl_xor1) { return v; }
#define DPPF(v, ctrl) __builtin_bit_cast(float, __builtin_amdgcn_update_dpp(0, __builtin_bit_cast(int, (v)), (ctrl), 0xf, 0xf, false))
__device__ __forceinline__ float swap16_sum(float m) { auto rr = __builtin_amdgcn_permlane16_swap(__float_as_uint(m), __float_as_uint(m), false, false); return __uint_as_float(rr[0]) + __uint_as_float(rr[1]); }
__device__ __forceinline__ float swap32_sum(float m) { auto rr = __builtin_amdgcn_permlane32_swap(__float_as_uint(m), __float_as_uint(m), false, false); return __uint_as_float(rr[0]) + __uint_as_float(rr[1]); }
__device__ __forceinline__ float wave_sum(float v) {
  v += DPPF(v, 0xB1); v += DPPF(v, 0x4E); v += DPPF(v, 0x124); v += DPPF(v, 0x128);
  v = swap16_sum(v); v = swap32_sum(v);
  return v;
}
__device__ __forceinline__ int fresh_tid() { int t = threadIdx.x; asm volatile("" : "+v"(t)); return t; }
typedef const Params __attribute__((address_space(4)))* CParamsPtr;
__device__ __forceinline__ CParamsPtr kargs() { CParamsPtr kp = (CParamsPtr)__builtin_amdgcn_kernarg_segment_ptr(); asm volatile("" : "+s"(kp)); return kp; }
__device__ __forceinline__ float half_swap_max(float m) { auto rr = __builtin_amdgcn_permlane32_swap(__float_as_uint(m), __float_as_uint(m), false, false); return fmaxf(__uint_as_float(rr[0]), __uint_as_float(rr[1])); }
__device__ __forceinline__ float half_swap_sum(float m) { auto rr = __builtin_amdgcn_permlane32_swap(__float_as_uint(m), __float_as_uint(m), false, false); return __uint_as_float(rr[0]) + __uint_as_float(rr[1]); }

__device__ __forceinline__ void transpose_item(const float* W, int K, int N, bf16_t* WT, LAS float* scr, int item, int lane, bool glu) {
  const int nblk = N / 32, kb = item / nblk, nb = item % nblk, k0 = 64 * kb, n0 = 32 * nb;
#pragma unroll 8
  for (int i = 0; i < 32; ++i) { const int kk = 2 * i + (lane >> 5); scr[kk * 33 + (lane & 31)] = W[(size_t)(k0 + kk) * N + n0 + (lane & 31)]; }
  asm volatile("s_waitcnt lgkmcnt(0)" ::: "memory");
  const int c = lane & 7;
#pragma unroll
  for (int j = 0; j < 4; ++j) { const int n = (lane >> 3) + 8 * j; const LAS float* s = scr + (8 * c) * 33 + n;
    u32x4 o; o.x = pkbf(s[0 * 33], s[1 * 33]); o.y = pkbf(s[2 * 33], s[3 * 33]); o.z = pkbf(s[4 * 33], s[5 * 33]); o.w = pkbf(s[6 * 33], s[7 * 33]);
    int nr = n0 + n; if (glu) { const int bj = nr >= 2816 ? 1 : 0, cc = nr - 2816 * bj; nr = 256 * (cc >> 7) + 128 * bj + (cc & 127); }
    *(u32x4*)(WT + (size_t)nr * K + k0 + 8 * c) = o; }
  asm volatile("s_waitcnt lgkmcnt(0)" ::: "memory");
}
__device__ __forceinline__ void transpose_mat(const float* W, int K, int N, bf16_t* WT, LAS float* scr, int gw, int ngw, int lane, bool glu) {
  const int items = (K / 64) * (N / 32);
  for (int it = gw; it < items; it += ngw) transpose_item(W, K, N, WT, scr, it, lane, glu);
}

__device__ __forceinline__ float row_rstd(const f32x4 (&v)[4], float eps) {
  float s = 0.f;
#pragma unroll
  for (int j = 0; j < 4; ++j) s += (v[j].x * v[j].x + v[j].y * v[j].y) + (v[j].z * v[j].z + v[j].w * v[j].w);
  return rsqrtf(wave_sum(s) * (1.f / 1024.f) + eps);
}
__device__ __forceinline__ void store_h_row(bf16_t* hrow, const f32x4 (&v)[4], float rstd, const float* g, int lane) {
#pragma unroll
  for (int j = 0; j < 4; ++j) { const f32x4 gg = *(const f32x4*)(g + 4 * lane + 256 * j);
    u32x2 w; w.x = pkbf(v[j].x * rstd * gg.x, v[j].y * rstd * gg.y); w.y = pkbf(v[j].z * rstd * gg.z, v[j].w * rstd * gg.w);
    *(u32x2*)(hrow + 4 * lane + 256 * j) = w; }
}
__device__ __forceinline__ void phase_init_norm(const float* xp, const float* xs, float* x, bf16_t* H, const float* g, int gw, int ngw, int lane) {
  for (int m = gw; m < M_TOK; m += ngw) {
    const float* src = (m < MH) ? xp + (size_t)m * DM : xs + (size_t)(m - MH) * DM;
    f32x4 v[4];
#pragma unroll
    for (int j = 0; j < 4; ++j) v[j] = *(const f32x4*)(src + 4 * lane + 256 * j);
    store_h_row(H + (size_t)m * DM, v, row_rstd(v, 1e-6f), g, lane);
  }
}
__device__ __forceinline__ void phase_res_norm(const bf16_t* Y, float* x, bf16_t* H, const float* gA, const float* gB, int gw, int ngw, int lane, const float* xp, const float* xs) {
  for (int m = gw; m < M_TOK; m += ngw) {
    bf16_t* xb = (bf16_t*)((char*)x + (size_t)m * 4096 + 2048);
    float y[2][8], v[2][8];
#pragma unroll
    for (int j = 0; j < 2; ++j) { const u32x4 w = *(const u32x4*)(Y + (size_t)m * DM + 8 * lane + 512 * j);
      y[j][0] = bflo(w.x); y[j][1] = bfhi(w.x); y[j][2] = bflo(w.y); y[j][3] = bfhi(w.y); y[j][4] = bflo(w.z); y[j][5] = bfhi(w.z); y[j][6] = bflo(w.w); y[j][7] = bfhi(w.w); }
    if (xp) { const float* xsrc = (m < MH) ? xp + (size_t)m * DM : xs + (size_t)(m - MH) * DM;
#pragma unroll
      for (int j = 0; j < 2; ++j) { const f32x4 a = *(const f32x4*)(xsrc + 8 * lane + 512 * j), c = *(const f32x4*)(xsrc + 8 * lane + 512 * j + 4);
        v[j][0] = a.x; v[j][1] = a.y; v[j][2] = a.z; v[j][3] = a.w; v[j][4] = c.x; v[j][5] = c.y; v[j][6] = c.z; v[j][7] = c.w; }
    } else {
#pragma unroll
      for (int j = 0; j < 2; ++j) { const u32x4 w = *(const u32x4*)(xb + 8 * lane + 512 * j);
        v[j][0] = bflo(w.x); v[j][1] = bfhi(w.x); v[j][2] = bflo(w.y); v[j][3] = bfhi(w.y); v[j][4] = bflo(w.z); v[j][5] = bfhi(w.z); v[j][6] = bflo(w.w); v[j][7] = bfhi(w.w); }
    }
    float sy = 0.f;
#pragma unroll
    for (int j = 0; j < 2; ++j)
#pragma unroll
      for (int e = 0; e < 8; ++e) sy += y[j][e] * y[j][e];
    const float ry = rsqrtf(wave_sum(sy) * (1.f / 1024.f) + 1e-6f);
    float sv = 0.f;
#pragma unroll
    for (int j = 0; j < 2; ++j) { const f32x4 g0 = *(const f32x4*)(gA + 8 * lane + 512 * j), g1 = *(const f32x4*)(gA + 8 * lane + 512 * j + 4);
      const float gg[8] = {g0.x, g0.y, g0.z, g0.w, g1.x, g1.y, g1.z, g1.w};
#pragma unroll
      for (int e = 0; e < 8; ++e) { v[j][e] += y[j][e] * ry * gg[e]; sv += v[j][e] * v[j][e]; } }
    if (gB) {
      const float rx = rsqrtf(wave_sum(sv) * (1.f / 1024.f) + 1e-6f);
#pragma unroll
      for (int j = 0; j < 2; ++j) { const f32x4 g0 = *(const f32x4*)(gB + 8 * lane + 512 * j), g1 = *(const f32x4*)(gB + 8 * lane + 512 * j + 4);
        u32x4 w; w.x = pkbf(v[j][0], v[j][1]); w.y = pkbf(v[j][2], v[j][3]); w.z = pkbf(v[j][4], v[j][5]); w.w = pkbf(v[j][6], v[j][7]);
        *(u32x4*)(xb + 8 * lane + 512 * j) = w;
        u32x4 h; h.x = pkbf(v[j][0] * rx * g0.x, v[j][1] * rx * g0.y); h.y = pkbf(v[j][2] * rx * g0.z, v[j][3] * rx * g0.w); h.z = pkbf(v[j][4] * rx * g1.x, v[j][5] * rx * g1.y); h.w = pkbf(v[j][6] * rx * g1.z, v[j][7] * rx * g1.w);
        *(u32x4*)(H + (size_t)m * DM + 8 * lane + 512 * j) = h; }
    } else {
#pragma unroll
      for (int j = 0; j < 2; ++j) { *(f32x4*)(x + (size_t)m * DM + 8 * lane + 512 * j) = (f32x4){v[j][0], v[j][1], v[j][2], v[j][3]}; *(f32x4*)(x + (size_t)m * DM + 8 * lane + 512 * j + 4) = (f32x4){v[j][4], v[j][5], v[j][6], v[j][7]}; }
    }
  }
}

__device__ __forceinline__ void rope_seg(bf16_t* pp, int pos, float sc, const float* rope, int lane) {
  u32x4 a = *(const u32x4*)pp, b = *(const u32x4*)(pp + 8);
  float x1[8] = {bflo(a.x), bfhi(a.x), bflo(a.y), bfhi(a.y), bflo(a.z), bfhi(a.z), bflo(a.w), bfhi(a.w)};
  float x2[8] = {bflo(b.x), bfhi(b.x), bflo(b.y), bfhi(b.y), bflo(b.z), bfhi(b.z), bflo(b.w), bfhi(b.w)};
  if ((lane & 3) == 0) { const float* cs = rope + (size_t)pos * 16;
#pragma unroll
    for (int i = 0; i < 8; ++i) { const float c = cs[i], s = cs[8 + i]; const float u = x1[i] * c - x2[i] * s, w = x2[i] * c + x1[i] * s; x1[i] = u; x2[i] = w; } }
  a.x = pkbf(x1[0] * sc, x1[1] * sc); a.y = pkbf(x1[2] * sc, x1[3] * sc); a.z = pkbf(x1[4] * sc, x1[5] * sc); a.w = pkbf(x1[6] * sc, x1[7] * sc);
  b.x = pkbf(x2[0] * sc, x2[1] * sc); b.y = pkbf(x2[2] * sc, x2[3] * sc); b.z = pkbf(x2[4] * sc, x2[5] * sc); b.w = pkbf(x2[6] * sc, x2[7] * sc);
  *(u32x4*)pp = a; *(u32x4*)(pp + 8) = b;
}

__device__ __forceinline__ s16x4 vtr(ldsp p) { typedef short v4i16_t __attribute__((ext_vector_type(4))); return __builtin_bit_cast(s16x4, __builtin_amdgcn_ds_read_tr16_b64_v4i16((LAS v4i16_t*)p)); }
__device__ __forceinline__ int voffa(int row, int ch) { return 2048 * (row >> 3) + 512 * (ch >> 2) + 64 * (row & 7) + 16 * ((ch & 3) ^ ((row >> 2) & 3)); }
__device__ __forceinline__ int koff(int row, int ch) { return 128 * row + ((ch ^ ((row >> 1) & 7)) << 4); }
__device__ __forceinline__ f32x16 qk_block(ldsp Kt, const int (&ko)[4], const bf16x8 (&qf)[4]) {
  f32x16 acc = {0.f, 0.f, 0.f, 0.f, 0.f, 0.f, 0.f, 0.f, 0.f, 0.f, 0.f, 0.f, 0.f, 0.f, 0.f, 0.f};
#pragma unroll
  for (int ds = 0; ds < 4; ++ds) { const bf16x8 kf = *(const LAS bf16x8*)(Kt + ko[ds]); acc = __builtin_amdgcn_mfma_f32_32x32x16_bf16(kf, qf[ds], acc, 0, 0, 0); }
  return acc;
}
__device__ __forceinline__ void k_load(bf16x8 (&kf)[4], ldsp Kt, const int (&ko)[4]) {
#pragma unroll
  for (int ds = 0; ds < 4; ++ds) kf[ds] = *(const LAS bf16x8*)(Kt + ko[ds]);
}
__device__ __forceinline__ f32x16 qk_frag(const bf16x8 (&kf)[4], const bf16x8 (&qf)[4]) {
  f32x16 acc = {0.f, 0.f, 0.f, 0.f, 0.f, 0.f, 0.f, 0.f, 0.f, 0.f, 0.f, 0.f, 0.f, 0.f, 0.f, 0.f};
#pragma unroll
  for (int ds = 0; ds < 4; ++ds) acc = __builtin_amdgcn_mfma_f32_32x32x16_bf16(kf[ds], qf[ds], acc, 0, 0, 0);
  return acc;
}
constexpr float BIGSUM = 1.0995116e12f;
template <int NDB> __device__ __forceinline__ void softmax_block(f32x16& s, float& m, float& l, f32x16 (&o)[NDB], bf16x8 (&p)[2]) {
  if (__all(m == 0.f)) {
#pragma unroll
    for (int r = 0; r < 16; ++r) s[r] = __builtin_amdgcn_exp2f(s[r]);
  } else {
#pragma unroll
    for (int r = 0; r < 16; ++r) s[r] = __builtin_amdgcn_exp2f(s[r] - m);
  }
  float sum = 0.f;
#pragma unroll
  for (int r = 0; r < 16; ++r) sum += s[r];
  const float tot = half_swap_sum(sum);
  if (__any(!(tot <= BIGSUM))) {
    float mx = s[0];
#pragma unroll
    for (int r = 1; r < 16; ++r) mx = fmaxf(mx, s[r]);
    mx = half_swap_max(mx);
    const float dl = (tot <= BIGSUM) ? 0.f : __log2f(fminf(mx, 3.0e38f)); m += dl;
    const float f = __builtin_amdgcn_exp2f(-dl); l *= f; sum *= f;
#pragma unroll
    for (int r = 0; r < 16; ++r) s[r] *= f;
#pragma unroll
    for (int d = 0; d < NDB; ++d)
#pragma unroll
      for (int r = 0; r < 16; ++r) o[d][r] *= f;
  }
  l += sum;
  u32x4 w0, w1;
  w0.x = pkbf(s[0], s[1]); w0.y = pkbf(s[2], s[3]); w0.z = pkbf(s[4], s[5]); w0.w = pkbf(s[6], s[7]);
  w1.x = pkbf(s[8], s[9]); w1.y = pkbf(s[10], s[11]); w1.z = pkbf(s[12], s[13]); w1.w = pkbf(s[14], s[15]);
  p[0] = __builtin_bit_cast(bf16x8, w0); p[1] = __builtin_bit_cast(bf16x8, w1);
}
template <int DV, bool TWO> __device__ __forceinline__ void pv_block(ldsp Vt, int vb0, int vb1, const bf16x8 (&p0)[2], const bf16x8 (&p1)[2], f32x16 (&o0)[DV / 32], f32x16 (&o1)[DV / 32]) {
  constexpr int NDB = DV / 32, NST = 2 * NDB;
#define PV_I0(i) ((DV == 128) ? 2048 * (2 * ((i) / NDB)) + 512 * ((i) % NDB) : 128 * (16 * ((i) / NDB)) + 64 * ((i) % NDB))
#define PV_I1(i) ((DV == 128) ? 2048 * (2 * ((i) / NDB) + 1) + 512 * ((i) % NDB) : 128 * (16 * ((i) / NDB) + 8) + 64 * ((i) % NDB))
#define PV_RD(dl, dh, i) do { asm volatile("ds_read_b64_tr_b16 %0, %1 offset:%c2" : "=&v"(dl) : "v"(a0), "i"(PV_I0(i)) : "memory"); \
                              asm volatile("ds_read_b64_tr_b16 %0, %1 offset:%c2" : "=&v"(dh) : "v"(a1), "i"(PV_I1(i)) : "memory"); } while (0)
  const unsigned a0 = (unsigned)(unsigned long)(Vt + vb0), a1 = (unsigned)(unsigned long)(Vt + vb1);
  s16x4 lo[2], hh[2];
  PV_RD(lo[0], hh[0], 0);
#pragma unroll
  for (int i = 0; i < NST; ++i) {
    if (i + 1 < NST) { PV_RD(lo[(i + 1) & 1], hh[(i + 1) & 1], i + 1); asm volatile("s_waitcnt lgkmcnt(2)" ::: "memory"); }
    else asm volatile("s_waitcnt lgkmcnt(0)" ::: "memory");
    __builtin_amdgcn_sched_barrier(0);
    const s16x4 l_ = lo[i & 1], h_ = hh[i & 1];
    const bf16x8 a = {l_[0], l_[1], l_[2], l_[3], h_[0], h_[1], h_[2], h_[3]};
    const int s = i / NDB, db = i % NDB;
    o0[db] = __builtin_amdgcn_mfma_f32_32x32x16_bf16(a, p0[s], o0[db], 0, 0, 0);
    if (TWO) o1[db] = __builtin_amdgcn_mfma_f32_32x32x16_bf16(a, p1[s], o1[db], 0, 0, 0);
    __builtin_amdgcn_sched_barrier(0);
  }
#undef PV_I0
#undef PV_I1
#undef PV_RD
}

__device__ __forceinline__ void sm_pv(f32x16& s, float& m, float& l, f32x16 (&oself)[4], bf16x8 (&pout)[2], ldsp Vt, int vb0, int vb1, const bf16x8 (&pin)[2], f32x16 (&oacc)[4]) {
  if (!__all(m == 0.f)) {
#pragma unroll
    for (int r = 0; r < 16; ++r) s[r] -= m;
  }
#define SP_I0(i) (2048 * (2 * ((i) / 4)) + 512 * ((i) % 4))
#define SP_I1(i) (2048 * (2 * ((i) / 4) + 1) + 512 * ((i) % 4))
#define SP_RD(dl, dh, i) do { asm volatile("ds_read_b64_tr_b16 %0, %1 offset:%c2" : "=&v"(dl) : "v"(a0), "i"(SP_I0(i)) : "memory"); \
                              asm volatile("ds_read_b64_tr_b16 %0, %1 offset:%c2" : "=&v"(dh) : "v"(a1), "i"(SP_I1(i)) : "memory"); } while (0)
  const unsigned a0 = (unsigned)(unsigned long)(Vt + vb0), a1 = (unsigned)(unsigned long)(Vt + vb1);
  s16x4 lo[2], hh[2];
  SP_RD(lo[0], hh[0], 0);
#pragma unroll
  for (int i = 0; i < 8; ++i) {
    if (i + 1 < 8) { SP_RD(lo[(i + 1) & 1], hh[(i + 1) & 1], i + 1); asm volatile("s_waitcnt lgkmcnt(2)" ::: "memory"); }
    else asm volatile("s_waitcnt lgkmcnt(0)" ::: "memory");
    __builtin_amdgcn_sched_barrier(0);
    const s16x4 l_ = lo[i & 1], h_ = hh[i & 1];
    const bf16x8 a = {l_[0], l_[1], l_[2], l_[3], h_[0], h_[1], h_[2], h_[3]};
    oacc[i % 4] = __builtin_amdgcn_mfma_f32_32x32x16_bf16(a, pin[i / 4], oacc[i % 4], 0, 0, 0);
    s[2 * i] = __builtin_amdgcn_exp2f(s[2 * i]); s[2 * i + 1] = __builtin_amdgcn_exp2f(s[2 * i + 1]);
    __builtin_amdgcn_sched_barrier(0);
  }
#undef SP_I0
#undef SP_I1
#undef SP_RD
  float sum = 0.f;
#pragma unroll
  for (int r = 0; r < 16; ++r) sum += s[r];
  const float tot = half_swap_sum(sum);
  if (__any(!(tot <= BIGSUM))) {
    float mx = s[0];
#pragma unroll
    for (int r = 1; r < 16; ++r) mx = fmaxf(mx, s[r]);
    mx = half_swap_max(mx);
    const float dl = (tot <= BIGSUM) ? 0.f : __log2f(fminf(mx, 3.0e38f)); m += dl;
    const float f = __builtin_amdgcn_exp2f(-dl); l *= f; sum *= f;
#pragma unroll
    for (int r = 0; r < 16; ++r) s[r] *= f;
#pragma unroll
    for (int d = 0; d < 4; ++d)
#pragma unroll
      for (int r = 0; r < 16; ++r) oself[d][r] *= f;
  }
  l += sum;
  u32x4 w0, w1;
  w0.x = pkbf(s[0], s[1]); w0.y = pkbf(s[2], s[3]); w0.z = pkbf(s[4], s[5]); w0.w = pkbf(s[6], s[7]);
  w1.x = pkbf(s[8], s[9]); w1.y = pkbf(s[10], s[11]); w1.z = pkbf(s[12], s[13]); w1.w = pkbf(s[14], s[15]);
  pout[0] = __builtin_bit_cast(bf16x8, w0); pout[1] = __builtin_bit_cast(bf16x8, w1);
}

__device__ __forceinline__ void sm_finish(f32x16& s, float& m, float& l, f32x16 (&oself)[4], bf16x8 (&pout)[2]) {
  float sum = 0.f;
#pragma unroll
  for (int r = 0; r < 16; ++r) sum += s[r];
  const float tot = half_swap_sum(sum);
  if (__any(!(tot <= BIGSUM))) {
    float mx = s[0];
#pragma unroll
    for (int r = 1; r < 16; ++r) mx = fmaxf(mx, s[r]);
    mx = half_swap_max(mx);
    const float dl = (tot <= BIGSUM) ? 0.f : __log2f(fminf(mx, 3.0e38f)); m += dl;
    const float f = __builtin_amdgcn_exp2f(-dl); l *= f; sum *= f;
#pragma unroll
    for (int r = 0; r < 16; ++r) s[r] *= f;
#pragma unroll
    for (int d = 0; d < 4; ++d)
#pragma unroll
      for (int r = 0; r < 16; ++r) oself[d][r] *= f;
  }
  l += sum;
  u32x4 w0, w1;
  w0.x = pkbf(s[0], s[1]); w0.y = pkbf(s[2], s[3]); w0.z = pkbf(s[4], s[5]); w0.w = pkbf(s[6], s[7]);
  w1.x = pkbf(s[8], s[9]); w1.y = pkbf(s[10], s[11]); w1.z = pkbf(s[12], s[13]); w1.w = pkbf(s[14], s[15]);
  pout[0] = __builtin_bit_cast(bf16x8, w0); pout[1] = __builtin_bit_cast(bf16x8, w1);
}
__device__ __forceinline__ void pv2_sm2(f32x16& s0, f32x16& s1, float m0, float m1, ldsp Vt, int vb0, int vb1, const bf16x8 (&p0)[2], const bf16x8 (&p1)[2], f32x16 (&o0)[4], f32x16 (&o1)[4]) {
  if (!__all((m0 == 0.f) && (m1 == 0.f))) {
#pragma unroll
    for (int r = 0; r < 16; ++r) { s0[r] -= m0; s1[r] -= m1; }
  }
#define SP_I0(i) (2048 * (2 * ((i) / 4)) + 512 * ((i) % 4))
#define SP_I1(i) (2048 * (2 * ((i) / 4) + 1) + 512 * ((i) % 4))
#define SP_RD(dl, dh, i) do { asm volatile("ds_read_b64_tr_b16 %0, %1 offset:%c2" : "=&v"(dl) : "v"(a0), "i"(SP_I0(i)) : "memory"); \
                              asm volatile("ds_read_b64_tr_b16 %0, %1 offset:%c2" : "=&v"(dh) : "v"(a1), "i"(SP_I1(i)) : "memory"); } while (0)
  const unsigned a0 = (unsigned)(unsigned long)(Vt + vb0), a1 = (unsigned)(unsigned long)(Vt + vb1);
  s16x4 lo[2], hh[2];
  SP_RD(lo[0], hh[0], 0);
#pragma unroll
  for (int i = 0; i < 8; ++i) {
    if (i + 1 < 8) { SP_RD(lo[(i + 1) & 1], hh[(i + 1) & 1], i + 1); asm volatile("s_waitcnt lgkmcnt(2)" ::: "memory"); }
    else asm volatile("s_waitcnt lgkmcnt(0)" ::: "memory");
    __builtin_amdgcn_sched_barrier(0);
    const s16x4 l_ = lo[i & 1], h_ = hh[i & 1];
    const bf16x8 a = {l_[0], l_[1], l_[2], l_[3], h_[0], h_[1], h_[2], h_[3]};
    o0[i % 4] = __builtin_amdgcn_mfma_f32_32x32x16_bf16(a, p0[i / 4], o0[i % 4], 0, 0, 0);
    s0[2 * i] = __builtin_amdgcn_exp2f(s0[2 * i]); s0[2 * i + 1] = __builtin_amdgcn_exp2f(s0[2 * i + 1]);
    __builtin_amdgcn_sched_barrier(0);
    o1[i % 4] = __builtin_amdgcn_mfma_f32_32x32x16_bf16(a, p1[i / 4], o1[i % 4], 0, 0, 0);
    s1[2 * i] = __builtin_amdgcn_exp2f(s1[2 * i]); s1[2 * i + 1] = __builtin_amdgcn_exp2f(s1[2 * i + 1]);
    __builtin_amdgcn_sched_barrier(0);
  }
#undef SP_I0
#undef SP_I1
#undef SP_RD
}

__device__ __forceinline__ void pv2_sm2p(f32x16& s0, f32x16& s1, float& m0, float& l0, float& m1, float& l1, ldsp Vt, int vb0, int vb1,
                                         const bf16x8 (&p0)[2], const bf16x8 (&p1)[2], f32x16 (&o0)[4], f32x16 (&o1)[4], bf16x8 (&q0)[2], bf16x8 (&q1)[2]) {
  if (!__all((m0 == 0.f) && (m1 == 0.f))) {
#pragma unroll
    for (int r = 0; r < 16; ++r) { s0[r] -= m0; s1[r] -= m1; }
  }
#define SP_I0(i) (2048 * (2 * ((i) / 4)) + 512 * ((i) % 4))
#define SP_I1(i) (2048 * (2 * ((i) / 4) + 1) + 512 * ((i) % 4))
#define SP_RD(dl, dh, i) do { asm volatile("ds_read_b64_tr_b16 %0, %1 offset:%c2" : "=&v"(dl) : "v"(a0), "i"(SP_I0(i)) : "memory"); \
                              asm volatile("ds_read_b64_tr_b16 %0, %1 offset:%c2" : "=&v"(dh) : "v"(a1), "i"(SP_I1(i)) : "memory"); } while (0)
  const unsigned a0 = (unsigned)(unsigned long)(Vt + vb0), a1 = (unsigned)(unsigned long)(Vt + vb1);
  s16x4 lo[2], hh[2];
  unsigned w0[8], w1[8];
  float sum0 = 0.f, sum1 = 0.f;
  SP_RD(lo[0], hh[0], 0);
#pragma unroll
  for (int i = 0; i < 8; ++i) {
    if (i + 1 < 8) { SP_RD(lo[(i + 1) & 1], hh[(i + 1) & 1], i + 1); asm volatile("s_waitcnt lgkmcnt(2)" ::: "memory"); }
    else asm volatile("s_waitcnt lgkmcnt(0)" ::: "memory");
    __builtin_amdgcn_sched_barrier(0);
    const s16x4 l_ = lo[i & 1], h_ = hh[i & 1];
    const bf16x8 a = {l_[0], l_[1], l_[2], l_[3], h_[0], h_[1], h_[2], h_[3]};
    o0[i % 4] = __builtin_amdgcn_mfma_f32_32x32x16_bf16(a, p0[i / 4], o0[i % 4], 0, 0, 0);
    { const float e0 = __builtin_amdgcn_exp2f(s0[2 * i]), e1 = __builtin_amdgcn_exp2f(s0[2 * i + 1]); sum0 += e0; sum0 += e1; w0[i] = pkbf(e0, e1); }
    __builtin_amdgcn_sched_barrier(0);
    o1[i % 4] = __builtin_amdgcn_mfma_f32_32x32x16_bf16(a, p1[i / 4], o1[i % 4], 0, 0, 0);
    { const float e0 = __builtin_amdgcn_exp2f(s1[2 * i]), e1 = __builtin_amdgcn_exp2f(s1[2 * i + 1]); sum1 += e0; sum1 += e1; w1[i] = pkbf(e0, e1); }
    __builtin_amdgcn_sched_barrier(0);
  }
#undef SP_I0
#undef SP_I1
#undef SP_RD
  const float tot0 = half_swap_sum(sum0), tot1 = half_swap_sum(sum1);
  if (__any(!(tot0 <= BIGSUM) || !(tot1 <= BIGSUM))) {
    float mx0 = 0.f, mx1 = 0.f;
#pragma unroll
    for (int i = 0; i < 8; ++i) { mx0 = fmaxf(mx0, fmaxf(bflo(w0[i]), bfhi(w0[i]))); mx1 = fmaxf(mx1, fmaxf(bflo(w1[i]), bfhi(w1[i]))); }
    mx0 = half_swap_max(mx0); mx1 = half_swap_max(mx1);
    const float d0 = (tot0 <= BIGSUM) ? 0.f : __log2f(fminf(mx0, 3.0e38f)), d1 = (tot1 <= BIGSUM) ? 0.f : __log2f(fminf(mx1, 3.0e38f));
    m0 += d0; m1 += d1;
    const float f0 = __builtin_amdgcn_exp2f(-d0), f1 = __builtin_amdgcn_exp2f(-d1); l0 *= f0; l1 *= f1; sum0 *= f0; sum1 *= f1;
#pragma unroll
    for (int i = 0; i < 8; ++i) { w0[i] = pkbf(bflo(w0[i]) * f0, bfhi(w0[i]) * f0); w1[i] = pkbf(bflo(w1[i]) * f1, bfhi(w1[i]) * f1); }
#pragma unroll
    for (int d = 0; d < 4; ++d)
#pragma unroll
      for (int r = 0; r < 16; ++r) { o0[d][r] *= f0; o1[d][r] *= f1; }
  }
  l0 += sum0; l1 += sum1;
  q0[0] = __builtin_bit_cast(bf16x8, (u32x4){w0[0], w0[1], w0[2], w0[3]}); q0[1] = __builtin_bit_cast(bf16x8, (u32x4){w0[4], w0[5], w0[6], w0[7]});
  q1[0] = __builtin_bit_cast(bf16x8, (u32x4){w1[0], w1[1], w1[2], w1[3]}); q1[1] = __builtin_bit_cast(bf16x8, (u32x4){w1[4], w1[5], w1[6], w1[7]});
}

__device__ __forceinline__ void diff_unit(ldsp lds, const bf16_t* Q, const bf16_t* K, const bf16_t* V, bf16_t* O, int tok0, int S, int h, int qb, float lam, float osc, const float* subg) {
  const int tid = fresh_tid(), lane = tid & 63, wid = tid >> 6, r32 = lane & 31, hi = lane >> 5;
  const int NT = S / 64;
  const bf16_t* kbase = K + (size_t)tok0 * DM + 128 * h; const bf16_t* vbase = V + (size_t)tok0 * DM + 128 * h;
#define DIFF_DMA(t, bo) do { const int ln_ = fresh_tid() & 63, wv_ = __builtin_amdgcn_readfirstlane(fresh_tid() >> 6); \
    { const int row_ = 8 * wv_ + (ln_ >> 3), ch_ = (ln_ & 7) ^ ((row_ >> 1) & 7); const bf16_t* g_ = kbase + (size_t)((t) * 64 + row_) * DM + 8 * ch_; \
      __builtin_amdgcn_global_load_lds((const unsigned*)g_, (LAS unsigned*)(lds + (bo) + 1024 * wv_), 16, 0, 0); \
      __builtin_amdgcn_global_load_lds((const unsigned*)(g_ + 64), (LAS unsigned*)(lds + (bo) + 8192 + 1024 * wv_), 16, 0, 0); } \
    _Pragma("unroll") for (int hq_ = 0; hq_ < 2; ++hq_) { const int o_ = 1024 * hq_ + 16 * ln_, row_ = 8 * wv_ + ((o_ >> 6) & 7), ch_ = 4 * (o_ >> 9) + (((o_ >> 4) & 3) ^ ((row_ >> 2) & 3)); \
      __builtin_amdgcn_global_load_lds((const unsigned*)(vbase + (size_t)((t) * 64 + row_) * DM + 8 * ch_), (LAS unsigned*)(lds + (bo) + 16384 + 2048 * wv_ + 1024 * hq_), 16, 0, 0); } } while (0)
  DIFF_DMA(0, 0);
  const size_t qrow = (size_t)(tok0 + 256 * qb + 32 * wid + r32) * DM;
  bf16x8 q0[4], q1[4];
#pragma unroll
  for (int ds = 0; ds < 4; ++ds) { q0[ds] = *(const bf16x8*)(Q + qrow + (2 * h) * 64 + 16 * ds + 8 * hi); q1[ds] = *(const bf16x8*)(Q + qrow + (2 * h + 1) * 64 + 16 * ds + 8 * hi); }
  f32x16 o0[4], o1[4];
#pragma unroll
  for (int d = 0; d < 4; ++d)
#pragma unroll
    for (int r = 0; r < 16; ++r) { o0[d][r] = 0.f; o1[d][r] = 0.f; }
  float m0 = 0.f, l0 = 0.f, m1 = 0.f, l1 = 0.f;
  int ko[4];
#pragma unroll
  for (int ds = 0; ds < 4; ++ds) ko[ds] = 128 * r32 + (((2 * ds + hi) ^ ((r32 >> 1) & 7)) << 4);
  const int q4 = (lane & 15) >> 2, p4 = lane & 3, gi = (lane >> 4) & 1;
  int vb0 = 64 * (4 * hi + q4) + 16 * ((2 * gi + (p4 >> 1)) ^ hi) + 8 * (p4 & 1);
  int vb1 = 64 * (4 * hi + q4) + 16 * ((2 * gi + (p4 >> 1)) ^ (2 + hi)) + 8 * (p4 & 1);
  __syncthreads();
  bf16x8 pa[2], pb[2];
  pb[0] = (bf16x8){0, 0, 0, 0, 0, 0, 0, 0}; pb[1] = pb[0]; pa[0] = pb[0]; pa[1] = pb[0];
  int bcur = 0, bnext = 32768;
  ldsp prevV = lds + 16384;
#pragma unroll 1
  for (int t = 0; t < NT; ++t) {
    asm volatile("" : "+v"(ko[0]), "+v"(ko[1]), "+v"(ko[2]), "+v"(ko[3]), "+v"(vb0), "+v"(vb1));
    if (t + 1 < NT) DIFF_DMA(t + 1, bnext);
    ldsp base = lds + bcur;
    {
      f32x16 sc0 = qk_block(base, ko, q0);
      __builtin_amdgcn_sched_barrier(0);
      f32x16 sc1 = qk_block(base + 8192, ko, q1);
      __builtin_amdgcn_sched_barrier(0);
      bf16x8 pc[2], pd[2];
      pv2_sm2p(sc0, sc1, m0, l0, m1, l1, prevV, vb0, vb1, pa, pb, o0, o1, pc, pd);
      sc0 = qk_block(base + 4096, ko, q0);
      __builtin_amdgcn_sched_barrier(0);
      sc1 = qk_block(base + 8192 + 4096, ko, q1);
      __builtin_amdgcn_sched_barrier(0);
      pv2_sm2p(sc0, sc1, m0, l0, m1, l1, base + 16384, vb0, vb1, pc, pd, o0, o1, pa, pb);
      prevV = base + 16384 + 8192;
    }
    __syncthreads();
    bcur = bnext; bnext = (bnext == 65536) ? 0 : bnext + 32768;
  }
  pv_block<128, true>(prevV, vb0, vb1, pa, pb, o0, o1);
  __syncthreads();
#undef DIFF_DMA
  l0 = half_swap_sum(l0); l1 = half_swap_sum(l1);
  const float i0 = 1.f / l0, i1 = lam / l1;
  float ssq = 0.f;
#pragma unroll
  for (int d = 0; d < 4; ++d)
#pragma unroll
    for (int r = 0; r < 16; ++r) { const float v = o0[d][r] * i0 - o1[d][r] * i1; o0[d][r] = v; ssq += v * v; }
  ssq = half_swap_sum(ssq);
  const float rs = rsqrtf(ssq * (1.f / 128.f) + 1e-5f) * osc;
  bf16_t* orow = O + (size_t)(tok0 + 256 * qb + 32 * (fresh_tid() >> 6) + (fresh_tid() & 31)) * DM + 128 * h;
#pragma unroll
  for (int d = 0; d < 4; ++d)
#pragma unroll
    for (int g4 = 0; g4 < 4; ++g4) { const int dd = 32 * d + 8 * g4 + 4 * hi; const f32x4 gg = *(const f32x4*)(subg + dd);
      u32x2 w; w.x = pkbf(o0[d][4 * g4] * rs * gg.x, o0[d][4 * g4 + 1] * rs * gg.y); w.y = pkbf(o0[d][4 * g4 + 2] * rs * gg.z, o0[d][4 * g4 + 3] * rs * gg.w);
      *(u32x2*)(orow + dd) = w; }
}
__device__ __forceinline__ void phase_diff_attn(ldsp lds, const bf16_t* Q, const bf16_t* K, const bf16_t* V, bf16_t* O, const float* lamv, const float* subg, float lam_init, float osc_l) {
  const int lane = fresh_tid() & 63;
  const float t0 = wave_sum(lamv[lane] * lamv[64 + lane]), t1 = wave_sum(lamv[128 + lane] * lamv[192 + lane]);
  const float lam = __expf(t0) - __expf(t1) + lam_init;
  const int G = gridDim.x, bx = blockIdx.x;
  const bool xmap = (G == 256); const int x = bx & 7, c = bx >> 3;
  const int nu = xmap ? 8 : (2048 - bx + G - 1) / G;
#pragma unroll 1
  for (int i = 0; i < nu; ++i) {
    int bh, qb, S, tok0;
    if (xmap) { if (i < 4) { bh = 4 * x + i; qb = c; S = 8192; tok0 = (bh >> 3) * 8192; } else { bh = 8 * x + 2 * (i - 4) + (c >> 4); qb = c & 15; S = 4096; tok0 = MH + (bh >> 3) * 4096; } }
    else { const int u = bx + i * G; if (u < 1024) { bh = u >> 5; qb = u & 31; S = 8192; tok0 = (bh >> 3) * 8192; } else { const int v = u - 1024; bh = v >> 4; qb = v & 15; S = 4096; tok0 = MH + (bh >> 3) * 4096; } }
    diff_unit(lds, Q, K, V, O, tok0, S, bh & 7, qb, lam, osc_l, subg);
  }
}

__device__ __forceinline__ void dil_unit(ldsp lds, bf16_t* QKV, float* LSE, int half, int u) {
  const int tid = fresh_tid(), lane = tid & 63, wid = tid >> 6, r32 = lane & 31, hi = lane >> 5;
  const int g = u / 2048, rem = u % 2048, head = rem & 15, blk = rem >> 4;
  const int S = half ? 4096 : 8192, nbs = S / 256, seq = blk / nbs, wi = blk % nbs;
  const int dsh = 2 * g, dil = 1 << dsh, L = S >> dsh, nq = L / 256, r = wi / nq, qb = wi % nq, m0 = 256 * qb;
  const int seqrow = seq * S;
  const int colq = g * 3072 + head * 64, colk = colq + 1024, colv = colq + 2048;
  ldsp Kt = lds, Vt = lds + 49152;
#pragma unroll
  for (int i = 0; i < 6; ++i) { const int idx = tid + 512 * i, j = idx >> 3, ch = idx & 7, mk = m0 - 64 + j;
    u32x4 kv = {0u, 0u, 0u, 0u}, vv = {0u, 0u, 0u, 0u};
    if (mk >= 0 && mk < L) { const size_t rowo = (size_t)(seqrow + mk * dil + r) * 9216; kv = *(const u32x4*)(QKV + rowo + colk + 8 * ch); vv = *(const u32x4*)(QKV + rowo + colv + 8 * ch); }
    *(LAS u32x4*)(Kt + koff(j, ch)) = kv; *(LAS u32x4*)(Vt + 128 * j + 16 * ch) = vv; }
  const int mq = m0 + 32 * wid + r32; const size_t qrowo = (size_t)(seqrow + mq * dil + r) * 9216 + colq;
  bf16x8 qf[4];
#pragma unroll
  for (int ds = 0; ds < 4; ++ds) qf[ds] = *(const bf16x8*)(QKV + qrowo + 16 * ds + 8 * hi);
  f32x16 o[2];
#pragma unroll
  for (int d = 0; d < 2; ++d)
#pragma unroll
    for (int rr = 0; rr < 16; ++rr) o[d][rr] = 0.f;
  float m = 0.f, l = 0.f;
  int ko[4];
#pragma unroll
  for (int ds = 0; ds < 4; ++ds) ko[ds] = 128 * r32 + (((2 * ds + hi) ^ ((r32 >> 1) & 7)) << 4);
  const int q4 = (lane & 15) >> 2, p4 = lane & 3, gi = (lane >> 4) & 1;
  const int vb = 128 * (4 * hi + q4) + 32 * gi + 8 * p4;
  __syncthreads();
#pragma unroll 1
  for (int b = 0; b < 5; ++b) {
    const int kr0 = 32 * wid + 32 * b;
    f32x16 s = qk_block(Kt + 128 * kr0, ko, qf);
#pragma unroll
    for (int rr = 0; rr < 16; ++rr) { const int kvr = (rr & 3) + 8 * (rr >> 2) + 4 * hi; const int mk = m0 - 64 + kr0 + kvr; const int dlt = mk - mq;
      const bool ok = (dlt >= -64) && (dlt <= 64) && (mk >= 0) && (mk < L); s[rr] = ok ? s[rr] : -INFINITY; }
    bf16x8 p[2];
    softmax_block<2>(s, m, l, o, p);
    pv_block<64, false>(Vt + 128 * kr0, vb, vb, p, p, o, o);
  }
  l = half_swap_sum(l);
  const float il = 1.f / l;
  bf16_t* orow = QKV + qrowo;
#pragma unroll
  for (int d = 0; d < 2; ++d)
#pragma unroll
    for (int g4 = 0; g4 < 4; ++g4) { const int dd = 32 * d + 8 * g4 + 4 * hi;
      u32x2 w; w.x = pkbf(o[d][4 * g4] * il, o[d][4 * g4 + 1] * il); w.y = pkbf(o[d][4 * g4 + 2] * il, o[d][4 * g4 + 3] * il);
      *(u32x2*)(orow + dd) = w; }
  if (hi == 0) LSE[((size_t)g * MH + (seqrow + mq * dil + r)) * 16 + head] = m + __log2f(l);
  __syncthreads();
}
__device__ __forceinline__ void phase_dil_combine(const bf16_t* QKV, const float* LSE, bf16_t* O  , int gw, int ngw, int lane) {
  for (int t = gw; t < MH; t += ngw) {
    const int head = lane >> 2, d0 = 16 * (lane & 3);
    float ls[3], mx = -INFINITY;
#pragma unroll
    for (int g = 0; g < 3; ++g) { ls[g] = LSE[((size_t)g * MH + t) * 16 + head]; mx = fmaxf(mx, ls[g]); }
    float w[3], ws = 0.f;
#pragma unroll
    for (int g = 0; g < 3; ++g) { w[g] = __builtin_amdgcn_exp2f(ls[g] - mx); ws += w[g]; }
    const float iw = 1.f / ws; float acc[16];
#pragma unroll
    for (int i = 0; i < 16; ++i) acc[i] = 0.f;
#pragma unroll
    for (int g = 0; g < 3; ++g) { const bf16_t* p = QKV + (size_t)t * 9216 + g * 3072 + head * 64 + d0; const u32x4 a = *(const u32x4*)p, b = *(const u32x4*)(p + 8); const float wg = w[g] * iw;
      acc[0] += wg * bflo(a.x); acc[1] += wg * bfhi(a.x); acc[2] += wg * bflo(a.y); acc[3] += wg * bfhi(a.y); acc[4] += wg * bflo(a.z); acc[5] += wg * bfhi(a.z); acc[6] += wg * bflo(a.w); acc[7] += wg * bfhi(a.w);
      acc[8] += wg * bflo(b.x); acc[9] += wg * bfhi(b.x); acc[10] += wg * bflo(b.y); acc[11] += wg * bfhi(b.y); acc[12] += wg * bflo(b.z); acc[13] += wg * bfhi(b.z); acc[14] += wg * bflo(b.w); acc[15] += wg * bfhi(b.w); }
    u32x4 a, b; a.x = pkbf(acc[0], acc[1]); a.y = pkbf(acc[2], acc[3]); a.z = pkbf(acc[4], acc[5]); a.w = pkbf(acc[6], acc[7]);
    b.x = pkbf(acc[8], acc[9]); b.y = pkbf(acc[10], acc[11]); b.z = pkbf(acc[12], acc[13]); b.w = pkbf(acc[14], acc[15]);
    bf16_t* op = O + (size_t)t * DM + head * 64 + d0; *(u32x4*)op = a; *(u32x4*)(op + 8) = b;
  }
}

__device__ __forceinline__ void phase_hgrn_gates(bf16_t* QF, int gt, int ngt) {
  const size_t total = (size_t)M_TOK * 384;
  for (size_t it = gt; it < total; it += ngt) {
    const int row = (int)(it / 384), c8 = (int)(it % 384); bf16_t* p = QF + (size_t)row * 5120 + 8 * c8; const bool isq = c8 < 128;
    u32x4 a = *(const u32x4*)p; float v[8] = {bflo(a.x), bfhi(a.x), bflo(a.y), bfhi(a.y), bflo(a.z), bfhi(a.z), bflo(a.w), bfhi(a.w)};
#pragma unroll
    for (int i = 0; i < 8; ++i) { const float z = v[i]; v[i] = isq ? z / (1.f + __expf(-z)) * 0.08838834764831845f : 1.f / (1.f + __expf(z)); }
    a.x = pkbf(v[0], v[1]); a.y = pkbf(v[2], v[3]); a.z = pkbf(v[4], v[5]); a.w = pkbf(v[6], v[7]); *(u32x4*)p = a;
  }
}
__device__ __forceinline__ int rowimg(int row, int ch) { return 256 * row + ((ch ^ (row & 15)) << 4); }
__device__ __forceinline__ void hgrn_chain(ldsp lds, const bf16_t* QF, bf16_t* Ofw, bf16_t* Obw, const float* oml, int c) {
  const int tid = fresh_tid(), lane = tid & 63, wid = tid >> 6, r32 = lane & 31, hi = lane >> 5;
  const int dir = c & 1, head = (c >> 1) & 7, sq = c >> 4;
  const int T = (sq < 4) ? 8192 : 4096, NC = T / 64; const int seqrow = (sq < 4) ? sq * 8192 : MH + (sq - 4) * 4096;
  bf16_t* Od = dir ? Obw : Ofw;
  constexpr int RAWQ = 0, RAWS = 16384, IMG_V = 32768, IMG_QT = 49152, IMG_KT = 65536, IMG_KH = 81920, OUTB = 98304, TOT = 114688, DEC = 118784;
  const int vblk = wid & 3, tblk = wid >> 2;
  const int kp = tid & 63, e8 = tid >> 6;
  const float om0 = oml[head * 128 + 2 * kp], om1 = oml[head * 128 + 2 * kp + 1];
  f32x16 Sacc[4];
#pragma unroll
  for (int kb = 0; kb < 4; ++kb)
#pragma unroll
    for (int r = 0; r < 16; ++r) Sacc[kb][r] = 0.f;
  const int lrow = tid >> 4, c16 = tid & 15;
  const int qcol = head * 128 + 8 * c16, fcol = 1024 + dir * 1024 + head * 128 + 8 * c16, vcol = 3072 + head * 128 + 8 * c16;
  u32x4 pq0, pq1, ps0, ps1, pv0, pv1;
#define HG_LOAD(n) do { const int t0_ = dir ? T - 64 * ((n) + 1) : 64 * (n); const int ra_ = dir ? 63 - lrow : lrow, rb_ = dir ? 31 - lrow : lrow + 32; \
    const bf16_t* pa_ = QF + (size_t)(seqrow + t0_ + ra_) * 5120; const bf16_t* pb_ = QF + (size_t)(seqrow + t0_ + rb_) * 5120; \
    pq0 = *(const u32x4*)(pa_ + qcol); pq1 = *(const u32x4*)(pb_ + qcol); ps0 = *(const u32x4*)(pa_ + fcol); ps1 = *(const u32x4*)(pb_ + fcol); pv0 = *(const u32x4*)(pa_ + vcol); pv1 = *(const u32x4*)(pb_ + vcol); } while (0)
#define HG_STORE() do { *(LAS u32x4*)(lds + RAWQ + 256 * lrow + 16 * c16) = pq0; *(LAS u32x4*)(lds + RAWQ + 256 * (lrow + 32) + 16 * c16) = pq1; \
    *(LAS u32x4*)(lds + RAWS + 256 * lrow + 16 * c16) = ps0; *(LAS u32x4*)(lds + RAWS + 256 * (lrow + 32) + 16 * c16) = ps1; \
    *(LAS u32x4*)(lds + IMG_V + voffa(lrow, c16)) = pv0; *(LAS u32x4*)(lds + IMG_V + voffa(lrow + 32, c16)) = pv1; } while (0)
  const int q4 = (lane & 15) >> 2, p4 = lane & 3, gi = (lane >> 4) & 1;
  const int vbp0 = 64 * (4 * hi + q4) + 16 * ((2 * gi + (p4 >> 1)) ^ hi) + 8 * (p4 & 1), vbp1 = 64 * (4 * hi + q4) + 16 * ((2 * gi + (p4 >> 1)) ^ (2 + hi)) + 8 * (p4 & 1);
  const int nb0 = 2048 * hi + 64 * q4 + 16 * ((2 * gi + (p4 >> 1)) ^ (2 * hi)) + 8 * (p4 & 1), nb1 = 2048 * hi + 64 * q4 + 16 * ((2 * gi + (p4 >> 1)) ^ (2 * hi + 1)) + 8 * (p4 & 1);
  HG_LOAD(0); HG_STORE(); __syncthreads();
#pragma unroll 1
  for (int n = 0; n < NC; ++n) {
    if (n + 1 < NC) HG_LOAD(n + 1);
    float kk0[8], kk1[8], g0[8], g1[8]; float c0 = 0.f, c1 = 0.f;
#pragma unroll
    for (int i = 0; i < 8; ++i) { const int row = 8 * e8 + i; const unsigned sw = *(const LAS unsigned*)(lds + RAWS + 256 * row + 4 * kp);
      kk0[i] = om0 * bflo(sw); kk1[i] = om1 * bfhi(sw); c0 += __log2f(1.f - kk0[i]); c1 += __log2f(1.f - kk1[i]); g0[i] = c0; g1[i] = c1; }
    *(LAS f32x2*)(lds + TOT + (e8 * 128 + 2 * kp) * 4) = (f32x2){c0, c1};
    __syncthreads();
    float off0 = 0.f, off1 = 0.f, ge0 = 0.f, ge1 = 0.f;
#pragma unroll
    for (int e = 0; e < 8; ++e) { const f32x2 t = *(const LAS f32x2*)(lds + TOT + (e * 128 + 2 * kp) * 4); ge0 += t.x; ge1 += t.y; if (e < e8) { off0 += t.x; off1 += t.y; } }
#pragma unroll
    for (int i = 0; i < 8; ++i) { const int row = 8 * e8 + i; const float G0 = off0 + g0[i], G1 = off1 + g1[i];
      const unsigned qw = *(const LAS unsigned*)(lds + RAWQ + 256 * row + 4 * kp);
      const float eq0 = __builtin_amdgcn_exp2f(G0), eq1 = __builtin_amdgcn_exp2f(G1), ek0 = __builtin_amdgcn_exp2f(-G0), ek1 = __builtin_amdgcn_exp2f(-G1);
      const float eh0 = __builtin_amdgcn_exp2f(ge0 - G0), eh1 = __builtin_amdgcn_exp2f(ge1 - G1);
      const int ro = rowimg(row, kp >> 2) + 4 * (kp & 3);
      *(LAS unsigned*)(lds + IMG_QT + ro) = pkbf(bflo(qw) * eq0, bfhi(qw) * eq1);
      *(LAS unsigned*)(lds + IMG_KT + ro) = pkbf(kk0[i] * ek0, kk1[i] * ek1);
      *(LAS unsigned*)(lds + IMG_KH + voffa(row, kp >> 2) + 4 * (kp & 3)) = pkbf(kk0[i] * eh0, kk1[i] * eh1); }
    if (e8 == 7) *(LAS f32x2*)(lds + DEC + 8 * kp) = (f32x2){__builtin_amdgcn_exp2f(ge0), __builtin_amdgcn_exp2f(ge1)};
    __syncthreads();
    bf16x8 px[2][2];
#pragma unroll
    for (int sb = 0; sb < 2; ++sb) {
      if (sb <= tblk) {
        f32x16 X;
#pragma unroll
        for (int r = 0; r < 16; ++r) X[r] = 0.f;
#pragma unroll
        for (int ds = 0; ds < 8; ++ds) { const bf16x8 a = *(const LAS bf16x8*)(lds + IMG_KT + rowimg(32 * sb + r32, 2 * ds + hi)), bq = *(const LAS bf16x8*)(lds + IMG_QT + rowimg(32 * tblk + r32, 2 * ds + hi));
          X = __builtin_amdgcn_mfma_f32_32x32x16_bf16(a, bq, X, 0, 0, 0); }
        if (sb == tblk) {
#pragma unroll
          for (int r = 0; r < 16; ++r) { const int sl = (r & 3) + 8 * (r >> 2) + 4 * hi; X[r] = (sl <= r32) ? X[r] : 0.f; } }
        u32x4 w0, w1;
        w0.x = pkbf(X[0], X[1]); w0.y = pkbf(X[2], X[3]); w0.z = pkbf(X[4], X[5]); w0.w = pkbf(X[6], X[7]);
        w1.x = pkbf(X[8], X[9]); w1.y = pkbf(X[10], X[11]); w1.z = pkbf(X[12], X[13]); w1.w = pkbf(X[14], X[15]);
        px[sb][0] = __builtin_bit_cast(bf16x8, w0); px[sb][1] = __builtin_bit_cast(bf16x8, w1);
      } else { px[sb][0] = (bf16x8){0, 0, 0, 0, 0, 0, 0, 0}; px[sb][1] = px[sb][0]; }
    }
    f32x16 acc;
#pragma unroll
    for (int r = 0; r < 16; ++r) acc[r] = 0.f;
#pragma unroll
    for (int sb = 0; sb < 2; ++sb)
#pragma unroll
      for (int s2 = 0; s2 < 2; ++s2) {
        const s16x4 lo = vtr(lds + IMG_V + vbp0 + 2048 * (4 * sb + 2 * s2) + 512 * vblk), hh = vtr(lds + IMG_V + vbp1 + 2048 * (4 * sb + 2 * s2 + 1) + 512 * vblk);
        const bf16x8 a = {lo[0], lo[1], lo[2], lo[3], hh[0], hh[1], hh[2], hh[3]};
        acc = __builtin_amdgcn_mfma_f32_32x32x16_bf16(a, px[sb][s2], acc, 0, 0, 0);
      }
#pragma unroll
    for (int kb = 0; kb < 4; ++kb)
#pragma unroll
      for (int s2 = 0; s2 < 2; ++s2) {
        u32x4 w; w.x = pkbf(Sacc[kb][8 * s2 + 0], Sacc[kb][8 * s2 + 1]); w.y = pkbf(Sacc[kb][8 * s2 + 2], Sacc[kb][8 * s2 + 3]); w.z = pkbf(Sacc[kb][8 * s2 + 4], Sacc[kb][8 * s2 + 5]); w.w = pkbf(Sacc[kb][8 * s2 + 6], Sacc[kb][8 * s2 + 7]);
        const u32x2 b0 = *(const LAS u32x2*)(lds + IMG_QT + rowimg(32 * tblk + r32, 4 * kb + 2 * s2) + 8 * hi), b1 = *(const LAS u32x2*)(lds + IMG_QT + rowimg(32 * tblk + r32, 4 * kb + 2 * s2 + 1) + 8 * hi);
        const u32x4 bw = {b0.x, b0.y, b1.x, b1.y};
        acc = __builtin_amdgcn_mfma_f32_32x32x16_bf16(__builtin_bit_cast(bf16x8, w), __builtin_bit_cast(bf16x8, bw), acc, 0, 0, 0);
      }
#pragma unroll
    for (int g4 = 0; g4 < 4; ++g4) { u32x2 w; w.x = pkbf(acc[4 * g4], acc[4 * g4 + 1]); w.y = pkbf(acc[4 * g4 + 2], acc[4 * g4 + 3]);
      *(LAS u32x2*)(lds + OUTB + rowimg(32 * tblk + r32, 4 * vblk + g4) + 8 * hi) = w; }
#pragma unroll
    for (int kb = 0; kb < 4; ++kb) {
#pragma unroll
      for (int g4 = 0; g4 < 4; ++g4) { const f32x4 d = *(const LAS f32x4*)(lds + DEC + 4 * (32 * kb + 8 * g4 + 4 * hi));
        Sacc[kb][4 * g4] *= d.x; Sacc[kb][4 * g4 + 1] *= d.y; Sacc[kb][4 * g4 + 2] *= d.z; Sacc[kb][4 * g4 + 3] *= d.w; }
#pragma unroll
      for (int s4 = 0; s4 < 4; ++s4) {
        const s16x4 a0 = vtr(lds + IMG_KH + nb0 + 4096 * s4 + 512 * kb), a1 = vtr(lds + IMG_KH + nb1 + 4096 * s4 + 256 + 512 * kb);
        const s16x4 b0 = vtr(lds + IMG_V + nb0 + 4096 * s4 + 512 * vblk), b1 = vtr(lds + IMG_V + nb1 + 4096 * s4 + 256 + 512 * vblk);
        const bf16x8 a = {a0[0], a0[1], a0[2], a0[3], a1[0], a1[1], a1[2], a1[3]}, bb = {b0[0], b0[1], b0[2], b0[3], b1[0], b1[1], b1[2], b1[3]};
        Sacc[kb] = __builtin_amdgcn_mfma_f32_32x32x16_bf16(a, bb, Sacc[kb], 0, 0, 0);
      }
    }
    __syncthreads();
    { const int t0_ = dir ? T - 64 * (n + 1) : 64 * n;
#pragma unroll
      for (int i = 0; i < 2; ++i) { const int tau = lrow + 32 * i; const int grow = dir ? 63 - tau : tau;
        *(u32x4*)(Od + (size_t)(seqrow + t0_ + grow) * 1024 + head * 128 + 8 * c16) = *(const LAS u32x4*)(lds + OUTB + rowimg(tau, c16)); } }
    if (n + 1 < NC) HG_STORE();
    __syncthreads();
  }
#undef HG_LOAD
#undef HG_STORE
}
__device__ __forceinline__ void phase_hgrn_combine(const bf16_t* QF, const bf16_t* Ofw, const bf16_t* Obw, bf16_t* O, const float* gn, int gw, int ngw, int lane) {
  for (int t = gw; t < M_TOK; t += ngw) {
    const int c0 = 16 * lane;
    float v[16], gv[16];
    { const bf16_t* a = Ofw + (size_t)t * 1024 + c0; const bf16_t* b = Obw + (size_t)t * 1024 + c0; const bf16_t* gp = QF + (size_t)t * 5120 + 4096 + c0;
#pragma unroll
      for (int j = 0; j < 2; ++j) { const u32x4 x = *(const u32x4*)(a + 8 * j), y = *(const u32x4*)(b + 8 * j), z = *(const u32x4*)(gp + 8 * j);
        v[8 * j + 0] = bflo(x.x) + bflo(y.x); v[8 * j + 1] = bfhi(x.x) + bfhi(y.x); v[8 * j + 2] = bflo(x.y) + bflo(y.y); v[8 * j + 3] = bfhi(x.y) + bfhi(y.y);
        v[8 * j + 4] = bflo(x.z) + bflo(y.z); v[8 * j + 5] = bfhi(x.z) + bfhi(y.z); v[8 * j + 6] = bflo(x.w) + bflo(y.w); v[8 * j + 7] = bfhi(x.w) + bfhi(y.w);
        gv[8 * j + 0] = bflo(z.x); gv[8 * j + 1] = bfhi(z.x); gv[8 * j + 2] = bflo(z.y); gv[8 * j + 3] = bfhi(z.y); gv[8 * j + 4] = bflo(z.z); gv[8 * j + 5] = bfhi(z.z); gv[8 * j + 6] = bflo(z.w); gv[8 * j + 7] = bfhi(z.w); } }
    float ss = 0.f;
#pragma unroll
    for (int i = 0; i < 16; ++i) ss += v[i] * v[i];
    ss += DPPF(ss, 0xB1); ss += DPPF(ss, 0x4E); ss += DPPF(ss, 0x141);
    const float rs = rsqrtf(ss * (1.f / 128.f) + 1e-6f);
    unsigned w[8];
#pragma unroll
    for (int i = 0; i < 8; ++i) { const int d = (c0 & 127) + 2 * i; const float g0 = gv[2 * i], g1 = gv[2 * i + 1];
      w[i] = pkbf(v[2 * i] * rs * gn[d] * (g0 / (1.f + __expf(-g0))), v[2 * i + 1] * rs * gn[d + 1] * (g1 / (1.f + __expf(-g1)))); }
    bf16_t* op = O + (size_t)t * DM + c0; *(u32x4*)op = (u32x4){w[0], w[1], w[2], w[3]}; *(u32x4*)(op + 8) = (u32x4){w[4], w[5], w[6], w[7]};
  }
}

__device__ __forceinline__ void phase_convglu(const bf16_t* U, bf16_t* G, const float* cw  , const float* cb  , int half, int gt, int ngt) {
  const size_t total = (size_t)MH * 352; const int S = half ? 4096 : 8192;
  for (size_t it = gt; it < total; it += ngt) {
    const int row = (int)(it / 352), c8 = (int)(it % 352), c = 8 * c8; const int pos = row & (S - 1);
    float a[8], b[8];
#pragma unroll
    for (int i = 0; i < 8; ++i) { a[i] = cb[c + i]; b[i] = cb[2816 + c + i]; }
#pragma unroll
    for (int tap = 0; tap < 3; ++tap) { const int pp = pos + tap - 1; if (pp < 0 || pp >= S) continue;
      const bf16_t* ur = U + (size_t)(row + tap - 1) * 5632; const u32x4 ua = *(const u32x4*)(ur + c), ub = *(const u32x4*)(ur + 2816 + c);
      const float fa[8] = {bflo(ua.x), bfhi(ua.x), bflo(ua.y), bfhi(ua.y), bflo(ua.z), bfhi(ua.z), bflo(ua.w), bfhi(ua.w)};
      const float fb[8] = {bflo(ub.x), bfhi(ub.x), bflo(ub.y), bfhi(ub.y), bflo(ub.z), bfhi(ub.z), bflo(ub.w), bfhi(ub.w)};
#pragma unroll
      for (int i = 0; i < 8; ++i) { a[i] += fa[i] * cw[tap * 5632 + c + i]; b[i] += fb[i] * cw[tap * 5632 + 2816 + c + i]; } }
    float o[8];
#pragma unroll
    for (int i = 0; i < 8; ++i) { const float x = a[i], z = 1.5957691216057308f * (x + 0.044715f * x * x * x); o[i] = x / (1.f + __expf(-z)) * b[i]; }
    u32x4 w; w.x = pkbf(o[0], o[1]); w.y = pkbf(o[2], o[3]); w.z = pkbf(o[4], o[5]); w.w = pkbf(o[6], o[7]);
    *(u32x4*)(G + (size_t)row * DFF + c) = w;
  }
}

#define XB_TMO      128
#define XB_XCNT(j)  (256  + 64 * (j))
#define XB_XSUB(j)  (1280 + 64 * (j))
#define XB_XGEN(j)  (2304 + 64 * (j))
#define XB_TOP      3328
#define XB_TOPGEN   3392
#define XCD_BAR_WORDS 3456
#define XB_SPIN_CAP (1u << 18)

__device__ __forceinline__ unsigned xb_ld(unsigned* p)              { return __hip_atomic_load(p, __ATOMIC_RELAXED, __HIP_MEMORY_SCOPE_AGENT); }
__device__ __forceinline__ unsigned xb_add(unsigned* p, unsigned v) { return __hip_atomic_fetch_add(p, v, __ATOMIC_RELAXED, __HIP_MEMORY_SCOPE_AGENT); }
__device__ __forceinline__ unsigned xb_xcc_id() { return (unsigned)__builtin_amdgcn_s_getreg((3 << 11) | 20) & 0xFu; }
#define XB_SPIN(cond, bar) do { unsigned _sp = 0; while (cond) { __builtin_amdgcn_s_sleep(1); \
    if ((++_sp & 255u) == 0u) { if (xb_ld(&(bar)[XB_TMO])) break; if (_sp > XB_SPIN_CAP) { atomicAdd(&(bar)[XB_TMO], 1u); break; } } } } while (0)

struct XcdBarrier {
    unsigned* bar; unsigned x;
    volatile LAS unsigned* st;
};

__device__ __forceinline__ XcdBarrier xcd_barrier_post(unsigned* bar, volatile LAS unsigned* st) {
    XcdBarrier b; b.bar = bar; b.x = xb_xcc_id(); b.st = st;
    if (threadIdx.x == 0) (void)xb_add(&bar[XB_XCNT(b.x)], 1u);
    return b;
}
__device__ __forceinline__ void xcd_barrier_complete(unsigned* bar, unsigned x, unsigned& nloc, unsigned& nx) {
    const unsigned G = gridDim.x * gridDim.y * gridDim.z;
    unsigned sum, cnt, mine, sp = 0u;
    for (;;) {
        sum = 0u; cnt = 0u; mine = 0u;
#pragma unroll
        for (unsigned j = 0; j < 16; ++j) { const unsigned c = xb_ld(&bar[XB_XCNT(j)]); sum += c; cnt += (c > 0u) ? 1u : 0u; mine = (j == x) ? c : mine; }
        if (sum == G) break;
        __builtin_amdgcn_s_sleep(1);
        if ((++sp & 255u) == 0u) { if (xb_ld(&bar[XB_TMO])) break; if (sp > XB_SPIN_CAP) { atomicAdd(&bar[XB_TMO], 1u); break; } }
    }
    nloc = mine > 0u ? mine : 1u; nx = cnt > 0u ? cnt : 1u;
}

__device__ __forceinline__ void xcd_barrier(const XcdBarrier& b) {
    asm volatile("s_waitcnt vmcnt(0)" ::: "memory");
    __syncthreads();
    if (threadIdx.x == 0) {
        unsigned* bar = b.bar;
        __builtin_amdgcn_s_waitcnt(0);
        unsigned nloc = b.st[0], nx = b.st[1];
        if (nloc == 0u) { xcd_barrier_complete(bar, b.x, nloc, nx); b.st[0] = nloc; b.st[1] = nx; }
        const unsigned old = xb_add(&bar[XB_XSUB(b.x)], 1u);
        const unsigned gen = old / nloc;
        if (old + 1u == (gen + 1u) * nloc) {
            __builtin_amdgcn_fence(__ATOMIC_RELEASE, "agent");
            asm volatile("s_waitcnt vmcnt(0)" ::: "memory");
            const unsigned og = xb_add(&bar[XB_TOP], 1u);
            const unsigned tg = og / nx;
            if (og + 1u == (tg + 1u) * nx) xb_add(&bar[XB_TOPGEN], 1u);
            else XB_SPIN(xb_ld(&bar[XB_TOPGEN]) == tg, bar);
            __builtin_amdgcn_fence(__ATOMIC_ACQUIRE, "agent");
            xb_add(&bar[XB_XGEN(b.x)], 1u);
            asm volatile("s_waitcnt vmcnt(0)" ::: "memory");
        } else {
            XB_SPIN(xb_ld(&bar[XB_XGEN(b.x)]) == gen, bar);
            __builtin_amdgcn_fence(__ATOMIC_ACQUIRE, "agent");
            asm volatile("s_waitcnt vmcnt(0)" ::: "memory");
        }
    }
    __syncthreads();
}

typedef pg8::EpiBf16<0> EpiP;
enum { OP_GEMM = 0, OP_ROPE_DIFF, OP_DIFF_ATTN, OP_RES_NORM, OP_ROPE_DIL, OP_DIL_ATTN, OP_DIL_COMB, OP_HG_GATES, OP_HG_SCAN, OP_HG_COMB, OP_CONVGLU, OP_GEMM_FFN, OP_END };
struct Step { int op; int half; const bf16_t* A; const bf16_t* Bt; bf16_t* O; int M, N, K, ldc, split; const bf16_t* Yin; int gA, gB; int mode, tok0; };
__device__ __forceinline__ Step get_step(int layer, int s, unsigned char* ws) {
  bf16_t* W = (bf16_t*)(ws + WS_W); bf16_t* H = (bf16_t*)(ws + WS_H); bf16_t* Y = (bf16_t*)(ws + WS_Y); bf16_t* BIG = (bf16_t*)(ws + WS_BIG);
  const int kind = layer % 3, j = layer / 3;
  Step st; st.op = OP_END; st.half = 0; st.A = H; st.Bt = W; st.O = Y; st.M = M_TOK; st.N = 1024; st.K = 1024; st.ldc = 1024; st.split = 0; st.Yin = Y; st.gA = 0; st.gB = -1; st.mode = 0; st.tok0 = 0;
  const int nmix = (kind == 0) ? 3 : (kind == 1) ? 7 : 4;
  if (s < nmix) {
    if (kind == 2) {
      if (s == 0) { st.op = OP_GEMM; st.A = H; st.Bt = W + WE_CIN; st.O = BIG; st.N = 5120; st.ldc = 5120; st.mode = 2; }
      else if (s == 1) st.op = OP_HG_SCAN;
      else if (s == 2) st.op = OP_HG_COMB;
      else { st.op = OP_GEMM; st.A = Y; st.Bt = W + WE_CO; st.O = H; }
    } else if (kind == 0) {
      if (s == 0) { st.op = OP_GEMM; st.A = H; st.Bt = W + WE_AQKV + (size_t)j * 3072 * 1024; st.O = BIG; st.N = 3072; st.split = 1024; st.mode = 1; }
      else if (s == 1) st.op = OP_DIFF_ATTN;
      else { st.op = OP_GEMM; st.A = H; st.Bt = W + WE_AO + (size_t)j * 1024 * 1024; st.O = Y; }
    } else {
      if (s == 6) { st.op = OP_GEMM; st.A = Y; st.Bt = W + WE_BO; st.O = H; }
      else { const int half = s / 3, q = s % 3; st.half = half;
        if (q == 0) { st.op = OP_GEMM; st.A = H + (size_t)half * MH * DM; st.Bt = W + WE_BQKV; st.O = BIG; st.M = MH; st.N = 9216; st.ldc = 9216; st.mode = 1; st.tok0 = half * MH; }
        else st.op = (q == 1) ? OP_DIL_ATTN : OP_DIL_COMB; }
    }
    return st;
  }
  const int f = s - nmix;
  bf16_t* U = Y; bf16_t* Gb = Y + 352ull * MiB / 2;
  if (f == 0) { st.op = OP_RES_NORM; st.Yin = (kind == 0) ? Y : H; st.gA = layer * 4 + 1; st.gB = layer * 4 + 2; }
  else if (f == 1) { st.op = OP_GEMM_FFN; st.A = H - 1024; st.Bt = W + WE_FIN + (size_t)layer * 5632 * 1024; st.O = Gb; st.M = 265 * 256; st.N = 5632; }
  else if (f == 2) { st.op = OP_GEMM; st.A = Gb; st.Bt = W + WE_FOUT + (size_t)layer * 1024 * 2816; st.O = Y; st.K = 2816; }
  else if (f == 3) { st.op = OP_RES_NORM; st.Yin = Y; st.gA = layer * 4 + 3; st.gB = (layer < 3) ? (layer + 1) * 4 : -1; }
  return st;
}

__global__ void __launch_bounds__(512) fwd_megakernel(Params p) {
  extern __shared__ __attribute__((aligned(16))) unsigned char lds_raw[];
  cg::grid_group grid = cg::this_grid();
  ldsp lds = (ldsp)lds_raw;
  const int G = gridDim.x, ngw = G * 8, ngt = G * 512;
  if (threadIdx.x < 2) *(LAS unsigned*)(lds + 131072 + 256 + 4 * threadIdx.x) = 0u;
  __syncthreads();
#define FRESH() const int tid = fresh_tid(), lane = tid & 63, wave = tid >> 6, gw = blockIdx.x * 8 + wave, gt = blockIdx.x * 512 + tid; (void)lane; (void)wave; (void)gw; (void)gt
  unsigned char* ws = kargs()->ws;
  float* x = kargs()->out;
  float* rope = (float*)(ws + WS_ROPE); float* oml = (float*)(ws + WS_OML);
  bf16_t* W = (bf16_t*)(ws + WS_W); bf16_t* H = (bf16_t*)(ws + WS_H); bf16_t* Y = (bf16_t*)(ws + WS_Y); bf16_t* BIG = (bf16_t*)(ws + WS_BIG);
#define norm_g (kargs()->in[2])

  {
    FRESH();
    LAS float* scr = (LAS float*)(lds + wave * 16384);
#pragma unroll 1
    for (int mi = 0; mi < 16; ++mi) {
      const float* src; bf16_t* dst; int K = 1024, N = 1024;
      if (mi < 2) { src = kargs()->in[3] + (size_t)mi * 1024 * 3072; dst = W + WE_AQKV + (size_t)mi * 3072 * 1024; N = 3072; }
      else if (mi < 4) { src = kargs()->in[6] + (size_t)(mi - 2) * 1024 * 1024; dst = W + WE_AO + (size_t)(mi - 2) * 1024 * 1024; }
      else if (mi == 4) { src = kargs()->in[7]; dst = W + WE_BQKV; N = 9216; }
      else if (mi == 5) { src = kargs()->in[8]; dst = W + WE_BO; }
      else if (mi == 6) { src = kargs()->in[9]; dst = W + WE_CIN; N = 5120; }
      else if (mi == 7) { src = kargs()->in[12]; dst = W + WE_CO; }
      else if (mi < 12) { src = kargs()->in[13] + (size_t)(mi - 8) * 1024 * 5632; dst = W + WE_FIN + (size_t)(mi - 8) * 5632 * 1024; N = 5632; }
      else { src = kargs()->in[16] + (size_t)(mi - 12) * 2816 * 1024; dst = W + WE_FOUT + (size_t)(mi - 12) * 1024 * 2816; K = 2816; }
      transpose_mat(src, K, N, dst, scr, gw, ngw, lane, mi >= 8 && mi < 12);
    }
    for (int i = gt; i < 8192 * 8; i += ngt) { const int pos = i >> 3, f = i & 7; const double rev = (double)pos * kargs()->invf[f] * 0.15915494309189535; const float fr = (float)(rev - floor(rev));
      rope[pos * 16 + f] = __builtin_amdgcn_cosf(fr); rope[pos * 16 + 8 + f] = __builtin_amdgcn_sinf(fr); }
    for (int i = gt; i < 1024; i += ngt) { const float* lg = kargs()->in[10]; const float a0 = lg[i], a1 = lg[1024 + i], a2 = lg[2048 + i], a3 = lg[3072 + i]; const float mx = fmaxf(fmaxf(a0, a1), fmaxf(a2, a3));
      const float e0 = __expf(a0 - mx), e1 = __expf(a1 - mx), e2 = __expf(a2 - mx), e3 = __expf(a3 - mx); oml[i] = 1.f - (e1 + e2) / (e0 + e1 + e2 + e3); }
    phase_init_norm(kargs()->in[0], kargs()->in[1], x, H, norm_g, gw, ngw, lane);
  }
  grid.sync();
  XcdBarrier xbar = xcd_barrier_post((unsigned*)(ws + WS_BAR), (volatile LAS unsigned*)(lds + 131072 + 256));

#pragma unroll 1
  for (int layer = 0; layer < 4; ++layer) {
#pragma unroll 1
#ifdef PROBE_DUP_OP
    for (int s = 0, rep_ = 0; s < 16; ) {
#else
    for (int s = 0; s < 16; ++s) {
#endif
      const Step st = get_step(layer, s, ws);
      if (st.op == OP_END) break;
#ifdef PROBE_REPEAT_OP
      for (int rep_ = 0; rep_ < ((st.op == PROBE_REPEAT_OP) ? 2 : 1); ++rep_) {
#endif
      switch (st.op) {
        case OP_GEMM: {
          pg8::EpiAct E{st.O, st.ldc, st.split, (size_t)M_TOK * DM, st.mode, rope, st.tok0, C2};
          int gM = st.M, gN = st.N, gK = st.K, gG = G, gB = (int)blockIdx.x; asm volatile("" : "+s"(gM), "+s"(gN), "+s"(gK), "+s"(gG), "+s"(gB));
          pg8::Gemm g{st.A, st.Bt, gM, gN, gK}; pg8::StaticOrder S; S.init(gM, gN, gG, gB);
          pg8::gemm_phase<pg8::EpiAct, pg8::StaticOrder, true, true>(lds, g, S, E);
        } break;
        case OP_GEMM_FFN: {
          int ly = layer; asm volatile("" : "+s"(ly));
          pg8::EpiConvGlu E{st.O, kargs()->in[14] + (size_t)ly * 3 * 5632, kargs()->in[15] + (size_t)ly * 5632};
          int gM = st.M, gN = st.N, gK = st.K, gG = G, gB = (int)blockIdx.x; asm volatile("" : "+s"(gM), "+s"(gN), "+s"(gK), "+s"(gG), "+s"(gB));
          pg8::Gemm g{st.A, st.Bt, gM, gN, gK}; pg8::StaticOrder S; S.init(gM, gN, gG, gB);
          pg8::gemm_phase<pg8::EpiConvGlu, pg8::StaticOrder, true, true, true>(lds, g, S, E);
        } break;
        case OP_ROPE_DIFF: { FRESH(); bf16_t* Qb = BIG; bf16_t* Kb = BIG + (size_t)M_TOK * DM;
          for (int it = gw; it < M_TOK * 2; it += ngw) { const int row = it >> 1, sg = it & 1; const int pos = (row < MH) ? (row & 8191) : (row & 4095);
            rope_seg((sg ? Kb : Qb) + (size_t)row * DM + 16 * lane, pos, sg ? 1.f : C2, rope, lane); } } break;
        case OP_DIFF_ATTN: { int ly = layer; asm volatile("" : "+s"(ly)); const int j = ly / 3; const float lam_init = __builtin_bit_cast(float, (ly == 0) ? 0x3e4ccccd : 0x3f0e59d5), osc_l = __builtin_bit_cast(float, (ly == 0) ? 0x3f4ccccd : 0x3ee34c57);
          phase_diff_attn(lds, BIG, BIG + (size_t)M_TOK * DM, BIG + 2 * (size_t)M_TOK * DM, H, kargs()->in[4] + j * 256, kargs()->in[5] + j * 128, lam_init, osc_l); } break;
        case OP_RES_NORM: { FRESH(); const bool first_ = (st.gA == 1); phase_res_norm(st.Yin, x, H, norm_g + st.gA * 1024, st.gB >= 0 ? norm_g + st.gB * 1024 : nullptr, gw, ngw, lane, first_ ? kargs()->in[0] : nullptr, first_ ? kargs()->in[1] : nullptr); } break;
        case OP_ROPE_DIL: { FRESH();
          for (int it = gw; it < MH * 6; it += ngw) { const int row = it / 6, sg = it % 6; const int tok = st.half * MH + row; const int pos = (tok < MH) ? (tok & 8191) : (tok & 4095);
            rope_seg(BIG + (size_t)row * 9216 + (sg >> 1) * 3072 + (sg & 1) * 1024 + 16 * lane, pos, (sg & 1) ? 1.f : C2, rope, lane); } } break;
        case OP_DIL_ATTN: { float* LSE = (float*)(BIG + (size_t)MH * 9216);
#pragma unroll 1
          for (int u = blockIdx.x; u < 6144; u += G) dil_unit(lds, BIG, LSE, st.half, u); } break;
        case OP_DIL_COMB: { FRESH(); phase_dil_combine(BIG, (const float*)(BIG + (size_t)MH * 9216), Y + (size_t)st.half * MH * DM, gw, ngw, lane); } break;
        case OP_HG_GATES: { FRESH(); phase_hgrn_gates(BIG, gt, ngt); } break;
        case OP_HG_SCAN: {
#pragma unroll 1
          for (int c = blockIdx.x; c < 192; c += G) hgrn_chain(lds, BIG, Y, H, oml, c); } break;
        case OP_HG_COMB: { FRESH(); phase_hgrn_combine(BIG, Y, H, Y, kargs()->in[11], gw, ngw, lane); } break;
        case OP_CONVGLU: { FRESH(); phase_convglu(Y, Y + 352ull * MiB / 2 + (size_t)st.half * MH * DFF, kargs()->in[14] + (size_t)layer * 3 * 5632, kargs()->in[15] + (size_t)layer * 5632, st.half, gt, ngt); } break;
        default: break;
      }
      xcd_barrier(xbar);
#ifdef PROBE_DUP_OP
      if (st.op == PROBE_DUP_OP && rep_ == 0) rep_ = 1; else { rep_ = 0; ++s; }
#endif
#ifdef PROBE_REPEAT_OP
      }
#endif
    }
  }
}

constexpr int LDS_BYTES = 147456;
extern "C" void kernel_launch(void* const* d_in, const int* in_sizes, int n_in, void* d_out, int out_size, void* d_ws, size_t ws_size, hipStream_t stream) {
  static int grid = 0;
  if (grid == 0) {
    if (n_in != 17 || ws_size < WS_END) { fprintf(stderr, "kernel_launch: unexpected n_in %d / ws %zu\n", n_in, ws_size); grid = -1; return; }
    int dev = 0, cus = 0;
    if (hipGetDevice(&dev) != hipSuccess || hipDeviceGetAttribute(&cus, hipDeviceAttributeMultiprocessorCount, dev) != hipSuccess) { grid = -1; return; }
    if (hipFuncSetAttribute((const void*)fwd_megakernel, hipFuncAttributeMaxDynamicSharedMemorySize, LDS_BYTES) != hipSuccess) { fprintf(stderr, "hipFuncSetAttribute failed\n"); grid = -1; return; }
    grid = cus;
  }
  if (grid < 0) return;
  if (hipMemsetAsync((char*)d_ws + WS_BAR, 0, XCD_BAR_WORDS * 4, stream) != hipSuccess) { fprintf(stderr, "kernel_launch: memset of the barrier words failed\n"); return; }
  Params p{};
  for (int i = 0; i < 17; ++i) p.in[i] = (const float*)d_in[i];
  p.out = (float*)d_out; p.ws = (unsigned char*)d_ws;
  for (int i = 0; i < 8; ++i) p.invf[i] = pow(500000.0, -(double)i / 8.0);
  void* args[] = {&p};
  hipError_t e = hipLaunchCooperativeKernel((void*)fwd_megakernel, dim3(grid), dim3(512), args, LDS_BYTES, stream);
  if (e != hipSuccess) fprintf(stderr, "cooperative launch failed: %s (grid %d)\n", hipGetErrorString(e), grid);
}
```

```cpp
#include <hip/hip_runtime.h>
#include <hip/hip_cooperative_groups.h>
#include <cstdio>
#include <cstdint>
#include <cmath>
namespace cg = cooperative_groups;
namespace pg8 {
#define PG8_LAS __attribute__((address_space(3)))
typedef unsigned short bf16_t;
typedef short bf16x8 __attribute__((ext_vector_type(8)));
typedef float f32x4 __attribute__((ext_vector_type(4)));
typedef unsigned u32x4 __attribute__((ext_vector_type(4)));
constexpr int BM = 256, BK = 64, HALF = 128, HTB = HALF * BK * 2  , STAGE_BYTES = 8 * HTB, NXCD = 8, WGM = 8;

__host__ __device__ __forceinline__ int lds_byte(int r, int c) { const int st = (r >> 4) * 2 + (c >> 5), rr = r & 15, cc = c & 31, ob = rr * 64 + cc * 2; return st * 1024 + (ob ^ (((ob >> 9) & 1) << 5)); }
__host__ __device__ __forceinline__ void stage_rc(int b, int& R, int& C) { const int st = b / 1024, sb = b % 1024, swz = sb ^ (((sb >> 9) & 1) << 5); R = (st >> 1) * 16 + swz / 64; C = (st & 1) * 32 + (swz % 64) / 2; }
__host__ __device__ __forceinline__ int perm32(int rho) { const int n = rho >> 4, i = rho & 15; return 8 * (i >> 2) + 4 * n + (i & 3); }

struct Unit { int pm, pn; };
struct Gemm { const bf16_t* A; const bf16_t* Bt; int M, N, K; };

struct StaticOrder {
    int nM, nN, nwg, G, c;
    __host__ __device__ void init(int M, int N, int G_, int c_) { nM = M / BM; nN = N / BM; nwg = nM * nN; G = G_; c = c_; }
    __host__ __device__ bool next(int i, Unit& u) const {
        const int L = i * G + c; if (L >= nwg) return false;
        int wgid = L; { const int q = nwg / NXCD, r = nwg % NXCD, xcd = wgid % NXCD, off = wgid / NXCD; wgid = (xcd < r ? xcd * (q + 1) : r * (q + 1) + (xcd - r) * q) + off; }
        const int nig = WGM * nN, gid = wgid / nig, fm = gid * WGM, gsz = (nM - fm) < WGM ? (nM - fm) : WGM;
        u.pm = fm + ((wgid % nig) % gsz); u.pn = (wgid % nig) / gsz; return true;
    }
    __device__ __forceinline__ void a_ready(const Unit&) const {}
    __device__ __forceinline__ void done(const Unit&) const {}
};

__device__ __forceinline__ unsigned cvt_pk_bf16(float lo, float hi) { unsigned r; asm volatile("v_cvt_pk_bf16_f32 %0, %1, %2" : "=v"(r) : "v"(lo), "v"(hi)); return r; }
typedef float f32x2 __attribute__((ext_vector_type(2)));
__device__ __forceinline__ f32x2 gelu_pk(f32x2 v) {
    const f32x2 av = __builtin_elementwise_abs(v), d = av * 0.2316418882f + 1.0f;
    f32x2 t; t.x = __builtin_amdgcn_rcpf(d.x); t.y = __builtin_amdgcn_rcpf(d.y);
    f32x2 q = t * 0.5307027145f + (-0.7265760135f); q = q * t + 0.7107068705f; q = q * t + (-0.142248368f); q = q * t + 0.127414796f; q = q * t;
    const f32x2 s = (v * v) * (-0.72134752044f);
    f32x2 e; e.x = __builtin_amdgcn_exp2f(s.x); e.y = __builtin_amdgcn_exp2f(s.y);
    const f32x2 m = v * (q * e), r = v - m;
    f32x2 o; o.x = v.x < 0.f ? m.x : r.x; o.y = v.y < 0.f ? m.y : r.y; return o;
}

template <int ACT  > struct EpiBf16 {
    static constexpr bool PERM = true, AFTER_DRAIN = false; static_assert(ACT == 0 || ACT == 1, "EpiBf16: ACT is 0 (none) or 1 (gelu_pk)");
    bf16_t* O; int ldc; const float* bias; int split_cols; size_t split_stride; float scale0;
    __device__ __forceinline__ void operator()(const f32x4 (&acc)[2][2][4][2], const Unit& u, int wr, int wc, int fr, int fq) const {
        const int row0 = u.pm * BM + wr * 64 + fr; int colt = u.pn * BM; bf16_t* base = O;
        float sc = 1.f; if (split_cols) { const int t = colt / split_cols; base += (size_t)t * split_stride; colt -= t * split_cols; if (t == 0) sc = scale0; }
        const int col0 = colt + wc * 32 + 8 * fq, bcol0 = u.pn * BM + wc * 32 + 8 * fq;
        f32x4 bv[2][2];
#pragma unroll
        for (int bj = 0; bj < 2; ++bj)
#pragma unroll
            for (int n = 0; n < 2; ++n) bv[bj][n] = bias ? *(const f32x4*)(bias + bcol0 + bj * HALF + 4 * n) : (f32x4){0.f, 0.f, 0.f, 0.f};
#pragma unroll
        for (int ai = 0; ai < 2; ++ai)
#pragma unroll
            for (int m = 0; m < 4; ++m) { bf16_t* rowp = base + (size_t)(row0 + ai * HALF + m * 16) * ldc + col0;
#pragma unroll
                for (int bj = 0; bj < 2; ++bj) { f32x4 v0 = acc[ai][bj][m][0] + bv[bj][0], v1 = acc[ai][bj][m][1] + bv[bj][1];
                    if (ACT == 1) { f32x2 a = gelu_pk((f32x2){v0[0], v0[1]}), b = gelu_pk((f32x2){v0[2], v0[3]}), c = gelu_pk((f32x2){v1[0], v1[1]}), d = gelu_pk((f32x2){v1[2], v1[3]});
                        v0 = (f32x4){a.x, a.y, b.x, b.y}; v1 = (f32x4){c.x, c.y, d.x, d.y}; }
                    v0 = v0 * sc; v1 = v1 * sc; u32x4 w; w.x = cvt_pk_bf16(v0[0], v0[1]); w.y = cvt_pk_bf16(v0[2], v0[3]); w.z = cvt_pk_bf16(v1[0], v1[1]); w.w = cvt_pk_bf16(v1[2], v1[3]);
                    *(u32x4*)(rowp + bj * HALF) = w; } }
    }
};


struct EpiAct {
    static constexpr bool PERM = true, AFTER_DRAIN = false;
    bf16_t* O; int ldc; int split_cols; size_t split_stride; int mode; const float* rope; int tok0; float qscale;
    __device__ __forceinline__ void operator()(const f32x4 (&acc)[2][2][4][2], const Unit& u, int wr, int wc, int fr, int fq) const {
        const int row0 = u.pm * BM + wr * 64 + fr; int colt = u.pn * BM; bf16_t* base = O; asm volatile("" : "+s"(base));
        const float* rope_ = rope; asm volatile("" : "+s"(rope_));
        int act = 0;
        if (mode == 1) { const int seg = colt % 3072; act = seg < 1024 ? 1 : (seg < 2048 ? 2 : 0); }
        else if (mode == 2) { act = colt < 1024 ? 3 : (colt < 3072 ? 4 : 0); }
        if (split_cols) { const int t = colt / split_cols; base += (size_t)t * split_stride; colt -= t * split_cols; }
        const int col0 = colt + wc * 32 + 8 * fq;
        const bool rope_wave = (act == 1 || act == 2) && ((wc & 1) == 0);
        const float sc = (act == 1) ? qscale : 1.f;
        const float sgn = (fq == 0) ? -1.f : 1.f; const bool rot = fq < 2;
#pragma unroll
        for (int ai = 0; ai < 2; ++ai)
#pragma unroll
            for (int m = 0; m < 4; ++m) {
                const int row = row0 + ai * HALF + m * 16; bf16_t* rowp = base + (size_t)row * ldc + col0;
                f32x4 c0 = {1.f, 1.f, 1.f, 1.f}, c1 = c0, s0 = {0.f, 0.f, 0.f, 0.f}, s1 = s0;
                if (rope_wave) { const int tok = tok0 + row; const int pos = (tok < 32768) ? (tok & 8191) : (tok & 4095); const float* cs = rope_ + (size_t)pos * 16;
                    c0 = *(const f32x4*)cs; c1 = *(const f32x4*)(cs + 4); s0 = *(const f32x4*)(cs + 8) * sgn; s1 = *(const f32x4*)(cs + 12) * sgn; }
#pragma unroll
                for (int bj = 0; bj < 2; ++bj) {
                    f32x4 v0 = acc[ai][bj][m][0], v1 = acc[ai][bj][m][1];
                    if (rope_wave) {
                        f32x4 p0, p1;
#pragma unroll
                        for (int e = 0; e < 4; ++e) { float a0 = v0[e], b0 = v0[e], a1 = v1[e], b1 = v1[e];
                            asm volatile("s_nop 1\n\tv_permlane16_swap_b32 %0, %1" : "+v"(a0), "+v"(b0));
                            asm volatile("s_nop 1\n\tv_permlane16_swap_b32 %0, %1" : "+v"(a1), "+v"(b1));
                            p0[e] = (fq & 1) ? a0 : b0; p1[e] = (fq & 1) ? a1 : b1; }
                        const f32x4 r0 = v0 * c0 + p0 * s0, r1 = v1 * c1 + p1 * s1;
                        if (rot) { v0 = r0; v1 = r1; }
                    }
                    if (act == 3) {
#pragma unroll
                        for (int e = 0; e < 4; ++e) { v0[e] = v0[e] * __builtin_amdgcn_rcpf(1.f + __builtin_amdgcn_exp2f(-1.4426950409f * v0[e])) * 0.08838834764831845f;
                                                       v1[e] = v1[e] * __builtin_amdgcn_rcpf(1.f + __builtin_amdgcn_exp2f(-1.4426950409f * v1[e])) * 0.08838834764831845f; }
                    } else if (act == 4) {
#pragma unroll
                        for (int e = 0; e < 4; ++e) { v0[e] = __builtin_amdgcn_rcpf(1.f + __builtin_amdgcn_exp2f(1.4426950409f * v0[e])); v1[e] = __builtin_amdgcn_rcpf(1.f + __builtin_amdgcn_exp2f(1.4426950409f * v1[e])); }
                    }
                    v0 = v0 * sc; v1 = v1 * sc;
                    u32x4 w; w.x = cvt_pk_bf16(v0[0], v0[1]); w.y = cvt_pk_bf16(v0[2], v0[3]); w.z = cvt_pk_bf16(v1[0], v1[1]); w.w = cvt_pk_bf16(v1[2], v1[3]);
                    *(u32x4*)(rowp + bj * HALF) = w;
                }
            }
    }
};

struct EpiConvGlu {
    static constexpr bool PERM = true, AFTER_DRAIN = false;
    bf16_t* G; const float* cw; const float* cb;
    __device__ __forceinline__ void operator()(f32x4 (&acc)[2][2][4][2], const Unit& u, int wr, int wc, int fr, int fq) const {
        const int chb = u.pn * 128 + wc * 32 + 8 * fq;
        bf16_t* G_ = G; const float* cw_ = cw; const float* cb_ = cb; asm volatile("" : "+s"(G_), "+s"(cw_), "+s"(cb_));
        f32x4 w0[2][2], w1[2][2], w2[2][2], bb[2][2];
#pragma unroll
        for (int bj = 0; bj < 2; ++bj)
#pragma unroll
            for (int n = 0; n < 2; ++n) { const int col = bj * 2816 + chb + 4 * n;
                w0[bj][n] = *(const f32x4*)(cw_ + col); w1[bj][n] = *(const f32x4*)(cw_ + 5632 + col); w2[bj][n] = *(const f32x4*)(cw_ + 2 * 5632 + col); bb[bj][n] = *(const f32x4*)(cb_ + col); }
#pragma unroll
        for (int ai = 0; ai < 2; ++ai) {
            const int tokb = 62 * (4 * u.pm + 2 * ai + wr) - 1 + 4 * fr;
            float pm_[4], nm_[4];
#pragma unroll
            for (int m = 0; m < 4; ++m) { const int t = tokb + m; const int msk = (t < 32768) ? 8191 : 4095; pm_[m] = ((t & msk) == 0) ? 0.f : 1.f; nm_[m] = ((t & msk) == msk) ? 0.f : 1.f; }
#pragma unroll
            for (int bj = 0; bj < 2; ++bj)
#pragma unroll
                for (int n = 0; n < 2; ++n) {
                    const f32x4 x0 = acc[ai][bj][0][n], x1 = acc[ai][bj][1][n], x2 = acc[ai][bj][2][n], x3 = acc[ai][bj][3][n];
                    f32x4 pv, nx;
#pragma unroll
                    for (int e = 0; e < 4; ++e) { float a_, b_;
                        asm volatile("s_nop 1\n\tv_mov_b32_dpp %0, %1 row_shr:1 row_mask:0xf bank_mask:0xf bound_ctrl:1" : "=&v"(a_) : "v"(x3[e]));
                        asm volatile("s_nop 1\n\tv_mov_b32_dpp %0, %1 row_shl:1 row_mask:0xf bank_mask:0xf bound_ctrl:1" : "=&v"(b_) : "v"(x0[e]));
                        pv[e] = a_; nx[e] = b_; }
                    acc[ai][bj][0][n] = bb[bj][n] + w0[bj][n] * (pv * pm_[0]) + w1[bj][n] * x0 + w2[bj][n] * (x1 * nm_[0]);
                    acc[ai][bj][1][n] = bb[bj][n] + w0[bj][n] * (x0 * pm_[1]) + w1[bj][n] * x1 + w2[bj][n] * (x2 * nm_[1]);
                    acc[ai][bj][2][n] = bb[bj][n] + w0[bj][n] * (x1 * pm_[2]) + w1[bj][n] * x2 + w2[bj][n] * (x3 * nm_[2]);
                    acc[ai][bj][3][n] = bb[bj][n] + w0[bj][n] * (x2 * pm_[3]) + w1[bj][n] * x3 + w2[bj][n] * (nx * nm_[3]);
                }
#pragma unroll
            for (int m = 0; m < 4; ++m) {
                const int pos = 4 * fr + m, t = tokb + m;
                unsigned wv[4];
#pragma unroll
                for (int n = 0; n < 2; ++n) { float o[4];
#pragma unroll
                    for (int e = 0; e < 4; ++e) { const float x = acc[ai][0][m][n][e]; const float z = -2.302208198f * (x + 0.044715f * x * x * x);
                        o[e] = x * __builtin_amdgcn_rcpf(1.f + __builtin_amdgcn_exp2f(z)) * acc[ai][1][m][n][e]; }
                    wv[2 * n] = cvt_pk_bf16(o[0], o[1]); wv[2 * n + 1] = cvt_pk_bf16(o[2], o[3]); }
                if (pos >= 1 && pos <= 62 && t < 65536) *(u32x4*)(G_ + (size_t)t * 2816 + chb) = (u32x4){wv[0], wv[1], wv[2], wv[3]};
            }
        }
    }
};
template <class Epi, class Sched, bool ALIGN_EPI = false, bool SP2 = false, bool APERM = false>
__device__ __forceinline__ void gemm_phase(PG8_LAS unsigned char* lds, const Gemm g, const Sched& S, const Epi& E) {
    int tid_l = threadIdx.x; asm volatile("" : "+v"(tid_l));
    const int tid = tid_l, wid = __builtin_amdgcn_readfirstlane(tid >> 6), lane = tid & 63, wr = wid >> 2, wc = wid & 3, fr = lane & 15, fq = lane >> 4;
    const int K = g.K, nt = K / BK;
    unsigned voffA[2], voffB[2];
#pragma unroll
    for (int i = 0; i < 2; ++i) { int R, C; stage_rc(tid * 16 + i * 8192, R, C); const int Rb = Epi::PERM ? ((R & ~31) + perm32(R & 31)) : R;
        const int Ra = APERM ? (62 * (R >> 6) + 4 * (R & 15) + ((R >> 4) & 3)) : R;
        voffA[i] = (unsigned)(Ra * K + C) * 2u; voffB[i] = (unsigned)(Rb * K + C) * 2u; }
    const size_t kstep = (size_t)(BK * 2);
    const size_t hstep = (size_t)HALF * K * 2;
    const size_t tstep = 2 * hstep;
    const size_t hstepA = APERM ? (size_t)124 * K * 2 : hstep, tstepA = 2 * hstepA;
    const unsigned ldsw = (unsigned)wid * 1024u;
    const int aoff = lds_byte(wr * 64 + fr, fq * 8), boff = lds_byte(wc * 32 + fr, fq * 8);
#define PG8_SA(b, h) (((b) * 2 + (h)) * HTB)
#define PG8_SB(b, h) ((4 + (b) * 2 + (h)) * HTB)
#define PG8_STAGE(bufoff, gbase, voff) do { _Pragma("unroll") for (int _i = 0; _i < 2; ++_i) \
        __builtin_amdgcn_global_load_lds((const unsigned*)((const char*)(gbase) + (voff)[_i]), (PG8_LAS unsigned*)(lds + (bufoff) + ldsw + _i * 8192), 16, 0, 0); } while (0)
#define PG8_LDA(dst, b, h) do { _Pragma("unroll") for (int m = 0; m < 4; ++m) _Pragma("unroll") for (int k = 0; k < 2; ++k) dst[m][k] = *(const PG8_LAS bf16x8*)(lds + PG8_SA(b, h) + aoff + m * 2048 + k * 1024); } while (0)
#define PG8_LDB(dst, b, h) do { _Pragma("unroll") for (int n = 0; n < 2; ++n) _Pragma("unroll") for (int k = 0; k < 2; ++k) dst[n][k] = *(const PG8_LAS bf16x8*)(lds + PG8_SB(b, h) + boff + n * 2048 + k * 1024); } while (0)
#define PG8_MMA(ai, bj, At, Bt) do { __builtin_amdgcn_s_setprio(1); _Pragma("unroll") for (int m = 0; m < 4; ++m) _Pragma("unroll") for (int n = 0; n < 2; ++n) _Pragma("unroll") for (int k = 0; k < 2; ++k) \
        acc[ai][bj][m][n] = __builtin_amdgcn_mfma_f32_16x16x32_bf16(Bt[n][k], At[m][k], acc[ai][bj][m][n], 0, 0, 0); __builtin_amdgcn_s_setprio(0); } while (0)
#define PG8_WAIT_V(n) asm volatile("s_waitcnt vmcnt(" #n ")" ::: "memory")
#define PG8_WAIT_L(n) asm volatile("s_waitcnt lgkmcnt(" #n ")" ::: "memory")
#define PG8_BAR __builtin_amdgcn_s_barrier()
#define PG8_SCHED __builtin_amdgcn_sched_barrier(0)
    Unit cur, nxt; int ui = 0;
    if (!S.next(0, cur)) return;
    f32x4 acc[2][2][4][2];
#pragma unroll
    for (int a = 0; a < 2; ++a)
#pragma unroll
        for (int b = 0; b < 2; ++b)
#pragma unroll
            for (int m = 0; m < 4; ++m)
#pragma unroll
                for (int n = 0; n < 2; ++n) acc[a][b][m][n] = (f32x4){0.f, 0.f, 0.f, 0.f};
    bf16x8 At[4][2], B0[2][2], B1[2][2];
    const char* cA = (const char*)g.A + (size_t)cur.pm * tstepA; const char* cB = (const char*)g.Bt + (size_t)cur.pn * tstep;
    S.a_ready(cur);
    if constexpr (SP2) {
        PG8_STAGE(PG8_SB(0, 0), cB, voffB); PG8_STAGE(PG8_SB(0, 1), cB + hstep, voffB); PG8_STAGE(PG8_SA(0, 0), cA, voffA); PG8_STAGE(PG8_SA(0, 1), cA + hstepA, voffA);
        if (wr == 1) PG8_BAR;
        PG8_WAIT_V(2); PG8_BAR;
        PG8_STAGE(PG8_SB(1, 0), cB + kstep, voffB); PG8_STAGE(PG8_SA(1, 0), cA + kstep, voffA); PG8_STAGE(PG8_SB(1, 1), cB + hstep + kstep, voffB);
        PG8_WAIT_V(6); PG8_BAR;
    } else {
        PG8_STAGE(PG8_SB(0, 0), cB, voffB); PG8_STAGE(PG8_SA(0, 0), cA, voffA); PG8_STAGE(PG8_SB(0, 1), cB + hstep, voffB); PG8_STAGE(PG8_SA(0, 1), cA + hstepA, voffA);
        if (wr == 1) PG8_BAR;
        PG8_WAIT_V(4); PG8_BAR;
        PG8_STAGE(PG8_SB(1, 0), cB + kstep, voffB); PG8_STAGE(PG8_SA(1, 0), cA + kstep, voffA); PG8_STAGE(PG8_SB(1, 1), cB + hstep + kstep, voffB);
        PG8_WAIT_V(6); PG8_BAR;
    }
    for (;;) {
        const bool has_next = S.next(ui + 1, nxt);
        const char* nA = has_next ? (const char*)g.A + (size_t)nxt.pm * tstepA : cA; const char* nB = has_next ? (const char*)g.Bt + (size_t)nxt.pn * tstep : cB;
        for (int t = 0; t < nt; t += 2) {
            const bool last = (t == nt - 2);
            const char* a1 = cA + (size_t)(t + 1) * kstep;
            const char* a2 = last ? nA : cA + (size_t)(t + 2) * kstep; const char* b2 = last ? nB : cB + (size_t)(t + 2) * kstep;
            const char* a3 = a2 + kstep; const char* b3 = b2 + kstep;
            if (last && has_next) S.a_ready(nxt);
            if constexpr (SP2) {
            PG8_LDB(B0, 0, 0); PG8_LDB(B1, 0, 1); PG8_SCHED; PG8_LDA(At, 0, 0); PG8_STAGE(PG8_SA(1, 1), a1 + hstepA, voffA);
            PG8_WAIT_V(8); PG8_WAIT_L(0); PG8_BAR; PG8_MMA(0, 0, At, B0); PG8_MMA(0, 1, At, B1); PG8_BAR; PG8_SCHED;
            PG8_LDA(At, 0, 1); PG8_STAGE(PG8_SB(0, 0), b2, voffB); PG8_STAGE(PG8_SB(0, 1), b2 + hstep, voffB); PG8_STAGE(PG8_SA(0, 0), a2, voffA);
            PG8_WAIT_V(8); PG8_WAIT_L(0); PG8_BAR; PG8_MMA(1, 0, At, B0); PG8_MMA(1, 1, At, B1); PG8_BAR; PG8_SCHED;
            PG8_LDB(B0, 1, 0); PG8_LDB(B1, 1, 1); PG8_SCHED; PG8_LDA(At, 1, 0); PG8_STAGE(PG8_SA(0, 1), a2 + hstepA, voffA);
            PG8_WAIT_V(8); PG8_WAIT_L(0); PG8_BAR; PG8_MMA(0, 0, At, B0); PG8_MMA(0, 1, At, B1); PG8_BAR; PG8_SCHED;
            PG8_LDA(At, 1, 1); PG8_STAGE(PG8_SB(1, 0), b3, voffB); PG8_STAGE(PG8_SB(1, 1), b3 + hstep, voffB); PG8_STAGE(PG8_SA(1, 0), a3, voffA);
            PG8_WAIT_V(8); PG8_WAIT_L(0); PG8_BAR; PG8_MMA(1, 0, At, B0); PG8_MMA(1, 1, At, B1); PG8_BAR; PG8_SCHED;
            } else {
            PG8_LDB(B0, 0, 0); PG8_SCHED; PG8_LDA(At, 0, 0); PG8_STAGE(PG8_SA(1, 1), a1 + hstepA, voffA);
            PG8_WAIT_L(8); PG8_BAR; PG8_WAIT_L(0); PG8_MMA(0, 0, At, B0); PG8_BAR; PG8_SCHED;
            PG8_LDB(B1, 0, 1); PG8_STAGE(PG8_SB(0, 0), b2, voffB);
            PG8_BAR; PG8_WAIT_L(0); PG8_MMA(0, 1, At, B1); PG8_BAR;
            PG8_LDA(At, 0, 1); PG8_STAGE(PG8_SA(0, 0), a2, voffA);
            PG8_BAR; PG8_WAIT_L(0); PG8_MMA(1, 0, At, B0); PG8_BAR; PG8_SCHED;
            PG8_STAGE(PG8_SB(0, 1), b2 + hstep, voffB);
            PG8_WAIT_V(6); PG8_BAR; PG8_MMA(1, 1, At, B1); PG8_BAR;
            PG8_LDB(B0, 1, 0); PG8_SCHED; PG8_LDA(At, 1, 0); PG8_STAGE(PG8_SA(0, 1), a2 + hstepA, voffA);
            PG8_WAIT_L(8); PG8_BAR; PG8_WAIT_L(0); PG8_MMA(0, 0, At, B0); PG8_BAR; PG8_SCHED;
            PG8_LDB(B1, 1, 1); PG8_STAGE(PG8_SB(1, 0), b3, voffB);
            PG8_BAR; PG8_WAIT_L(0); PG8_MMA(0, 1, At, B1); PG8_BAR;
            PG8_LDA(At, 1, 1); PG8_STAGE(PG8_SA(1, 0), a3, voffA);
            PG8_BAR; PG8_WAIT_L(0); PG8_MMA(1, 0, At, B0); PG8_BAR; PG8_SCHED;
            PG8_STAGE(PG8_SB(1, 1), b3 + hstep, voffB);
            PG8_WAIT_V(6); PG8_BAR; PG8_MMA(1, 1, At, B1); PG8_BAR;
            }
        }
        if constexpr (ALIGN_EPI) { if (wr == 0) PG8_BAR; }
        if constexpr (!Epi::AFTER_DRAIN) { E(acc, cur, wr, wc, fr, fq); S.done(cur); }
        if (!has_next) break;
#pragma unroll
        for (int a = 0; a < 2; ++a)
#pragma unroll
            for (int b = 0; b < 2; ++b)
#pragma unroll
                for (int m = 0; m < 4; ++m)
#pragma unroll
                    for (int n = 0; n < 2; ++n) acc[a][b][m][n] = (f32x4){0.f, 0.f, 0.f, 0.f};
        cur = nxt; cA = nA; cB = nB; ++ui;
        if constexpr (ALIGN_EPI) { if (wr == 1) PG8_BAR; }
    }
    PG8_WAIT_V(0);
    if constexpr (!ALIGN_EPI) { if (wr == 0) PG8_BAR; }
    PG8_BAR;
    if constexpr (Epi::AFTER_DRAIN) { E.fused(acc, cur, wr, wc, fr, fq, lds, wid, lane); S.done(cur); }
#undef PG8_SA
#undef PG8_SB
#undef PG8_STAGE
#undef PG8_LDA
#undef PG8_LDB
#undef PG8_MMA
#undef PG8_WAIT_V
#undef PG8_WAIT_L
#undef PG8_BAR
#undef PG8_SCHED
}
}

#define LAS __attribute__((address_space(3)))
typedef unsigned short bf16_t;
typedef short bf16x8 __attribute__((ext_vector_type(8)));
typedef short s16x4 __attribute__((ext_vector_type(4)));
typedef float f32x16 __attribute__((ext_vector_type(16)));
typedef float f32x4 __attribute__((ext_vector_type(4)));
typedef float f32x2 __attribute__((ext_vector_type(2)));
typedef unsigned u32x4 __attribute__((ext_vector_type(4)));
typedef unsigned u32x2 __attribute__((ext_vector_type(2)));
typedef __bf16 bf16x2_t __attribute__((ext_vector_type(2)));
typedef LAS unsigned char* ldsp;

constexpr int M_TOK = 65536, MH = 32768, DM = 1024, DFF = 2816;
constexpr float C2 = 0.125f * 1.4426950408889634f;
constexpr size_t MiB = 1u << 20;
constexpr size_t WS_ROPE = 0;
constexpr size_t WS_OML = 512 * 1024;
constexpr size_t WS_BAR = 768 * 1024;
constexpr size_t WS_W = 1 * MiB;
constexpr size_t WS_H = 117 * MiB;
constexpr size_t WS_Y = 245 * MiB;
constexpr size_t WS_BIG = 373 * MiB;
constexpr size_t WS_END = 1013 * MiB;
constexpr size_t WE_AQKV = 0, WE_AO = WE_AQKV + 2ull * 3072 * 1024, WE_BQKV = WE_AO + 2ull * 1024 * 1024, WE_BO = WE_BQKV + 9216ull * 1024,
                 WE_CIN = WE_BO + 1024ull * 1024, WE_CO = WE_CIN + 5120ull * 1024, WE_FIN = WE_CO + 1024ull * 1024, WE_FOUT = WE_FIN + 4ull * 5632 * 1024,
                 WE_END = WE_FOUT + 4ull * 2816 * 1024;
static_assert(WE_END * 2 <= 116 * MiB, "weights fit");

struct Params { const float* in[17]; float* out; unsigned char* ws; double invf[8]; int pad0, pad1; };

__device__ __forceinline__ float bflo(unsigned u) { return __uint_as_float(u << 16); }
__device__ __forceinline__ float bfhi(unsigned u) { return __uint_as_float(u & 0xffff0000u); }
__device__ __forceinline__ unsigned pkbf(float lo, float hi) { f32x2 v = {lo, hi}; bf16x2_t b = __builtin_convertvector(v, bf16x2_t); return __builtin_bit_cast(unsigned, b); }
__device__ __forceinline__ float dppf(float v, int ctrl_xor1) { return v; }
#define DPPF(v, ctrl) __builtin_bit_cast(float, __builtin_amdgcn_update_dpp(0, __builtin_bit_cast(int, (v)), (ctrl), 0xf, 0xf, false))
__device__ __forceinline__ float swap16_sum(float m) { auto rr = __builtin_amdgcn_permlane16_swap(__float_as_uint(m), __float_as_uint(m), false, false); return __uint_as_float(rr[0]) + __uint_as_float(rr[1]); }
__device__ __forceinline__ float swap32_sum(float m) { auto rr = __builtin_amdgcn_permlane32_swap(__float_as_uint(m), __float_as_uint(m), false, false); return __uint_as_float(rr[0]) + __uint_as_float(rr[1]); }
__device__ __forceinline__ float wave_sum(float v) {
  v += DPPF(v, 0xB1); v += DPPF(v, 0x4E); v += DPPF(v, 0x124); v += DPPF(v, 0x128);
  v = swap16_sum(v); v = swap32_sum(v);
  return v;
}
__device__ __forceinline__ int fresh_tid() { int t = threadIdx.x; asm volatile("" : "+v"(t)); return t; }
typedef const Params __attribute__((address_space(4)))* CParamsPtr;
__device__ __forceinline__ CParamsPtr kargs() { CParamsPtr kp = (CParamsPtr)__builtin_amdgcn_kernarg_segment_ptr(); asm volatile("" : "+s"(kp)); return kp; }
__device__ __forceinline__ float half_swap_max(float m) { auto rr = __builtin_amdgcn_permlane32_swap(__float_as_uint(m), __float_as_uint(m), false, false); return fmaxf(__uint_as_float(rr[0]), __uint_as_float(rr[1])); }
__device__ __forceinline__ float half_swap_sum(float m) { auto rr = __builtin_amdgcn_permlane32_swap(__float_as_uint(m), __float_as_uint(m), false, false); return __uint_as_float(rr[0]) + __uint_as_float(rr[1]); }

__device__ __forceinline__ void transpose_item(const float* W, int K, int N, bf16_t* WT, LAS float* scr, int item, int lane, bool glu) {
  const int nblk = N / 32, kb = item / nblk, nb = item % nblk, k0 = 64 * kb, n0 = 32 * nb;
#pragma unroll 8
  for (int i = 0; i < 32; ++i) { const int kk = 2 * i + (lane >> 5); scr[kk * 33 + (lane & 31)] = W[(size_t)(k0 + kk) * N + n0 + (lane & 31)]; }
  asm volatile("s_waitcnt lgkmcnt(0)" ::: "memory");
  const int c = lane & 7;
#pragma unroll
  for (int j = 0; j < 4; ++j) { const int n = (lane >> 3) + 8 * j; const LAS float* s = scr + (8 * c) * 33 + n;
    u32x4 o; o.x = pkbf(s[0 * 33], s[1 * 33]); o.y = pkbf(s[2 * 33], s[3 * 33]); o.z = pkbf(s[4 * 33], s[5 * 33]); o.w = pkbf(s[6 * 33], s[7 * 33]);
    int nr = n0 + n; if (glu) { const int bj = nr >= 2816 ? 1 : 0, cc = nr - 2816 * bj; nr = 256 * (cc >> 7) + 128 * bj + (cc & 127); }
    *(u32x4*)(WT + (size_t)nr * K + k0 + 8 * c) = o; }
  asm volatile("s_waitcnt lgkmcnt(0)" ::: "memory");
}
__device__ __forceinline__ void transpose_mat(const float* W, int K, int N, bf16_t* WT, LAS float* scr, int gw, int ngw, int lane, bool glu) {
  const int items = (K / 64) * (N / 32);
  for (int it = gw; it < items; it += ngw) transpose_item(W, K, N, WT, scr, it, lane, glu);
}

__device__ __forceinline__ float row_rstd(const f32x4 (&v)[4], float eps) {
  float s = 0.f;
#pragma unroll
  for (int j = 0; j < 4; ++j) s += (v[j].x * v[j].x + v[j].y * v[j].y) + (v[j].z * v[j].z + v[j].w * v[j].w);
  return rsqrtf(wave_sum(s) * (1.f / 1024.f) + eps);
}
__device__ __forceinline__ void store_h_row(bf16_t* hrow, const f32x4 (&v)[4], float rstd, const float* g, int lane) {
#pragma unroll
  for (int j = 0; j < 4; ++j) { const f32x4 gg = *(const f32x4*)(g + 4 * lane + 256 * j);
    u32x2 w; w.x = pkbf(v[j].x * rstd * gg.x, v[j].y * rstd * gg.y); w.y = pkbf(v[j].z * rstd * gg.z, v[j].w * rstd * gg.w);
    *(u32x2*)(hrow + 4 * lane + 256 * j) = w; }
}
__device__ __forceinline__ void phase_init_norm(const float* xp, const float* xs, float* x, bf16_t* H, const float* g, int gw, int ngw, int lane) {
  for (int m = gw; m < M_TOK; m += ngw) {
    const float* src = (m < MH) ? xp + (size_t)m * DM : xs + (size_t)(m - MH) * DM;
    f32x4 v[4];
#pragma unroll
    for (int j = 0; j < 4; ++j) v[j] = *(const f32x4*)(src + 4 * lane + 256 * j);
    store_h_row(H + (size_t)m * DM, v, row_rstd(v, 1e-6f), g, lane);
  }
}
__device__ __forceinline__ void phase_res_norm(const bf16_t* Y, float* x, bf16_t* H, const float* gA, const float* gB, int gw, int ngw, int lane, const float* xp, const float* xs) {
  float ga_[2][8], gb_[2][8];
#pragma unroll
  for (int j = 0; j < 2; ++j) { const f32x4 g0 = *(const f32x4*)(gA + 8 * lane + 512 * j), g1 = *(const f32x4*)(gA + 8 * lane + 512 * j + 4);
    ga_[j][0] = g0.x; ga_[j][1] = g0.y; ga_[j][2] = g0.z; ga_[j][3] = g0.w; ga_[j][4] = g1.x; ga_[j][5] = g1.y; ga_[j][6] = g1.z; ga_[j][7] = g1.w;
    const float* gq = gB ? gB : gA; const f32x4 h0 = *(const f32x4*)(gq + 8 * lane + 512 * j), h1 = *(const f32x4*)(gq + 8 * lane + 512 * j + 4);
    gb_[j][0] = h0.x; gb_[j][1] = h0.y; gb_[j][2] = h0.z; gb_[j][3] = h0.w; gb_[j][4] = h1.x; gb_[j][5] = h1.y; gb_[j][6] = h1.z; gb_[j][7] = h1.w; }
  for (int m = gw; m < M_TOK; m += ngw) {
    bf16_t* xb = (bf16_t*)((char*)x + (size_t)m * 4096 + 2048);
    float y[2][8], v[2][8];
#pragma unroll
    for (int j = 0; j < 2; ++j) { const u32x4 w = *(const u32x4*)(Y + (size_t)m * DM + 8 * lane + 512 * j);
      y[j][0] = bflo(w.x); y[j][1] = bfhi(w.x); y[j][2] = bflo(w.y); y[j][3] = bfhi(w.y); y[j][4] = bflo(w.z); y[j][5] = bfhi(w.z); y[j][6] = bflo(w.w); y[j][7] = bfhi(w.w); }
    if (xp) { const float* xsrc = (m < MH) ? xp + (size_t)m * DM : xs + (size_t)(m - MH) * DM;
#pragma unroll
      for (int j = 0; j < 2; ++j) { const f32x4 a = *(const f32x4*)(xsrc + 8 * lane + 512 * j), c = *(const f32x4*)(xsrc + 8 * lane + 512 * j + 4);
        v[j][0] = a.x; v[j][1] = a.y; v[j][2] = a.z; v[j][3] = a.w; v[j][4] = c.x; v[j][5] = c.y; v[j][6] = c.z; v[j][7] = c.w; }
    } else {
#pragma unroll
      for (int j = 0; j < 2; ++j) { const u32x4 w = *(const u32x4*)(xb + 8 * lane + 512 * j);
        v[j][0] = bflo(w.x); v[j][1] = bfhi(w.x); v[j][2] = bflo(w.y); v[j][3] = bfhi(w.y); v[j][4] = bflo(w.z); v[j][5] = bfhi(w.z); v[j][6] = bflo(w.w); v[j][7] = bfhi(w.w); }
    }
    float sy = 0.f;
#pragma unroll
    for (int j = 0; j < 2; ++j)
#pragma unroll
      for (int e = 0; e < 8; ++e) sy += y[j][e] * y[j][e];
    const float ry = rsqrtf(wave_sum(sy) * (1.f / 1024.f) + 1e-6f);
    float sv = 0.f;
#pragma unroll
    for (int j = 0; j < 2; ++j)
#pragma unroll
      for (int e = 0; e < 8; ++e) { v[j][e] += y[j][e] * ry * ga_[j][e]; sv += v[j][e] * v[j][e]; }
    if (gB) {
      const float rx = rsqrtf(wave_sum(sv) * (1.f / 1024.f) + 1e-6f);
#pragma unroll
      for (int j = 0; j < 2; ++j) {
        u32x4 w; w.x = pkbf(v[j][0], v[j][1]); w.y = pkbf(v[j][2], v[j][3]); w.z = pkbf(v[j][4], v[j][5]); w.w = pkbf(v[j][6], v[j][7]);
        *(u32x4*)(xb + 8 * lane + 512 * j) = w;
        u32x4 h; h.x = pkbf(v[j][0] * rx * gb_[j][0], v[j][1] * rx * gb_[j][1]); h.y = pkbf(v[j][2] * rx * gb_[j][2], v[j][3] * rx * gb_[j][3]); h.z = pkbf(v[j][4] * rx * gb_[j][4], v[j][5] * rx * gb_[j][5]); h.w = pkbf(v[j][6] * rx * gb_[j][6], v[j][7] * rx * gb_[j][7]);
        *(u32x4*)(H + (size_t)m * DM + 8 * lane + 512 * j) = h; }
    } else {
#pragma unroll
      for (int j = 0; j < 2; ++j) { *(f32x4*)(x + (size_t)m * DM + 8 * lane + 512 * j) = (f32x4){v[j][0], v[j][1], v[j][2], v[j][3]}; *(f32x4*)(x + (size_t)m * DM + 8 * lane + 512 * j + 4) = (f32x4){v[j][4], v[j][5], v[j][6], v[j][7]}; }
    }
  }
}

__device__ __forceinline__ void rope_seg(bf16_t* pp, int pos, float sc, const float* rope, int lane) {
  u32x4 a = *(const u32x4*)pp, b = *(const u32x4*)(pp + 8);
  float x1[8] = {bflo(a.x), bfhi(a.x), bflo(a.y), bfhi(a.y), bflo(a.z), bfhi(a.z), bflo(a.w), bfhi(a.w)};
  float x2[8] = {bflo(b.x), bfhi(b.x), bflo(b.y), bfhi(b.y), bflo(b.z), bfhi(b.z), bflo(b.w), bfhi(b.w)};
  if ((lane & 3) == 0) { const float* cs = rope + (size_t)pos * 16;
#pragma unroll
    for (int i = 0; i < 8; ++i) { const float c = cs[i], s = cs[8 + i]; const float u = x1[i] * c - x2[i] * s, w = x2[i] * c + x1[i] * s; x1[i] = u; x2[i] = w; } }
  a.x = pkbf(x1[0] * sc, x1[1] * sc); a.y = pkbf(x1[2] * sc, x1[3] * sc); a.z = pkbf(x1[4] * sc, x1[5] * sc); a.w = pkbf(x1[6] * sc, x1[7] * sc);
  b.x = pkbf(x2[0] * sc, x2[1] * sc); b.y = pkbf(x2[2] * sc, x2[3] * sc); b.z = pkbf(x2[4] * sc, x2[5] * sc); b.w = pkbf(x2[6] * sc, x2[7] * sc);
  *(u32x4*)pp = a; *(u32x4*)(pp + 8) = b;
}

__device__ __forceinline__ s16x4 vtr(ldsp p) { typedef short v4i16_t __attribute__((ext_vector_type(4))); return __builtin_bit_cast(s16x4, __builtin_amdgcn_ds_read_tr16_b64_v4i16((LAS v4i16_t*)p)); }
__device__ __forceinline__ int voffa(int row, int ch) { return 2048 * (row >> 3) + 512 * (ch >> 2) + 64 * (row & 7) + 16 * ((ch & 3) ^ ((row >> 2) & 3)); }
__device__ __forceinline__ int koff(int row, int ch) { return 128 * row + ((ch ^ ((row >> 1) & 7)) << 4); }
__device__ __forceinline__ f32x16 qk_block(ldsp Kt, const int (&ko)[4], const bf16x8 (&qf)[4]) {
  f32x16 acc = {0.f, 0.f, 0.f, 0.f, 0.f, 0.f, 0.f, 0.f, 0.f, 0.f, 0.f, 0.f, 0.f, 0.f, 0.f, 0.f};
#pragma unroll
  for (int ds = 0; ds < 4; ++ds) { const bf16x8 kf = *(const LAS bf16x8*)(Kt + ko[ds]); acc = __builtin_amdgcn_mfma_f32_32x32x16_bf16(kf, qf[ds], acc, 0, 0, 0); }
  return acc;
}
__device__ __forceinline__ void k_load(bf16x8 (&kf)[4], ldsp Kt, const int (&ko)[4]) {
#pragma unroll
  for (int ds = 0; ds < 4; ++ds) kf[ds] = *(const LAS bf16x8*)(Kt + ko[ds]);
}
__device__ __forceinline__ f32x16 qk_frag(const bf16x8 (&kf)[4], const bf16x8 (&qf)[4]) {
  f32x16 acc = {0.f, 0.f, 0.f, 0.f, 0.f, 0.f, 0.f, 0.f, 0.f, 0.f, 0.f, 0.f, 0.f, 0.f, 0.f, 0.f};
#pragma unroll
  for (int ds = 0; ds < 4; ++ds) acc = __builtin_amdgcn_mfma_f32_32x32x16_bf16(kf[ds], qf[ds], acc, 0, 0, 0);
  return acc;
}
constexpr float BIGSUM = 1.0995116e12f;
template <int NDB> __device__ __forceinline__ void softmax_block(f32x16& s, float& m, float& l, f32x16 (&o)[NDB], bf16x8 (&p)[2]) {
  if (__all(m == 0.f)) {
#pragma unroll
    for (int r = 0; r < 16; ++r) s[r] = __builtin_amdgcn_exp2f(s[r]);
  } else {
#pragma unroll
    for (int r = 0; r < 16; ++r) s[r] = __builtin_amdgcn_exp2f(s[r] - m);
  }
  float sum = 0.f;
#pragma unroll
  for (int r = 0; r < 16; ++r) sum += s[r];
  const float tot = half_swap_sum(sum);
  if (__any(!(tot <= BIGSUM))) {
    float mx = s[0];
#pragma unroll
    for (int r = 1; r < 16; ++r) mx = fmaxf(mx, s[r]);
    mx = half_swap_max(mx);
    const float dl = (tot <= BIGSUM) ? 0.f : __log2f(fminf(mx, 3.0e38f)); m += dl;
    const float f = __builtin_amdgcn_exp2f(-dl); l *= f; sum *= f;
#pragma unroll
    for (int r = 0; r < 16; ++r) s[r] *= f;
#pragma unroll
    for (int d = 0; d < NDB; ++d)
#pragma unroll
      for (int r = 0; r < 16; ++r) o[d][r] *= f;
  }
  l += sum;
  u32x4 w0, w1;
  w0.x = pkbf(s[0], s[1]); w0.y = pkbf(s[2], s[3]); w0.z = pkbf(s[4], s[5]); w0.w = pkbf(s[6], s[7]);
  w1.x = pkbf(s[8], s[9]); w1.y = pkbf(s[10], s[11]); w1.z = pkbf(s[12], s[13]); w1.w = pkbf(s[14], s[15]);
  p[0] = __builtin_bit_cast(bf16x8, w0); p[1] = __builtin_bit_cast(bf16x8, w1);
}
template <int DV, bool TWO> __device__ __forceinline__ void pv_block(ldsp Vt, int vb0, int vb1, const bf16x8 (&p0)[2], const bf16x8 (&p1)[2], f32x16 (&o0)[DV / 32], f32x16 (&o1)[DV / 32]) {
  constexpr int NDB = DV / 32, NST = 2 * NDB;
#define PV_I0(i) ((DV == 128) ? 2048 * (2 * ((i) / NDB)) + 512 * ((i) % NDB) : 128 * (16 * ((i) / NDB)) + 64 * ((i) % NDB))
#define PV_I1(i) ((DV == 128) ? 2048 * (2 * ((i) / NDB) + 1) + 512 * ((i) % NDB) : 128 * (16 * ((i) / NDB) + 8) + 64 * ((i) % NDB))
#define PV_RD(dl, dh, i) do { asm volatile("ds_read_b64_tr_b16 %0, %1 offset:%c2" : "=&v"(dl) : "v"(a0), "i"(PV_I0(i)) : "memory"); \
                              asm volatile("ds_read_b64_tr_b16 %0, %1 offset:%c2" : "=&v"(dh) : "v"(a1), "i"(PV_I1(i)) : "memory"); } while (0)
  const unsigned a0 = (unsigned)(unsigned long)(Vt + vb0), a1 = (unsigned)(unsigned long)(Vt + vb1);
  s16x4 lo[2], hh[2];
  PV_RD(lo[0], hh[0], 0);
#pragma unroll
  for (int i = 0; i < NST; ++i) {
    if (i + 1 < NST) { PV_RD(lo[(i + 1) & 1], hh[(i + 1) & 1], i + 1); asm volatile("s_waitcnt lgkmcnt(2)" ::: "memory"); }
    else asm volatile("s_waitcnt lgkmcnt(0)" ::: "memory");
    __builtin_amdgcn_sched_barrier(0);
    const s16x4 l_ = lo[i & 1], h_ = hh[i & 1];
    const bf16x8 a = {l_[0], l_[1], l_[2], l_[3], h_[0], h_[1], h_[2], h_[3]};
    const int s = i / NDB, db = i % NDB;
    o0[db] = __builtin_amdgcn_mfma_f32_32x32x16_bf16(a, p0[s], o0[db], 0, 0, 0);
    if (TWO) o1[db] = __builtin_amdgcn_mfma_f32_32x32x16_bf16(a, p1[s], o1[db], 0, 0, 0);
    __builtin_amdgcn_sched_barrier(0);
  }
#undef PV_I0
#undef PV_I1
#undef PV_RD
}

__device__ __forceinline__ void sm_pv(f32x16& s, float& m, float& l, f32x16 (&oself)[4], bf16x8 (&pout)[2], ldsp Vt, int vb0, int vb1, const bf16x8 (&pin)[2], f32x16 (&oacc)[4]) {
  if (!__all(m == 0.f)) {
#pragma unroll
    for (int r = 0; r < 16; ++r) s[r] -= m;
  }
#define SP_I0(i) (2048 * (2 * ((i) / 4)) + 512 * ((i) % 4))
#define SP_I1(i) (2048 * (2 * ((i) / 4) + 1) + 512 * ((i) % 4))
#define SP_RD(dl, dh, i) do { asm volatile("ds_read_b64_tr_b16 %0, %1 offset:%c2" : "=&v"(dl) : "v"(a0), "i"(SP_I0(i)) : "memory"); \
                              asm volatile("ds_read_b64_tr_b16 %0, %1 offset:%c2" : "=&v"(dh) : "v"(a1), "i"(SP_I1(i)) : "memory"); } while (0)
  const unsigned a0 = (unsigned)(unsigned long)(Vt + vb0), a1 = (unsigned)(unsigned long)(Vt + vb1);
  s16x4 lo[2], hh[2];
  SP_RD(lo[0], hh[0], 0);
#pragma unroll
  for (int i = 0; i < 8; ++i) {
    if (i + 1 < 8) { SP_RD(lo[(i + 1) & 1], hh[(i + 1) & 1], i + 1); asm volatile("s_waitcnt lgkmcnt(2)" ::: "memory"); }
    else asm volatile("s_waitcnt lgkmcnt(0)" ::: "memory");
    __builtin_amdgcn_sched_barrier(0);
    const s16x4 l_ = lo[i & 1], h_ = hh[i & 1];
    const bf16x8 a = {l_[0], l_[1], l_[2], l_[3], h_[0], h_[1], h_[2], h_[3]};
    oacc[i % 4] = __builtin_amdgcn_mfma_f32_32x32x16_bf16(a, pin[i / 4], oacc[i % 4], 0, 0, 0);
    s[2 * i] = __builtin_amdgcn_exp2f(s[2 * i]); s[2 * i + 1] = __builtin_amdgcn_exp2f(s[2 * i + 1]);
    __builtin_amdgcn_sched_barrier(0);
  }
#undef SP_I0
#undef SP_I1
#undef SP_RD
  float sum = 0.f;
#pragma unroll
  for (int r = 0; r < 16; ++r) sum += s[r];
  const float tot = half_swap_sum(sum);
  if (__any(!(tot <= BIGSUM))) {
    float mx = s[0];
#pragma unroll
    for (int r = 1; r < 16; ++r) mx = fmaxf(mx, s[r]);
    mx = half_swap_max(mx);
    const float dl = (tot <= BIGSUM) ? 0.f : __log2f(fminf(mx, 3.0e38f)); m += dl;
    const float f = __builtin_amdgcn_exp2f(-dl); l *= f; sum *= f;
#pragma unroll
    for (int r = 0; r < 16; ++r) s[r] *= f;
#pragma unroll
    for (int d = 0; d < 4; ++d)
#pragma unroll
      for (int r = 0; r < 16; ++r) oself[d][r] *= f;
  }
  l += sum;
  u32x4 w0, w1;
  w0.x = pkbf(s[0], s[1]); w0.y = pkbf(s[2], s[3]); w0.z = pkbf(s[4], s[5]); w0.w = pkbf(s[6], s[7]);
  w1.x = pkbf(s[8], s[9]); w1.y = pkbf(s[10], s[11]); w1.z = pkbf(s[12], s[13]); w1.w = pkbf(s[14], s[15]);
  pout[0] = __builtin_bit_cast(bf16x8, w0); pout[1] = __builtin_bit_cast(bf16x8, w1);
}

__device__ __forceinline__ void sm_finish(f32x16& s, float& m, float& l, f32x16 (&oself)[4], bf16x8 (&pout)[2]) {
  float sum = 0.f;
#pragma unroll
  for (int r = 0; r < 16; ++r) sum += s[r];
  const float tot = half_swap_sum(sum);
  if (__any(!(tot <= BIGSUM))) {
    float mx = s[0];
#pragma unroll
    for (int r = 1; r < 16; ++r) mx = fmaxf(mx, s[r]);
    mx = half_swap_max(mx);
    const float dl = (tot <= BIGSUM) ? 0.f : __log2f(fminf(mx, 3.0e38f)); m += dl;
    const float f = __builtin_amdgcn_exp2f(-dl); l *= f; sum *= f;
#pragma unroll
    for (int r = 0; r < 16; ++r) s[r] *= f;
#pragma unroll
    for (int d = 0; d < 4; ++d)
#pragma unroll
      for (int r = 0; r < 16; ++r) oself[d][r] *= f;
  }
  l += sum;
  u32x4 w0, w1;
  w0.x = pkbf(s[0], s[1]); w0.y = pkbf(s[2], s[3]); w0.z = pkbf(s[4], s[5]); w0.w = pkbf(s[6], s[7]);
  w1.x = pkbf(s[8], s[9]); w1.y = pkbf(s[10], s[11]); w1.z = pkbf(s[12], s[13]); w1.w = pkbf(s[14], s[15]);
  pout[0] = __builtin_bit_cast(bf16x8, w0); pout[1] = __builtin_bit_cast(bf16x8, w1);
}
__device__ __forceinline__ void pv2_sm2(f32x16& s0, f32x16& s1, float m0, float m1, ldsp Vt, int vb0, int vb1, const bf16x8 (&p0)[2], const bf16x8 (&p1)[2], f32x16 (&o0)[4], f32x16 (&o1)[4]) {
  if (!__all((m0 == 0.f) && (m1 == 0.f))) {
#pragma unroll
    for (int r = 0; r < 16; ++r) { s0[r] -= m0; s1[r] -= m1; }
  }
#define SP_I0(i) (2048 * (2 * ((i) / 4)) + 512 * ((i) % 4))
#define SP_I1(i) (2048 * (2 * ((i) / 4) + 1) + 512 * ((i) % 4))
#define SP_RD(dl, dh, i) do { asm volatile("ds_read_b64_tr_b16 %0, %1 offset:%c2" : "=&v"(dl) : "v"(a0), "i"(SP_I0(i)) : "memory"); \
                              asm volatile("ds_read_b64_tr_b16 %0, %1 offset:%c2" : "=&v"(dh) : "v"(a1), "i"(SP_I1(i)) : "memory"); } while (0)
  const unsigned a0 = (unsigned)(unsigned long)(Vt + vb0), a1 = (unsigned)(unsigned long)(Vt + vb1);
  s16x4 lo[2], hh[2];
  SP_RD(lo[0], hh[0], 0);
#pragma unroll
  for (int i = 0; i < 8; ++i) {
    if (i + 1 < 8) { SP_RD(lo[(i + 1) & 1], hh[(i + 1) & 1], i + 1); asm volatile("s_waitcnt lgkmcnt(2)" ::: "memory"); }
    else asm volatile("s_waitcnt lgkmcnt(0)" ::: "memory");
    __builtin_amdgcn_sched_barrier(0);
    const s16x4 l_ = lo[i & 1], h_ = hh[i & 1];
    const bf16x8 a = {l_[0], l_[1], l_[2], l_[3], h_[0], h_[1], h_[2], h_[3]};
    o0[i % 4] = __builtin_amdgcn_mfma_f32_32x32x16_bf16(a, p0[i / 4], o0[i % 4], 0, 0, 0);
    s0[2 * i] = __builtin_amdgcn_exp2f(s0[2 * i]); s0[2 * i + 1] = __builtin_amdgcn_exp2f(s0[2 * i + 1]);
    __builtin_amdgcn_sched_barrier(0);
    o1[i % 4] = __builtin_amdgcn_mfma_f32_32x32x16_bf16(a, p1[i / 4], o1[i % 4], 0, 0, 0);
    s1[2 * i] = __builtin_amdgcn_exp2f(s1[2 * i]); s1[2 * i + 1] = __builtin_amdgcn_exp2f(s1[2 * i + 1]);
    __builtin_amdgcn_sched_barrier(0);
  }
#undef SP_I0
#undef SP_I1
#undef SP_RD
}

__device__ __forceinline__ void pv2_sm2p(f32x16& s0, f32x16& s1, float& m0, float& l0, float& m1, float& l1, ldsp Vt, int vb0, int vb1,
                                         const bf16x8 (&p0)[2], const bf16x8 (&p1)[2], f32x16 (&o0)[4], f32x16 (&o1)[4], bf16x8 (&q0)[2], bf16x8 (&q1)[2]) {
  if (!__all((m0 == 0.f) && (m1 == 0.f))) {
#pragma unroll
    for (int r = 0; r < 16; ++r) { s0[r] -= m0; s1[r] -= m1; }
  }
#define SP_I0(i) (2048 * (2 * ((i) / 4)) + 512 * ((i) % 4))
#define SP_I1(i) (2048 * (2 * ((i) / 4) + 1) + 512 * ((i) % 4))
#define SP_RD(dl, dh, i) do { asm volatile("ds_read_b64_tr_b16 %0, %1 offset:%c2" : "=&v"(dl) : "v"(a0), "i"(SP_I0(i)) : "memory"); \
                              asm volatile("ds_read_b64_tr_b16 %0, %1 offset:%c2" : "=&v"(dh) : "v"(a1), "i"(SP_I1(i)) : "memory"); } while (0)
  const unsigned a0 = (unsigned)(unsigned long)(Vt + vb0), a1 = (unsigned)(unsigned long)(Vt + vb1);
  s16x4 lo[2], hh[2];
  unsigned w0[8], w1[8];
  float sum0 = 0.f, sum1 = 0.f;
  SP_RD(lo[0], hh[0], 0);
#pragma unroll
  for (int i = 0; i < 8; ++i) {
    if (i + 1 < 8) { SP_RD(lo[(i + 1) & 1], hh[(i + 1) & 1], i + 1); asm volatile("s_waitcnt lgkmcnt(2)" ::: "memory"); }
    else asm volatile("s_waitcnt lgkmcnt(0)" ::: "memory");
    __builtin_amdgcn_sched_barrier(0);
    const s16x4 l_ = lo[i & 1], h_ = hh[i & 1];
    const bf16x8 a = {l_[0], l_[1], l_[2], l_[3], h_[0], h_[1], h_[2], h_[3]};
    o0[i % 4] = __builtin_amdgcn_mfma_f32_32x32x16_bf16(a, p0[i / 4], o0[i % 4], 0, 0, 0);
    { const float e0 = __builtin_amdgcn_exp2f(s0[2 * i]), e1 = __builtin_amdgcn_exp2f(s0[2 * i + 1]); sum0 += e0; sum0 += e1; w0[i] = pkbf(e0, e1); }
    __builtin_amdgcn_sched_barrier(0);
    o1[i % 4] = __builtin_amdgcn_mfma_f32_32x32x16_bf16(a, p1[i / 4], o1[i % 4], 0, 0, 0);
    { const float e0 = __builtin_amdgcn_exp2f(s1[2 * i]), e1 = __builtin_amdgcn_exp2f(s1[2 * i + 1]); sum1 += e0; sum1 += e1; w1[i] = pkbf(e0, e1); }
    __builtin_amdgcn_sched_barrier(0);
  }
#undef SP_I0
#undef SP_I1
#undef SP_RD
  const float tot0 = half_swap_sum(sum0), tot1 = half_swap_sum(sum1);
  if (__any(!(tot0 <= BIGSUM) || !(tot1 <= BIGSUM))) {
    float mx0 = 0.f, mx1 = 0.f;
#pragma unroll
    for (int i = 0; i < 8; ++i) { mx0 = fmaxf(mx0, fmaxf(bflo(w0[i]), bfhi(w0[i]))); mx1 = fmaxf(mx1, fmaxf(bflo(w1[i]), bfhi(w1[i]))); }
    mx0 = half_swap_max(mx0); mx1 = half_swap_max(mx1);
    const float d0 = (tot0 <= BIGSUM) ? 0.f : __log2f(fminf(mx0, 3.0e38f)), d1 = (tot1 <= BIGSUM) ? 0.f : __log2f(fminf(mx1, 3.0e38f));
    m0 += d0; m1 += d1;
    const float f0 = __builtin_amdgcn_exp2f(-d0), f1 = __builtin_amdgcn_exp2f(-d1); l0 *= f0; l1 *= f1; sum0 *= f0; sum1 *= f1;
#pragma unroll
    for (int i = 0; i < 8; ++i) { w0[i] = pkbf(bflo(w0[i]) * f0, bfhi(w0[i]) * f0); w1[i] = pkbf(bflo(w1[i]) * f1, bfhi(w1[i]) * f1); }
#pragma unroll
    for (int d = 0; d < 4; ++d)
#pragma unroll
      for (int r = 0; r < 16; ++r) { o0[d][r] *= f0; o1[d][r] *= f1; }
  }
  l0 += sum0; l1 += sum1;
  q0[0] = __builtin_bit_cast(bf16x8, (u32x4){w0[0], w0[1], w0[2], w0[3]}); q0[1] = __builtin_bit_cast(bf16x8, (u32x4){w0[4], w0[5], w0[6], w0[7]});
  q1[0] = __builtin_bit_cast(bf16x8, (u32x4){w1[0], w1[1], w1[2], w1[3]}); q1[1] = __builtin_bit_cast(bf16x8, (u32x4){w1[4], w1[5], w1[6], w1[7]});
}

__device__ __forceinline__ void diff_unit(ldsp lds, const bf16_t* Q, const bf16_t* K, const bf16_t* V, bf16_t* O, int tok0, int S, int h, int qb, float lam, float osc, const float* subg) {
  const int tid = fresh_tid(), lane = tid & 63, wid = tid >> 6, r32 = lane & 31, hi = lane >> 5;
  const int NT = S / 64;
  const bf16_t* kbase = K + (size_t)tok0 * DM + 128 * h; const bf16_t* vbase = V + (size_t)tok0 * DM + 128 * h;
#define DIFF_DMA(t, bo) do { const int ln_ = fresh_tid() & 63, wv_ = __builtin_amdgcn_readfirstlane(fresh_tid() >> 6); \
    { const int row_ = 8 * wv_ + (ln_ >> 3), ch_ = (ln_ & 7) ^ ((row_ >> 1) & 7); const bf16_t* g_ = kbase + (size_t)((t) * 64 + row_) * DM + 8 * ch_; \
      __builtin_amdgcn_global_load_lds((const unsigned*)g_, (LAS unsigned*)(lds + (bo) + 1024 * wv_), 16, 0, 0); \
      __builtin_amdgcn_global_load_lds((const unsigned*)(g_ + 64), (LAS unsigned*)(lds + (bo) + 8192 + 1024 * wv_), 16, 0, 0); } \
    _Pragma("unroll") for (int hq_ = 0; hq_ < 2; ++hq_) { const int o_ = 1024 * hq_ + 16 * ln_, row_ = 8 * wv_ + ((o_ >> 6) & 7), ch_ = 4 * (o_ >> 9) + (((o_ >> 4) & 3) ^ ((row_ >> 2) & 3)); \
      __builtin_amdgcn_global_load_lds((const unsigned*)(vbase + (size_t)((t) * 64 + row_) * DM + 8 * ch_), (LAS unsigned*)(lds + (bo) + 16384 + 2048 * wv_ + 1024 * hq_), 16, 0, 0); } } while (0)
  DIFF_DMA(0, 0);
  const size_t qrow = (size_t)(tok0 + 256 * qb + 32 * wid + r32) * DM;
  bf16x8 q0[4], q1[4];
#pragma unroll
  for (int ds = 0; ds < 4; ++ds) { q0[ds] = *(const bf16x8*)(Q + qrow + (2 * h) * 64 + 16 * ds + 8 * hi); q1[ds] = *(const bf16x8*)(Q + qrow + (2 * h + 1) * 64 + 16 * ds + 8 * hi); }
  f32x16 o0[4], o1[4];
#pragma unroll
  for (int d = 0; d < 4; ++d)
#pragma unroll
    for (int r = 0; r < 16; ++r) { o0[d][r] = 0.f; o1[d][r] = 0.f; }
  float m0 = 0.f, l0 = 0.f, m1 = 0.f, l1 = 0.f;
  int ko[4];
#pragma unroll
  for (int ds = 0; ds < 4; ++ds) ko[ds] = 128 * r32 + (((2 * ds + hi) ^ ((r32 >> 1) & 7)) << 4);
  const int q4 = (lane & 15) >> 2, p4 = lane & 3, gi = (lane >> 4) & 1;
  int vb0 = 64 * (4 * hi + q4) + 16 * ((2 * gi + (p4 >> 1)) ^ hi) + 8 * (p4 & 1);
  int vb1 = 64 * (4 * hi + q4) + 16 * ((2 * gi + (p4 >> 1)) ^ (2 + hi)) + 8 * (p4 & 1);
  __syncthreads();
  bf16x8 pa[2], pb[2];
  pb[0] = (bf16x8){0, 0, 0, 0, 0, 0, 0, 0}; pb[1] = pb[0]; pa[0] = pb[0]; pa[1] = pb[0];
  int bcur = 0, bnext = 32768;
  ldsp prevV = lds + 16384;
#pragma unroll 1
  for (int t = 0; t < NT; ++t) {
    asm volatile("" : "+v"(ko[0]), "+v"(ko[1]), "+v"(ko[2]), "+v"(ko[3]), "+v"(vb0), "+v"(vb1));
    if (t + 1 < NT) DIFF_DMA(t + 1, bnext);
    ldsp base = lds + bcur;
    {
      f32x16 sc0 = qk_block(base, ko, q0);
      __builtin_amdgcn_sched_barrier(0);
      f32x16 sc1 = qk_block(base + 8192, ko, q1);
      __builtin_amdgcn_sched_barrier(0);
      bf16x8 pc[2], pd[2];
      pv2_sm2p(sc0, sc1, m0, l0, m1, l1, prevV, vb0, vb1, pa, pb, o0, o1, pc, pd);
      sc0 = qk_block(base + 4096, ko, q0);
      __builtin_amdgcn_sched_barrier(0);
      sc1 = qk_block(base + 8192 + 4096, ko, q1);
      __builtin_amdgcn_sched_barrier(0);
      pv2_sm2p(sc0, sc1, m0, l0, m1, l1, base + 16384, vb0, vb1, pc, pd, o0, o1, pa, pb);
      prevV = base + 16384 + 8192;
    }
    __syncthreads();
    bcur = bnext; bnext = (bnext == 65536) ? 0 : bnext + 32768;
  }
  pv_block<128, true>(prevV, vb0, vb1, pa, pb, o0, o1);
  __syncthreads();
#undef DIFF_DMA
  l0 = half_swap_sum(l0); l1 = half_swap_sum(l1);
  const float i0 = 1.f / l0, i1 = lam / l1;
  float ssq = 0.f;
#pragma unroll
  for (int d = 0; d < 4; ++d)
#pragma unroll
    for (int r = 0; r < 16; ++r) { const float v = o0[d][r] * i0 - o1[d][r] * i1; o0[d][r] = v; ssq += v * v; }
  ssq = half_swap_sum(ssq);
  const float rs = rsqrtf(ssq * (1.f / 128.f) + 1e-5f) * osc;
  bf16_t* orow = O + (size_t)(tok0 + 256 * qb + 32 * (fresh_tid() >> 6) + (fresh_tid() & 31)) * DM + 128 * h;
#pragma unroll
  for (int d = 0; d < 4; ++d)
#pragma unroll
    for (int g4 = 0; g4 < 4; ++g4) { const int dd = 32 * d + 8 * g4 + 4 * hi; const f32x4 gg = *(const f32x4*)(subg + dd);
      u32x2 w; w.x = pkbf(o0[d][4 * g4] * rs * gg.x, o0[d][4 * g4 + 1] * rs * gg.y); w.y = pkbf(o0[d][4 * g4 + 2] * rs * gg.z, o0[d][4 * g4 + 3] * rs * gg.w);
      *(u32x2*)(orow + dd) = w; }
}
__device__ __forceinline__ void phase_diff_attn(ldsp lds, const bf16_t* Q, const bf16_t* K, const bf16_t* V, bf16_t* O, const float* lamv, const float* subg, float lam_init, float osc_l) {
  const int lane = fresh_tid() & 63;
  const float t0 = wave_sum(lamv[lane] * lamv[64 + lane]), t1 = wave_sum(lamv[128 + lane] * lamv[192 + lane]);
  const float lam = __expf(t0) - __expf(t1) + lam_init;
  const int G = gridDim.x, bx = blockIdx.x;
  const bool xmap = (G == 256); const int x = bx & 7, c = bx >> 3;
  const int nu = xmap ? 8 : (2048 - bx + G - 1) / G;
#pragma unroll 1
  for (int i = 0; i < nu; ++i) {
    int bh, qb, S, tok0;
    if (xmap) { if (i < 4) { bh = 4 * x + i; qb = c; S = 8192; tok0 = (bh >> 3) * 8192; } else { bh = 8 * x + 2 * (i - 4) + (c >> 4); qb = c & 15; S = 4096; tok0 = MH + (bh >> 3) * 4096; } }
    else { const int u = bx + i * G; if (u < 1024) { bh = u >> 5; qb = u & 31; S = 8192; tok0 = (bh >> 3) * 8192; } else { const int v = u - 1024; bh = v >> 4; qb = v & 15; S = 4096; tok0 = MH + (bh >> 3) * 4096; } }
    diff_unit(lds, Q, K, V, O, tok0, S, bh & 7, qb, lam, osc_l, subg);
  }
}

__device__ __forceinline__ void dil_unit(ldsp lds, bf16_t* QKV, float* LSE, int half, int u) {
  const int tid = fresh_tid(), lane = tid & 63, wid = tid >> 6, r32 = lane & 31, hi = lane >> 5;
  const int g = u / 2048, rem = u % 2048, head = rem & 15, blk = rem >> 4;
  const int S = half ? 4096 : 8192, nbs = S / 256, seq = blk / nbs, wi = blk % nbs;
  const int dsh = 2 * g, dil = 1 << dsh, L = S >> dsh, nq = L / 256, r = wi / nq, qb = wi % nq, m0 = 256 * qb;
  const int seqrow = seq * S;
  const int colq = g * 3072 + head * 64, colk = colq + 1024, colv = colq + 2048;
  ldsp Kt = lds, Vt = lds + 49152;
#pragma unroll
  for (int i = 0; i < 6; ++i) { const int idx = tid + 512 * i, j = idx >> 3, ch = idx & 7, mk = m0 - 64 + j;
    u32x4 kv = {0u, 0u, 0u, 0u}, vv = {0u, 0u, 0u, 0u};
    if (mk >= 0 && mk < L) { const size_t rowo = (size_t)(seqrow + mk * dil + r) * 9216; kv = *(const u32x4*)(QKV + rowo + colk + 8 * ch); vv = *(const u32x4*)(QKV + rowo + colv + 8 * ch); }
    *(LAS u32x4*)(Kt + koff(j, ch)) = kv; *(LAS u32x4*)(Vt + 128 * j + 16 * ch) = vv; }
  const int mq = m0 + 32 * wid + r32; const size_t qrowo = (size_t)(seqrow + mq * dil + r) * 9216 + colq;
  bf16x8 qf[4];
#pragma unroll
  for (int ds = 0; ds < 4; ++ds) qf[ds] = *(const bf16x8*)(QKV + qrowo + 16 * ds + 8 * hi);
  f32x16 o[2];
#pragma unroll
  for (int d = 0; d < 2; ++d)
#pragma unroll
    for (int rr = 0; rr < 16; ++rr) o[d][rr] = 0.f;
  float m = 0.f, l = 0.f;
  int ko[4];
#pragma unroll
  for (int ds = 0; ds < 4; ++ds) ko[ds] = 128 * r32 + (((2 * ds + hi) ^ ((r32 >> 1) & 7)) << 4);
  const int q4 = (lane & 15) >> 2, p4 = lane & 3, gi = (lane >> 4) & 1;
  const int vb = 128 * (4 * hi + q4) + 32 * gi + 8 * p4;
  __syncthreads();
#pragma unroll 1
  for (int b = 0; b < 5; ++b) {
    const int kr0 = 32 * wid + 32 * b;
    f32x16 s = qk_block(Kt + 128 * kr0, ko, qf);
#pragma unroll
    for (int rr = 0; rr < 16; ++rr) { const int kvr = (rr & 3) + 8 * (rr >> 2) + 4 * hi; const int mk = m0 - 64 + kr0 + kvr; const int dlt = mk - mq;
      const bool ok = (dlt >= -64) && (dlt <= 64) && (mk >= 0) && (mk < L); s[rr] = ok ? s[rr] : -INFINITY; }
    bf16x8 p[2];
    softmax_block<2>(s, m, l, o, p);
    pv_block<64, false>(Vt + 128 * kr0, vb, vb, p, p, o, o);
  }
  l = half_swap_sum(l);
  const float il = 1.f / l;
  bf16_t* orow = QKV + qrowo;
#pragma unroll
  for (int d = 0; d < 2; ++d)
#pragma unroll
    for (int g4 = 0; g4 < 4; ++g4) { const int dd = 32 * d + 8 * g4 + 4 * hi;
      u32x2 w; w.x = pkbf(o[d][4 * g4] * il, o[d][4 * g4 + 1] * il); w.y = pkbf(o[d][4 * g4 + 2] * il, o[d][4 * g4 + 3] * il);
      *(u32x2*)(orow + dd) = w; }
  if (hi == 0) LSE[((size_t)g * MH + (seqrow + mq * dil + r)) * 16 + head] = m + __log2f(l);
  __syncthreads();
}
__device__ __forceinline__ void phase_dil_combine(const bf16_t* QKV, const float* LSE, bf16_t* O  , int gw, int ngw, int lane) {
  for (int t = gw; t < MH; t += ngw) {
    const int head = lane >> 2, d0 = 16 * (lane & 3);
    float ls[3], mx = -INFINITY;
#pragma unroll
    for (int g = 0; g < 3; ++g) { ls[g] = LSE[((size_t)g * MH + t) * 16 + head]; mx = fmaxf(mx, ls[g]); }
    float w[3], ws = 0.f;
#pragma unroll
    for (int g = 0; g < 3; ++g) { w[g] = __builtin_amdgcn_exp2f(ls[g] - mx); ws += w[g]; }
    const float iw = 1.f / ws; float acc[16];
#pragma unroll
    for (int i = 0; i < 16; ++i) acc[i] = 0.f;
#pragma unroll
    for (int g = 0; g < 3; ++g) { const bf16_t* p = QKV + (size_t)t * 9216 + g * 3072 + head * 64 + d0; const u32x4 a = *(const u32x4*)p, b = *(const u32x4*)(p + 8); const float wg = w[g] * iw;
      acc[0] += wg * bflo(a.x); acc[1] += wg * bfhi(a.x); acc[2] += wg * bflo(a.y); acc[3] += wg * bfhi(a.y); acc[4] += wg * bflo(a.z); acc[5] += wg * bfhi(a.z); acc[6] += wg * bflo(a.w); acc[7] += wg * bfhi(a.w);
      acc[8] += wg * bflo(b.x); acc[9] += wg * bfhi(b.x); acc[10] += wg * bflo(b.y); acc[11] += wg * bfhi(b.y); acc[12] += wg * bflo(b.z); acc[13] += wg * bfhi(b.z); acc[14] += wg * bflo(b.w); acc[15] += wg * bfhi(b.w); }
    u32x4 a, b; a.x = pkbf(acc[0], acc[1]); a.y = pkbf(acc[2], acc[3]); a.z = pkbf(acc[4], acc[5]); a.w = pkbf(acc[6], acc[7]);
    b.x = pkbf(acc[8], acc[9]); b.y = pkbf(acc[10], acc[11]); b.z = pkbf(acc[12], acc[13]); b.w = pkbf(acc[14], acc[15]);
    bf16_t* op = O + (size_t)t * DM + head * 64 + d0; *(u32x4*)op = a; *(u32x4*)(op + 8) = b;
  }
}

__device__ __forceinline__ void phase_hgrn_gates(bf16_t* QF, int gt, int ngt) {
  const size_t total = (size_t)M_TOK * 384;
  for (size_t it = gt; it < total; it += ngt) {
    const int row = (int)(it / 384), c8 = (int)(it % 384); bf16_t* p = QF + (size_t)row * 5120 + 8 * c8; const bool isq = c8 < 128;
    u32x4 a = *(const u32x4*)p; float v[8] = {bflo(a.x), bfhi(a.x), bflo(a.y), bfhi(a.y), bflo(a.z), bfhi(a.z), bflo(a.w), bfhi(a.w)};
#pragma unroll
    for (int i = 0; i < 8; ++i) { const float z = v[i]; v[i] = isq ? z / (1.f + __expf(-z)) * 0.08838834764831845f : 1.f / (1.f + __expf(z)); }
    a.x = pkbf(v[0], v[1]); a.y = pkbf(v[2], v[3]); a.z = pkbf(v[4], v[5]); a.w = pkbf(v[6], v[7]); *(u32x4*)p = a;
  }
}
__device__ __forceinline__ int rowimg(int row, int ch) { return 256 * row + ((ch ^ (row & 15)) << 4); }
__device__ __forceinline__ void hgrn_chain(ldsp lds, const bf16_t* QF, bf16_t* Ofw, bf16_t* Obw, const float* oml, int c) {
  const int tid = fresh_tid(), lane = tid & 63, wid = tid >> 6, r32 = lane & 31, hi = lane >> 5;
  const int dir = c & 1, head = (c >> 1) & 7, sq = c >> 4;
  const int T = (sq < 4) ? 8192 : 4096, NC = T / 64; const int seqrow = (sq < 4) ? sq * 8192 : MH + (sq - 4) * 4096;
  bf16_t* Od = dir ? Obw : Ofw;
  constexpr int RAWQ = 0, RAWS = 16384, IMG_V = 32768, IMG_QT = 49152, IMG_KT = 65536, IMG_KH = 81920, OUTB = 98304, TOT = 114688, DEC = 118784;
  const int vblk = wid & 3, tblk = wid >> 2;
  const int kp = tid & 63, e8 = tid >> 6;
  const float om0 = oml[head * 128 + 2 * kp], om1 = oml[head * 128 + 2 * kp + 1];
  f32x16 Sacc[4];
#pragma unroll
  for (int kb = 0; kb < 4; ++kb)
#pragma unroll
    for (int r = 0; r < 16; ++r) Sacc[kb][r] = 0.f;
  const int lrow = tid >> 4, c16 = tid & 15;
  const int qcol = head * 128 + 8 * c16, fcol = 1024 + dir * 1024 + head * 128 + 8 * c16, vcol = 3072 + head * 128 + 8 * c16;
  u32x4 pq0, pq1, ps0, ps1, pv0, pv1;
#define HG_LOAD(n) do { const int t0_ = dir ? T - 64 * ((n) + 1) : 64 * (n); const int ra_ = dir ? 63 - lrow : lrow, rb_ = dir ? 31 - lrow : lrow + 32; \
    const bf16_t* pa_ = QF + (size_t)(seqrow + t0_ + ra_) * 5120; const bf16_t* pb_ = QF + (size_t)(seqrow + t0_ + rb_) * 5120; \
    pq0 = *(const u32x4*)(pa_ + qcol); pq1 = *(const u32x4*)(pb_ + qcol); ps0 = *(const u32x4*)(pa_ + fcol); ps1 = *(const u32x4*)(pb_ + fcol); pv0 = *(const u32x4*)(pa_ + vcol); pv1 = *(const u32x4*)(pb_ + vcol); } while (0)
#define HG_STORE() do { *(LAS u32x4*)(lds + RAWQ + 256 * lrow + 16 * c16) = pq0; *(LAS u32x4*)(lds + RAWQ + 256 * (lrow + 32) + 16 * c16) = pq1; \
    *(LAS u32x4*)(lds + RAWS + 256 * lrow + 16 * c16) = ps0; *(LAS u32x4*)(lds + RAWS + 256 * (lrow + 32) + 16 * c16) = ps1; \
    *(LAS u32x4*)(lds + IMG_V + voffa(lrow, c16)) = pv0; *(LAS u32x4*)(lds + IMG_V + voffa(lrow + 32, c16)) = pv1; } while (0)
  const int q4 = (lane & 15) >> 2, p4 = lane & 3, gi = (lane >> 4) & 1;
  const int vbp0 = 64 * (4 * hi + q4) + 16 * ((2 * gi + (p4 >> 1)) ^ hi) + 8 * (p4 & 1), vbp1 = 64 * (4 * hi + q4) + 16 * ((2 * gi + (p4 >> 1)) ^ (2 + hi)) + 8 * (p4 & 1);
  const int nb0 = 2048 * hi + 64 * q4 + 16 * ((2 * gi + (p4 >> 1)) ^ (2 * hi)) + 8 * (p4 & 1), nb1 = 2048 * hi + 64 * q4 + 16 * ((2 * gi + (p4 >> 1)) ^ (2 * hi + 1)) + 8 * (p4 & 1);
  HG_LOAD(0); HG_STORE(); __syncthreads();
#pragma unroll 1
  for (int n = 0; n < NC; ++n) {
    if (n + 1 < NC) HG_LOAD(n + 1);
    float kk0[8], kk1[8], g0[8], g1[8]; float c0 = 0.f, c1 = 0.f;
#pragma unroll
    for (int i = 0; i < 8; ++i) { const int row = 8 * e8 + i; const unsigned sw = *(const LAS unsigned*)(lds + RAWS + 256 * row + 4 * kp);
      kk0[i] = om0 * bflo(sw); kk1[i] = om1 * bfhi(sw); c0 += __log2f(1.f - kk0[i]); c1 += __log2f(1.f - kk1[i]); g0[i] = c0; g1[i] = c1; }
    *(LAS f32x2*)(lds + TOT + (e8 * 128 + 2 * kp) * 4) = (f32x2){c0, c1};
    __syncthreads();
    float off0 = 0.f, off1 = 0.f, ge0 = 0.f, ge1 = 0.f;
#pragma unroll
    for (int e = 0; e < 8; ++e) { const f32x2 t = *(const LAS f32x2*)(lds + TOT + (e * 128 + 2 * kp) * 4); ge0 += t.x; ge1 += t.y; if (e < e8) { off0 += t.x; off1 += t.y; } }
#pragma unroll
    for (int i = 0; i < 8; ++i) { const int row = 8 * e8 + i; const float G0 = off0 + g0[i], G1 = off1 + g1[i];
      const unsigned qw = *(const LAS unsigned*)(lds + RAWQ + 256 * row + 4 * kp);
      const float eq0 = __builtin_amdgcn_exp2f(G0), eq1 = __builtin_amdgcn_exp2f(G1), ek0 = __builtin_amdgcn_exp2f(-G0), ek1 = __builtin_amdgcn_exp2f(-G1);
      const float eh0 = __builtin_amdgcn_exp2f(ge0 - G0), eh1 = __builtin_amdgcn_exp2f(ge1 - G1);
      const int ro = rowimg(row, kp >> 2) + 4 * (kp & 3);
      *(LAS unsigned*)(lds + IMG_QT + ro) = pkbf(bflo(qw) * eq0, bfhi(qw) * eq1);
      *(LAS unsigned*)(lds + IMG_KT + ro) = pkbf(kk0[i] * ek0, kk1[i] * ek1);
      *(LAS unsigned*)(lds + IMG_KH + voffa(row, kp >> 2) + 4 * (kp & 3)) = pkbf(kk0[i] * eh0, kk1[i] * eh1); }
    if (e8 == 7) *(LAS f32x2*)(lds + DEC + 8 * kp) = (f32x2){__builtin_amdgcn_exp2f(ge0), __builtin_amdgcn_exp2f(ge1)};
    __syncthreads();
    bf16x8 px[2][2];
#pragma unroll
    for (int sb = 0; sb < 2; ++sb) {
      if (sb <= tblk) {
        f32x16 X;
#pragma unroll
        for (int r = 0; r < 16; ++r) X[r] = 0.f;
#pragma unroll
        for (int ds = 0; ds < 8; ++ds) { const bf16x8 a = *(const LAS bf16x8*)(lds + IMG_KT + rowimg(32 * sb + r32, 2 * ds + hi)), bq = *(const LAS bf16x8*)(lds + IMG_QT + rowimg(32 * tblk + r32, 2 * ds + hi));
          X = __builtin_amdgcn_mfma_f32_32x32x16_bf16(a, bq, X, 0, 0, 0); }
        if (sb == tblk) {
#pragma unroll
          for (int r = 0; r < 16; ++r) { const int sl = (r & 3) + 8 * (r >> 2) + 4 * hi; X[r] = (sl <= r32) ? X[r] : 0.f; } }
        u32x4 w0, w1;
        w0.x = pkbf(X[0], X[1]); w0.y = pkbf(X[2], X[3]); w0.z = pkbf(X[4], X[5]); w0.w = pkbf(X[6], X[7]);
        w1.x = pkbf(X[8], X[9]); w1.y = pkbf(X[10], X[11]); w1.z = pkbf(X[12], X[13]); w1.w = pkbf(X[14], X[15]);
        px[sb][0] = __builtin_bit_cast(bf16x8, w0); px[sb][1] = __builtin_bit_cast(bf16x8, w1);
      } else { px[sb][0] = (bf16x8){0, 0, 0, 0, 0, 0, 0, 0}; px[sb][1] = px[sb][0]; }
    }
    f32x16 acc;
#pragma unroll
    for (int r = 0; r < 16; ++r) acc[r] = 0.f;
#pragma unroll
    for (int sb = 0; sb < 2; ++sb)
#pragma unroll
      for (int s2 = 0; s2 < 2; ++s2) {
        const s16x4 lo = vtr(lds + IMG_V + vbp0 + 2048 * (4 * sb + 2 * s2) + 512 * vblk), hh = vtr(lds + IMG_V + vbp1 + 2048 * (4 * sb + 2 * s2 + 1) + 512 * vblk);
        const bf16x8 a = {lo[0], lo[1], lo[2], lo[3], hh[0], hh[1], hh[2], hh[3]};
        acc = __builtin_amdgcn_mfma_f32_32x32x16_bf16(a, px[sb][s2], acc, 0, 0, 0);
      }
#pragma unroll
    for (int kb = 0; kb < 4; ++kb)
#pragma unroll
      for (int s2 = 0; s2 < 2; ++s2) {
        u32x4 w; w.x = pkbf(Sacc[kb][8 * s2 + 0], Sacc[kb][8 * s2 + 1]); w.y = pkbf(Sacc[kb][8 * s2 + 2], Sacc[kb][8 * s2 + 3]); w.z = pkbf(Sacc[kb][8 * s2 + 4], Sacc[kb][8 * s2 + 5]); w.w = pkbf(Sacc[kb][8 * s2 + 6], Sacc[kb][8 * s2 + 7]);
        const u32x2 b0 = *(const LAS u32x2*)(lds + IMG_QT + rowimg(32 * tblk + r32, 4 * kb + 2 * s2) + 8 * hi), b1 = *(const LAS u32x2*)(lds + IMG_QT + rowimg(32 * tblk + r32, 4 * kb + 2 * s2 + 1) + 8 * hi);
        const u32x4 bw = {b0.x, b0.y, b1.x, b1.y};
        acc = __builtin_amdgcn_mfma_f32_32x32x16_bf16(__builtin_bit_cast(bf16x8, w), __builtin_bit_cast(bf16x8, bw), acc, 0, 0, 0);
      }
#pragma unroll
    for (int g4 = 0; g4 < 4; ++g4) { u32x2 w; w.x = pkbf(acc[4 * g4], acc[4 * g4 + 1]); w.y = pkbf(acc[4 * g4 + 2], acc[4 * g4 + 3]);
      *(LAS u32x2*)(lds + OUTB + rowimg(32 * tblk + r32, 4 * vblk + g4) + 8 * hi) = w; }
#pragma unroll
    for (int kb = 0; kb < 4; ++kb) {
#pragma unroll
      for (int g4 = 0; g4 < 4; ++g4) { const f32x4 d = *(const LAS f32x4*)(lds + DEC + 4 * (32 * kb + 8 * g4 + 4 * hi));
        Sacc[kb][4 * g4] *= d.x; Sacc[kb][4 * g4 + 1] *= d.y; Sacc[kb][4 * g4 + 2] *= d.z; Sacc[kb][4 * g4 + 3] *= d.w; }
#pragma unroll
      for (int s4 = 0; s4 < 4; ++s4) {
        const s16x4 a0 = vtr(lds + IMG_KH + nb0 + 4096 * s4 + 512 * kb), a1 = vtr(lds + IMG_KH + nb1 + 4096 * s4 + 256 + 512 * kb);
        const s16x4 b0 = vtr(lds + IMG_V + nb0 + 4096 * s4 + 512 * vblk), b1 = vtr(lds + IMG_V + nb1 + 4096 * s4 + 256 + 512 * vblk);
        const bf16x8 a = {a0[0], a0[1], a0[2], a0[3], a1[0], a1[1], a1[2], a1[3]}, bb = {b0[0], b0[1], b0[2], b0[3], b1[0], b1[1], b1[2], b1[3]};
        Sacc[kb] = __builtin_amdgcn_mfma_f32_32x32x16_bf16(a, bb, Sacc[kb], 0, 0, 0);
      }
    }
    __syncthreads();
    { const int t0_ = dir ? T - 64 * (n + 1) : 64 * n;
#pragma unroll
      for (int i = 0; i < 2; ++i) { const int tau = lrow + 32 * i; const int grow = dir ? 63 - tau : tau;
        *(u32x4*)(Od + (size_t)(seqrow + t0_ + grow) * 1024 + head * 128 + 8 * c16) = *(const LAS u32x4*)(lds + OUTB + rowimg(tau, c16)); } }
    if (n + 1 < NC) HG_STORE();
    __syncthreads();
  }
#undef HG_LOAD
#undef HG_STORE
}
__device__ __forceinline__ void phase_hgrn_combine(const bf16_t* QF, const bf16_t* Ofw, const bf16_t* Obw, bf16_t* O, const float* gn, int gw, int ngw, int lane) {
  for (int t = gw; t < M_TOK; t += ngw) {
    const int c0 = 16 * lane;
    float v[16], gv[16];
    { const bf16_t* a = Ofw + (size_t)t * 1024 + c0; const bf16_t* b = Obw + (size_t)t * 1024 + c0; const bf16_t* gp = QF + (size_t)t * 5120 + 4096 + c0;
#pragma unroll
      for (int j = 0; j < 2; ++j) { const u32x4 x = *(const u32x4*)(a + 8 * j), y = *(const u32x4*)(b + 8 * j), z = *(const u32x4*)(gp + 8 * j);
        v[8 * j + 0] = bflo(x.x) + bflo(y.x); v[8 * j + 1] = bfhi(x.x) + bfhi(y.x); v[8 * j + 2] = bflo(x.y) + bflo(y.y); v[8 * j + 3] = bfhi(x.y) + bfhi(y.y);
        v[8 * j + 4] = bflo(x.z) + bflo(y.z); v[8 * j + 5] = bfhi(x.z) + bfhi(y.z); v[8 * j + 6] = bflo(x.w) + bflo(y.w); v[8 * j + 7] = bfhi(x.w) + bfhi(y.w);
        gv[8 * j + 0] = bflo(z.x); gv[8 * j + 1] = bfhi(z.x); gv[8 * j + 2] = bflo(z.y); gv[8 * j + 3] = bfhi(z.y); gv[8 * j + 4] = bflo(z.z); gv[8 * j + 5] = bfhi(z.z); gv[8 * j + 6] = bflo(z.w); gv[8 * j + 7] = bfhi(z.w); } }
    float ss = 0.f;
#pragma unroll
    for (int i = 0; i < 16; ++i) ss += v[i] * v[i];
    ss += DPPF(ss, 0xB1); ss += DPPF(ss, 0x4E); ss += DPPF(ss, 0x141);
    const float rs = rsqrtf(ss * (1.f / 128.f) + 1e-6f);
    unsigned w[8];
#pragma unroll
    for (int i = 0; i < 8; ++i) { const int d = (c0 & 127) + 2 * i; const float g0 = gv[2 * i], g1 = gv[2 * i + 1];
      w[i] = pkbf(v[2 * i] * rs * gn[d] * (g0 / (1.f + __expf(-g0))), v[2 * i + 1] * rs * gn[d + 1] * (g1 / (1.f + __expf(-g1)))); }
    bf16_t* op = O + (size_t)t * DM + c0; *(u32x4*)op = (u32x4){w[0], w[1], w[2], w[3]}; *(u32x4*)(op + 8) = (u32x4){w[4], w[5], w[6], w[7]};
  }
}

__device__ __forceinline__ void phase_convglu(const bf16_t* U, bf16_t* G, const float* cw  , const float* cb  , int half, int gt, int ngt) {
  const size_t total = (size_t)MH * 352; const int S = half ? 4096 : 8192;
  for (size_t it = gt; it < total; it += ngt) {
    const int row = (int)(it / 352), c8 = (int)(it % 352), c = 8 * c8; const int pos = row & (S - 1);
    float a[8], b[8];
#pragma unroll
    for (int i = 0; i < 8; ++i) { a[i] = cb[c + i]; b[i] = cb[2816 + c + i]; }
#pragma unroll
    for (int tap = 0; tap < 3; ++tap) { const int pp = pos + tap - 1; if (pp < 0 || pp >= S) continue;
      const bf16_t* ur = U + (size_t)(row + tap - 1) * 5632; const u32x4 ua = *(const u32x4*)(ur + c), ub = *(const u32x4*)(ur + 2816 + c);
      const float fa[8] = {bflo(ua.x), bfhi(ua.x), bflo(ua.y), bfhi(ua.y), bflo(ua.z), bfhi(ua.z), bflo(ua.w), bfhi(ua.w)};
      const float fb[8] = {bflo(ub.x), bfhi(ub.x), bflo(ub.y), bfhi(ub.y), bflo(ub.z), bfhi(ub.z), bflo(ub.w), bfhi(ub.w)};
#pragma unroll
      for (int i = 0; i < 8; ++i) { a[i] += fa[i] * cw[tap * 5632 + c + i]; b[i] += fb[i] * cw[tap * 5632 + 2816 + c + i]; } }
    float o[8];
#pragma unroll
    for (int i = 0; i < 8; ++i) { const float x = a[i], z = 1.5957691216057308f * (x + 0.044715f * x * x * x); o[i] = x / (1.f + __expf(-z)) * b[i]; }
    u32x4 w; w.x = pkbf(o[0], o[1]); w.y = pkbf(o[2], o[3]); w.z = pkbf(o[4], o[5]); w.w = pkbf(o[6], o[7]);
    *(u32x4*)(G + (size_t)row * DFF + c) = w;
  }
}

#define XB_TMO      128
#define XB_XCNT(j)  (256  + 64 * (j))
#define XB_XSUB(j)  (1280 + 64 * (j))
#define XB_XGEN(j)  (2304 + 64 * (j))
#define XB_TOP      3328
#define XB_TOPGEN   3392
#define XCD_BAR_WORDS 3456
#define XB_SPIN_CAP (1u << 18)

__device__ __forceinline__ unsigned xb_ld(unsigned* p)              { return __hip_atomic_load(p, __ATOMIC_RELAXED, __HIP_MEMORY_SCOPE_AGENT); }
__device__ __forceinline__ unsigned xb_add(unsigned* p, unsigned v) { return __hip_atomic_fetch_add(p, v, __ATOMIC_RELAXED, __HIP_MEMORY_SCOPE_AGENT); }
__device__ __forceinline__ unsigned xb_xcc_id() { return (unsigned)__builtin_amdgcn_s_getreg((3 << 11) | 20) & 0xFu; }
#define XB_SPIN(cond, bar) do { unsigned _sp = 0; while (cond) { __builtin_amdgcn_s_sleep(1); \
    if ((++_sp & 255u) == 0u) { if (xb_ld(&(bar)[XB_TMO])) break; if (_sp > XB_SPIN_CAP) { atomicAdd(&(bar)[XB_TMO], 1u); break; } } } } while (0)

struct XcdBarrier {
    unsigned* bar; unsigned x;
    volatile LAS unsigned* st;
};

__device__ __forceinline__ XcdBarrier xcd_barrier_post(unsigned* bar, volatile LAS unsigned* st) {
    XcdBarrier b; b.bar = bar; b.x = xb_xcc_id(); b.st = st;
    if (threadIdx.x == 0) (void)xb_add(&bar[XB_XCNT(b.x)], 1u);
    return b;
}
__device__ __forceinline__ void xcd_barrier_complete(unsigned* bar, unsigned x, unsigned& nloc, unsigned& nx) {
    const unsigned G = gridDim.x * gridDim.y * gridDim.z;
    unsigned sum, cnt, mine, sp = 0u;
    for (;;) {
        sum = 0u; cnt = 0u; mine = 0u;
#pragma unroll
        for (unsigned j = 0; j < 16; ++j) { const unsigned c = xb_ld(&bar[XB_XCNT(j)]); sum += c; cnt += (c > 0u) ? 1u : 0u; mine = (j == x) ? c : mine; }
        if (sum == G) break;
        __builtin_amdgcn_s_sleep(1);
        if ((++sp & 255u) == 0u) { if (xb_ld(&bar[XB_TMO])) break; if (sp > XB_SPIN_CAP) { atomicAdd(&bar[XB_TMO], 1u); break; } }
    }
    nloc = mine > 0u ? mine : 1u; nx = cnt > 0u ? cnt : 1u;
}

__device__ __forceinline__ void xcd_barrier(const XcdBarrier& b) {
    asm volatile("s_waitcnt vmcnt(0)" ::: "memory");
    __syncthreads();
    if (threadIdx.x == 0) {
        unsigned* bar = b.bar;
        __builtin_amdgcn_s_waitcnt(0);
        unsigned nloc = b.st[0], nx = b.st[1];
        if (nloc == 0u) { xcd_barrier_complete(bar, b.x, nloc, nx); b.st[0] = nloc; b.st[1] = nx; }
        const unsigned old = xb_add(&bar[XB_XSUB(b.x)], 1u);
        const unsigned gen = old / nloc;
        if (old + 1u == (gen + 1u) * nloc) {
            __builtin_amdgcn_fence(__ATOMIC_RELEASE, "agent");
            asm volatile("s_waitcnt vmcnt(0)" ::: "memory");
            const unsigned og = xb_add(&bar[XB_TOP], 1u);
            const unsigned tg = og / nx;
            if (og + 1u == (tg + 1u) * nx) xb_add(&bar[XB_TOPGEN], 1u);
            else XB_SPIN(xb_ld(&bar[XB_TOPGEN]) == tg, bar);
            __builtin_amdgcn_fence(__ATOMIC_ACQUIRE, "agent");
            xb_add(&bar[XB_XGEN(b.x)], 1u);
            asm volatile("s_waitcnt vmcnt(0)" ::: "memory");
        } else {
            XB_SPIN(xb_ld(&bar[XB_XGEN(b.x)]) == gen, bar);
            __builtin_amdgcn_fence(__ATOMIC_ACQUIRE, "agent");
            asm volatile("s_waitcnt vmcnt(0)" ::: "memory");
        }
    }
    __syncthreads();
}

typedef pg8::EpiBf16<0> EpiP;
enum { OP_GEMM = 0, OP_ROPE_DIFF, OP_DIFF_ATTN, OP_RES_NORM, OP_ROPE_DIL, OP_DIL_ATTN, OP_DIL_COMB, OP_HG_GATES, OP_HG_SCAN, OP_HG_COMB, OP_CONVGLU, OP_GEMM_FFN, OP_END };
struct Step { int op; int half; const bf16_t* A; const bf16_t* Bt; bf16_t* O; int M, N, K, ldc, split; const bf16_t* Yin; int gA, gB; int mode, tok0; };
__device__ __forceinline__ Step get_step(int layer, int s, unsigned char* ws) {
  bf16_t* W = (bf16_t*)(ws + WS_W); bf16_t* H = (bf16_t*)(ws + WS_H); bf16_t* Y = (bf16_t*)(ws + WS_Y); bf16_t* BIG = (bf16_t*)(ws + WS_BIG);
  const int kind = layer % 3, j = layer / 3;
  Step st; st.op = OP_END; st.half = 0; st.A = H; st.Bt = W; st.O = Y; st.M = M_TOK; st.N = 1024; st.K = 1024; st.ldc = 1024; st.split = 0; st.Yin = Y; st.gA = 0; st.gB = -1; st.mode = 0; st.tok0 = 0;
  const int nmix = (kind == 0) ? 3 : (kind == 1) ? 7 : 4;
  if (s < nmix) {
    if (kind == 2) {
      if (s == 0) { st.op = OP_GEMM; st.A = H; st.Bt = W + WE_CIN; st.O = BIG; st.N = 5120; st.ldc = 5120; st.mode = 2; }
      else if (s == 1) st.op = OP_HG_SCAN;
      else if (s == 2) st.op = OP_HG_COMB;
      else { st.op = OP_GEMM; st.A = Y; st.Bt = W + WE_CO; st.O = H; }
    } else if (kind == 0) {
      if (s == 0) { st.op = OP_GEMM; st.A = H; st.Bt = W + WE_AQKV + (size_t)j * 3072 * 1024; st.O = BIG; st.N = 3072; st.split = 1024; st.mode = 1; }
      else if (s == 1) st.op = OP_DIFF_ATTN;
      else { st.op = OP_GEMM; st.A = H; st.Bt = W + WE_AO + (size_t)j * 1024 * 1024; st.O = Y; }
    } else {
      if (s == 6) { st.op = OP_GEMM; st.A = Y; st.Bt = W + WE_BO; st.O = H; }
      else { const int half = s / 3, q = s % 3; st.half = half;
        if (q == 0) { st.op = OP_GEMM; st.A = H + (size_t)half * MH * DM; st.Bt = W + WE_BQKV; st.O = BIG; st.M = MH; st.N = 9216; st.ldc = 9216; st.mode = 1; st.tok0 = half * MH; }
        else st.op = (q == 1) ? OP_DIL_ATTN : OP_DIL_COMB; }
    }
    return st;
  }
  const int f = s - nmix;
  bf16_t* U = Y; bf16_t* Gb = Y + 352ull * MiB / 2;
  if (f == 0) { st.op = OP_RES_NORM; st.Yin = (kind == 0) ? Y : H; st.gA = layer * 4 + 1; st.gB = layer * 4 + 2; }
  else if (f == 1) { st.op = OP_GEMM_FFN; st.A = H - 1024; st.Bt = W + WE_FIN + (size_t)layer * 5632 * 1024; st.O = Gb; st.M = 265 * 256; st.N = 5632; }
  else if (f == 2) { st.op = OP_GEMM; st.A = Gb; st.Bt = W + WE_FOUT + (size_t)layer * 1024 * 2816; st.O = Y; st.K = 2816; }
  else if (f == 3) { st.op = OP_RES_NORM; st.Yin = Y; st.gA = layer * 4 + 3; st.gB = (layer < 3) ? (layer + 1) * 4 : -1; }
  return st;
}

__global__ void __launch_bounds__(512) fwd_megakernel(Params p) {
  extern __shared__ __attribute__((aligned(16))) unsigned char lds_raw[];
  cg::grid_group grid = cg::this_grid();
  ldsp lds = (ldsp)lds_raw;
  const int G = gridDim.x, ngw = G * 8, ngt = G * 512;
  if (threadIdx.x < 2) *(LAS unsigned*)(lds + 131072 + 256 + 4 * threadIdx.x) = 0u;
  __syncthreads();
#define FRESH() const int tid = fresh_tid(), lane = tid & 63, wave = tid >> 6, gw = blockIdx.x * 8 + wave, gt = blockIdx.x * 512 + tid; (void)lane; (void)wave; (void)gw; (void)gt
  unsigned char* ws = kargs()->ws;
  float* x = kargs()->out;
  float* rope = (float*)(ws + WS_ROPE); float* oml = (float*)(ws + WS_OML);
  bf16_t* W = (bf16_t*)(ws + WS_W); bf16_t* H = (bf16_t*)(ws + WS_H); bf16_t* Y = (bf16_t*)(ws + WS_Y); bf16_t* BIG = (bf16_t*)(ws + WS_BIG);
#define norm_g (kargs()->in[2])

  {
    FRESH();
    LAS float* scr = (LAS float*)(lds + wave * 16384);
#pragma unroll 1
    for (int mi = 0; mi < 16; ++mi) {
      const float* src; bf16_t* dst; int K = 1024, N = 1024;
      if (mi < 2) { src = kargs()->in[3] + (size_t)mi * 1024 * 3072; dst = W + WE_AQKV + (size_t)mi * 3072 * 1024; N = 3072; }
      else if (mi < 4) { src = kargs()->in[6] + (size_t)(mi - 2) * 1024 * 1024; dst = W + WE_AO + (size_t)(mi - 2) * 1024 * 1024; }
      else if (mi == 4) { src = kargs()->in[7]; dst = W + WE_BQKV; N = 9216; }
      else if (mi == 5) { src = kargs()->in[8]; dst = W + WE_BO; }
      else if (mi == 6) { src = kargs()->in[9]; dst = W + WE_CIN; N = 5120; }
      else if (mi == 7) { src = kargs()->in[12]; dst = W + WE_CO; }
      else if (mi < 12) { src = kargs()->in[13] + (size_t)(mi - 8) * 1024 * 5632; dst = W + WE_FIN + (size_t)(mi - 8) * 5632 * 1024; N = 5632; }
      else { src = kargs()->in[16] + (size_t)(mi - 12) * 2816 * 1024; dst = W + WE_FOUT + (size_t)(mi - 12) * 1024 * 2816; K = 2816; }
      transpose_mat(src, K, N, dst, scr, gw, ngw, lane, mi >= 8 && mi < 12);
    }
    for (int i = gt; i < 8192 * 8; i += ngt) { const int pos = i >> 3, f = i & 7; const double rev = (double)pos * kargs()->invf[f] * 0.15915494309189535; const float fr = (float)(rev - floor(rev));
      rope[pos * 16 + f] = __builtin_amdgcn_cosf(fr); rope[pos * 16 + 8 + f] = __builtin_amdgcn_sinf(fr); }
    for (int i = gt; i < 1024; i += ngt) { const float* lg = kargs()->in[10]; const float a0 = lg[i], a1 = lg[1024 + i], a2 = lg[2048 + i], a3 = lg[3072 + i]; const float mx = fmaxf(fmaxf(a0, a1), fmaxf(a2, a3));
      const float e0 = __expf(a0 - mx), e1 = __expf(a1 - mx), e2 = __expf(a2 - mx), e3 = __expf(a3 - mx); oml[i] = 1.f - (e1 + e2) / (e0 + e1 + e2 + e3); }
    phase_init_norm(kargs()->in[0], kargs()->in[1], x, H, norm_g, gw, ngw, lane);
  }
  grid.sync();
  XcdBarrier xbar = xcd_barrier_post((unsigned*)(ws + WS_BAR), (volatile LAS unsigned*)(lds + 131072 + 256));

#pragma unroll 1
  for (int layer = 0; layer < 4; ++layer) {
#pragma unroll 1
#ifdef PROBE_DUP_OP
    for (int s = 0, rep_ = 0; s < 16; ) {
#else
    for (int s = 0; s < 16; ++s) {
#endif
      const Step st = get_step(layer, s, ws);
      if (st.op == OP_END) break;
#ifdef PROBE_REPEAT_OP
      for (int rep_ = 0; rep_ < ((st.op == PROBE_REPEAT_OP) ? 2 : 1); ++rep_) {
#endif
      switch (st.op) {
        case OP_GEMM: {
          pg8::EpiAct E{st.O, st.ldc, st.split, (size_t)M_TOK * DM, st.mode, rope, st.tok0, C2};
          int gM = st.M, gN = st.N, gK = st.K, gG = G, gB = (int)blockIdx.x; asm volatile("" : "+s"(gM), "+s"(gN), "+s"(gK), "+s"(gG), "+s"(gB));
          pg8::Gemm g{st.A, st.Bt, gM, gN, gK}; pg8::StaticOrder S; S.init(gM, gN, gG, gB);
          pg8::gemm_phase<pg8::EpiAct, pg8::StaticOrder, true, true>(lds, g, S, E);
        } break;
        case OP_GEMM_FFN: {
          int ly = layer; asm volatile("" : "+s"(ly));
          pg8::EpiConvGlu E{st.O, kargs()->in[14] + (size_t)ly * 3 * 5632, kargs()->in[15] + (size_t)ly * 5632};
          int gM = st.M, gN = st.N, gK = st.K, gG = G, gB = (int)blockIdx.x; asm volatile("" : "+s"(gM), "+s"(gN), "+s"(gK), "+s"(gG), "+s"(gB));
          pg8::Gemm g{st.A, st.Bt, gM, gN, gK}; pg8::StaticOrder S; S.init(gM, gN, gG, gB);
          pg8::gemm_phase<pg8::EpiConvGlu, pg8::StaticOrder, true, true, true>(lds, g, S, E);
        } break;
        case OP_ROPE_DIFF: { FRESH(); bf16_t* Qb = BIG; bf16_t* Kb = BIG + (size_t)M_TOK * DM;
          for (int it = gw; it < M_TOK * 2; it += ngw) { const int row = it >> 1, sg = it & 1; const int pos = (row < MH) ? (row & 8191) : (row & 4095);
            rope_seg((sg ? Kb : Qb) + (size_t)row * DM + 16 * lane, pos, sg ? 1.f : C2, rope, lane); } } break;
        case OP_DIFF_ATTN: { int ly = layer; asm volatile("" : "+s"(ly)); const int j = ly / 3; const float lam_init = __builtin_bit_cast(float, (ly == 0) ? 0x3e4ccccd : 0x3f0e59d5), osc_l = __builtin_bit_cast(float, (ly == 0) ? 0x3f4ccccd : 0x3ee34c57);
          phase_diff_attn(lds, BIG, BIG + (size_t)M_TOK * DM, BIG + 2 * (size_t)M_TOK * DM, H, kargs()->in[4] + j * 256, kargs()->in[5] + j * 128, lam_init, osc_l); } break;
        case OP_RES_NORM: { FRESH(); const bool first_ = (st.gA == 1); phase_res_norm(st.Yin, x, H, norm_g + st.gA * 1024, st.gB >= 0 ? norm_g + st.gB * 1024 : nullptr, gw, ngw, lane, first_ ? kargs()->in[0] : nullptr, first_ ? kargs()->in[1] : nullptr); } break;
        case OP_ROPE_DIL: { FRESH();
          for (int it = gw; it < MH * 6; it += ngw) { const int row = it / 6, sg = it % 6; const int tok = st.half * MH + row; const int pos = (tok < MH) ? (tok & 8191) : (tok & 4095);
            rope_seg(BIG + (size_t)row * 9216 + (sg >> 1) * 3072 + (sg & 1) * 1024 + 16 * lane, pos, (sg & 1) ? 1.f : C2, rope, lane); } } break;
        case OP_DIL_ATTN: { float* LSE = (float*)(BIG + (size_t)MH * 9216);
#pragma unroll 1
          for (int u = blockIdx.x; u < 6144; u += G) dil_unit(lds, BIG, LSE, st.half, u); } break;
        case OP_DIL_COMB: { FRESH(); phase_dil_combine(BIG, (const float*)(BIG + (size_t)MH * 9216), Y + (size_t)st.half * MH * DM, gw, ngw, lane); } break;
        case OP_HG_GATES: { FRESH(); phase_hgrn_gates(BIG, gt, ngt); } break;
        case OP_HG_SCAN: {
#pragma unroll 1
          for (int c = blockIdx.x; c < 192; c += G) hgrn_chain(lds, BIG, Y, H, oml, c); } break;
        case OP_HG_COMB: { FRESH(); phase_hgrn_combine(BIG, Y, H, Y, kargs()->in[11], gw, ngw, lane); } break;
        case OP_CONVGLU: { FRESH(); phase_convglu(Y, Y + 352ull * MiB / 2 + (size_t)st.half * MH * DFF, kargs()->in[14] + (size_t)layer * 3 * 5632, kargs()->in[15] + (size_t)layer * 5632, st.half, gt, ngt); } break;
        default: break;
      }
      xcd_barrier(xbar);
#ifdef PROBE_DUP_OP
      if (st.op == PROBE_DUP_OP && rep_ == 0) rep_ = 1; else { rep_ = 0; ++s; }
#endif
#ifdef PROBE_REPEAT_OP
      }
#endif
    }
  }
}

constexpr int LDS_BYTES = 147456;
extern "C" void kernel_launch(void* const* d_in, const int* in_sizes, int n_in, void* d_out, int out_size, void* d_ws, size_t ws_size, hipStream_t stream) {
  static int grid = 0;
  if (grid == 0) {
    if (n_in != 17 || ws_size < WS_END) { fprintf(stderr, "kernel_launch: unexpected n_in %d / ws %zu\n", n_in, ws_size); grid = -1; return; }
    int dev = 0, cus = 0;
    if (hipGetDevice(&dev) != hipSuccess || hipDeviceGetAttribute(&cus, hipDeviceAttributeMultiprocessorCount, dev) != hipSuccess) { grid = -1; return; }
    if (hipFuncSetAttribute((const void*)fwd_megakernel, hipFuncAttributeMaxDynamicSharedMemorySize, LDS_BYTES) != hipSuccess) { fprintf(stderr, "hipFuncSetAttribute failed\n"); grid = -1; return; }
    grid = cus;
  }
  if (grid < 0) return;
  if (hipMemsetAsync((char*)d_ws + WS_BAR, 0, XCD_BAR_WORDS * 4, stream) != hipSuccess) { fprintf(stderr, "kernel_launch: memset of the barrier words failed\n"); return; }
  Params p{};
  for (int i = 0; i < 17; ++i) p.in[i] = (const float*)d_in[i];
  p.out = (float*)d_out; p.ws = (unsigned char*)d_ws;
  for (int i = 0; i < 8; ++i) p.invf[i] = pow(500000.0, -(double)i / 8.0);
  void* args[] = {&p};
  hipError_t e = hipLaunchCooperativeKernel((void*)fwd_megakernel, dim3(grid), dim3(512), args, LDS_BYTES, stream);
  if (e != hipSuccess) fprintf(stderr, "cooperative launch failed: %s (grid %d)\n", hipGetErrorString(e), grid);
}
```

```cpp
#include <hip/hip_runtime.h>
#include <hip/hip_cooperative_groups.h>
#include <cstdio>
#include <cstdint>
#include <cmath>
namespace cg = cooperative_groups;
namespace pg8 {
#define PG8_LAS __attribute__((address_space(3)))
typedef unsigned short bf16_t;
typedef short bf16x8 __attribute__((ext_vector_type(8)));
typedef float f32x4 __attribute__((ext_vector_type(4)));
typedef unsigned u32x4 __attribute__((ext_vector_type(4)));
constexpr int BM = 256, BK = 64, HALF = 128, HTB = HALF * BK * 2  , STAGE_BYTES = 8 * HTB, NXCD = 8, WGM = 8;

__host__ __device__ __forceinline__ int lds_byte(int r, int c) { const int st = (r >> 4) * 2 + (c >> 5), rr = r & 15, cc = c & 31, ob = rr * 64 + cc * 2; return st * 1024 + (ob ^ (((ob >> 9) & 1) << 5)); }
__host__ __device__ __forceinline__ void stage_rc(int b, int& R, int& C) { const int st = b / 1024, sb = b % 1024, swz = sb ^ (((sb >> 9) & 1) << 5); R = (st >> 1) * 16 + swz / 64; C = (st & 1) * 32 + (swz % 64) / 2; }
__host__ __device__ __forceinline__ int perm32(int rho) { const int n = rho >> 4, i = rho & 15; return 8 * (i >> 2) + 4 * n + (i & 3); }

struct Unit { int pm, pn; };
struct Gemm { const bf16_t* A; const bf16_t* Bt; int M, N, K; };

struct StaticOrder {
    int nM, nN, nwg, G, c;
    __host__ __device__ void init(int M, int N, int G_, int c_) { nM = M / BM; nN = N / BM; nwg = nM * nN; G = G_; c = c_; }
    __host__ __device__ bool next(int i, Unit& u) const {
        const int L = i * G + c; if (L >= nwg) return false;
        int wgid = L; { const int q = nwg / NXCD, r = nwg % NXCD, xcd = wgid % NXCD, off = wgid / NXCD; wgid = (xcd < r ? xcd * (q + 1) : r * (q + 1) + (xcd - r) * q) + off; }
        const int nig = WGM * nN, gid = wgid / nig, fm = gid * WGM, gsz = (nM - fm) < WGM ? (nM - fm) : WGM;
        u.pm = fm + ((wgid % nig) % gsz); u.pn = (wgid % nig) / gsz; return true;
    }
    __device__ __forceinline__ void a_ready(const Unit&) const {}
    __device__ __forceinline__ void done(const Unit&) const {}
};

__device__ __forceinline__ unsigned cvt_pk_bf16(float lo, float hi) { unsigned r; asm volatile("v_cvt_pk_bf16_f32 %0, %1, %2" : "=v"(r) : "v"(lo), "v"(hi)); return r; }
typedef float f32x2 __attribute__((ext_vector_type(2)));
__device__ __forceinline__ f32x2 gelu_pk(f32x2 v) {
    const f32x2 av = __builtin_elementwise_abs(v), d = av * 0.2316418882f + 1.0f;
    f32x2 t; t.x = __builtin_amdgcn_rcpf(d.x); t.y = __builtin_amdgcn_rcpf(d.y);
    f32x2 q = t * 0.5307027145f + (-0.7265760135f); q = q * t + 0.7107068705f; q = q * t + (-0.142248368f); q = q * t + 0.127414796f; q = q * t;
    const f32x2 s = (v * v) * (-0.72134752044f);
    f32x2 e; e.x = __builtin_amdgcn_exp2f(s.x); e.y = __builtin_amdgcn_exp2f(s.y);
    const f32x2 m = v * (q * e), r = v - m;
    f32x2 o; o.x = v.x < 0.f ? m.x : r.x; o.y = v.y < 0.f ? m.y : r.y; return o;
}

template <int ACT  > struct EpiBf16 {
    static constexpr bool PERM = true, AFTER_DRAIN = false; static_assert(ACT == 0 || ACT == 1, "EpiBf16: ACT is 0 (none) or 1 (gelu_pk)");
    bf16_t* O; int ldc; const float* bias; int split_cols; size_t split_stride; float scale0;
    __device__ __forceinline__ void operator()(const f32x4 (&acc)[2][2][4][2], const Unit& u, int wr, int wc, int fr, int fq) const {
        const int row0 = u.pm * BM + wr * 64 + fr; int colt = u.pn * BM; bf16_t* base = O;
        float sc = 1.f; if (split_cols) { const int t = colt / split_cols; base += (size_t)t * split_stride; colt -= t * split_cols; if (t == 0) sc = scale0; }
        const int col0 = colt + wc * 32 + 8 * fq, bcol0 = u.pn * BM + wc * 32 + 8 * fq;
        f32x4 bv[2][2];
#pragma unroll
        for (int bj = 0; bj < 2; ++bj)
#pragma unroll
            for (int n = 0; n < 2; ++n) bv[bj][n] = bias ? *(const f32x4*)(bias + bcol0 + bj * HALF + 4 * n) : (f32x4){0.f, 0.f, 0.f, 0.f};
#pragma unroll
        for (int ai = 0; ai < 2; ++ai)
#pragma unroll
            for (int m = 0; m < 4; ++m) { bf16_t* rowp = base + (size_t)(row0 + ai * HALF + m * 16) * ldc + col0;
#pragma unroll
                for (int bj = 0; bj < 2; ++bj) { f32x4 v0 = acc[ai][bj][m][0] + bv[bj][0], v1 = acc[ai][bj][m][1] + bv[bj][1];
                    if (ACT == 1) { f32x2 a = gelu_pk((f32x2){v0[0], v0[1]}), b = gelu_pk((f32x2){v0[2], v0[3]}), c = gelu_pk((f32x2){v1[0], v1[1]}), d = gelu_pk((f32x2){v1[2], v1[3]});
                        v0 = (f32x4){a.x, a.y, b.x, b.y}; v1 = (f32x4){c.x, c.y, d.x, d.y}; }
                    v0 = v0 * sc; v1 = v1 * sc; u32x4 w; w.x = cvt_pk_bf16(v0[0], v0[1]); w.y = cvt_pk_bf16(v0[2], v0[3]); w.z = cvt_pk_bf16(v1[0], v1[1]); w.w = cvt_pk_bf16(v1[2], v1[3]);
                    *(u32x4*)(rowp + bj * HALF) = w; } }
    }
};


struct EpiAct {
    static constexpr bool PERM = true, AFTER_DRAIN = false;
    bf16_t* O; int ldc; int split_cols; size_t split_stride; int mode; const float* rope; int tok0; float qscale;
    __device__ __forceinline__ void operator()(const f32x4 (&acc)[2][2][4][2], const Unit& u, int wr, int wc, int fr, int fq) const {
        const int row0 = u.pm * BM + wr * 64 + fr; int colt = u.pn * BM; bf16_t* base = O; asm volatile("" : "+s"(base));
        const float* rope_ = rope; asm volatile("" : "+s"(rope_));
        int act = 0;
        if (mode == 1) { const int seg = colt % 3072; act = seg < 1024 ? 1 : (seg < 2048 ? 2 : 0); }
        else if (mode == 2) { act = colt < 1024 ? 3 : (colt < 3072 ? 4 : 0); }
        if (split_cols) { const int t = colt / split_cols; base += (size_t)t * split_stride; colt -= t * split_cols; }
        const int col0 = colt + wc * 32 + 8 * fq;
        const bool rope_wave = (act == 1 || act == 2) && ((wc & 1) == 0);
        const float sc = (act == 1) ? qscale : 1.f;
        const float sgn = (fq == 0) ? -1.f : 1.f; const bool rot = fq < 2;
#pragma unroll
        for (int ai = 0; ai < 2; ++ai)
#pragma unroll
            for (int m = 0; m < 4; ++m) {
                const int row = row0 + ai * HALF + m * 16; bf16_t* rowp = base + (size_t)row * ldc + col0;
                f32x4 c0 = {1.f, 1.f, 1.f, 1.f}, c1 = c0, s0 = {0.f, 0.f, 0.f, 0.f}, s1 = s0;
                if (rope_wave) { const int tok = tok0 + row; const int pos = (tok < 32768) ? (tok & 8191) : (tok & 4095); const float* cs = rope_ + (size_t)pos * 16;
                    c0 = *(const f32x4*)cs; c1 = *(const f32x4*)(cs + 4); s0 = *(const f32x4*)(cs + 8) * sgn; s1 = *(const f32x4*)(cs + 12) * sgn; }
#pragma unroll
                for (int bj = 0; bj < 2; ++bj) {
                    f32x4 v0 = acc[ai][bj][m][0], v1 = acc[ai][bj][m][1];
                    if (rope_wave) {
                        f32x4 p0, p1;
#pragma unroll
                        for (int e = 0; e < 4; ++e) { float a0 = v0[e], b0 = v0[e], a1 = v1[e], b1 = v1[e];
                            asm volatile("s_nop 1\n\tv_permlane16_swap_b32 %0, %1" : "+v"(a0), "+v"(b0));
                            asm volatile("s_nop 1\n\tv_permlane16_swap_b32 %0, %1" : "+v"(a1), "+v"(b1));
                            p0[e] = (fq & 1) ? a0 : b0; p1[e] = (fq & 1) ? a1 : b1; }
                        const f32x4 r0 = v0 * c0 + p0 * s0, r1 = v1 * c1 + p1 * s1;
                        if (rot) { v0 = r0; v1 = r1; }
                    }
                    if (act == 3) {
#pragma unroll
                        for (int e = 0; e < 4; ++e) { v0[e] = v0[e] * __builtin_amdgcn_rcpf(1.f + __builtin_amdgcn_exp2f(-1.4426950409f * v0[e])) * 0.08838834764831845f;
                                                       v1[e] = v1[e] * __builtin_amdgcn_rcpf(1.f + __builtin_amdgcn_exp2f(-1.4426950409f * v1[e])) * 0.08838834764831845f; }
                    } else if (act == 4) {
#pragma unroll
                        for (int e = 0; e < 4; ++e) { v0[e] = __builtin_amdgcn_rcpf(1.f + __builtin_amdgcn_exp2f(1.4426950409f * v0[e])); v1[e] = __builtin_amdgcn_rcpf(1.f + __builtin_amdgcn_exp2f(1.4426950409f * v1[e])); }
                    }
                    v0 = v0 * sc; v1 = v1 * sc;
                    u32x4 w; w.x = cvt_pk_bf16(v0[0], v0[1]); w.y = cvt_pk_bf16(v0[2], v0[3]); w.z = cvt_pk_bf16(v1[0], v1[1]); w.w = cvt_pk_bf16(v1[2], v1[3]);
                    *(u32x4*)(rowp + bj * HALF) = w;
                }
            }
    }
};

struct EpiConvGlu {
    static constexpr bool PERM = true, AFTER_DRAIN = false;
    bf16_t* G; const float* cw; const float* cb;
    __device__ __forceinline__ void operator()(f32x4 (&acc)[2][2][4][2], const Unit& u, int wr, int wc, int fr, int fq) const {
        const int chb = u.pn * 128 + wc * 32 + 8 * fq;
        bf16_t* G_ = G; const float* cw_ = cw; const float* cb_ = cb; asm volatile("" : "+s"(G_), "+s"(cw_), "+s"(cb_));
        f32x4 w0[2][2], w1[2][2], w2[2][2], bb[2][2];
#pragma unroll
        for (int bj = 0; bj < 2; ++bj)
#pragma unroll
            for (int n = 0; n < 2; ++n) { const int col = bj * 2816 + chb + 4 * n;
                w0[bj][n] = *(const f32x4*)(cw_ + col); w1[bj][n] = *(const f32x4*)(cw_ + 5632 + col); w2[bj][n] = *(const f32x4*)(cw_ + 2 * 5632 + col); bb[bj][n] = *(const f32x4*)(cb_ + col); }
#pragma unroll
        for (int ai = 0; ai < 2; ++ai) {
            const int tokb = 62 * (4 * u.pm + 2 * ai + wr) - 1 + 4 * fr;
            float pm_[4], nm_[4];
#pragma unroll
            for (int m = 0; m < 4; ++m) { const int t = tokb + m; const int msk = (t < 32768) ? 8191 : 4095; pm_[m] = ((t & msk) == 0) ? 0.f : 1.f; nm_[m] = ((t & msk) == msk) ? 0.f : 1.f; }
#pragma unroll
            for (int bj = 0; bj < 2; ++bj)
#pragma unroll
                for (int n = 0; n < 2; ++n) {
                    const f32x4 x0 = acc[ai][bj][0][n], x1 = acc[ai][bj][1][n], x2 = acc[ai][bj][2][n], x3 = acc[ai][bj][3][n];
                    f32x4 pv, nx;
#pragma unroll
                    for (int e = 0; e < 4; ++e) { float a_, b_;
                        asm volatile("s_nop 1\n\tv_mov_b32_dpp %0, %1 row_shr:1 row_mask:0xf bank_mask:0xf bound_ctrl:1" : "=&v"(a_) : "v"(x3[e]));
                        asm volatile("s_nop 1\n\tv_mov_b32_dpp %0, %1 row_shl:1 row_mask:0xf bank_mask:0xf bound_ctrl:1" : "=&v"(b_) : "v"(x0[e]));
                        pv[e] = a_; nx[e] = b_; }
                    acc[ai][bj][0][n] = bb[bj][n] + w0[bj][n] * (pv * pm_[0]) + w1[bj][n] * x0 + w2[bj][n] * (x1 * nm_[0]);
                    acc[ai][bj][1][n] = bb[bj][n] + w0[bj][n] * (x0 * pm_[1]) + w1[bj][n] * x1 + w2[bj][n] * (x2 * nm_[1]);
                    acc[ai][bj][2][n] = bb[bj][n] + w0[bj][n] * (x1 * pm_[2]) + w1[bj][n] * x2 + w2[bj][n] * (x3 * nm_[2]);
                    acc[ai][bj][3][n] = bb[bj][n] + w0[bj][n] * (x2 * pm_[3]) + w1[bj][n] * x3 + w2[bj][n] * (nx * nm_[3]);
                }
#pragma unroll
            for (int m = 0; m < 4; ++m) {
                const int pos = 4 * fr + m, t = tokb + m;
                unsigned wv[4];
#pragma unroll
                for (int n = 0; n < 2; ++n) { float o[4];
#pragma unroll
                    for (int e = 0; e < 4; ++e) { const float x = acc[ai][0][m][n][e]; const float z = -2.302208198f * (x + 0.044715f * x * x * x);
                        o[e] = x * __builtin_amdgcn_rcpf(1.f + __builtin_amdgcn_exp2f(z)) * acc[ai][1][m][n][e]; }
                    wv[2 * n] = cvt_pk_bf16(o[0], o[1]); wv[2 * n + 1] = cvt_pk_bf16(o[2], o[3]); }
                if (pos >= 1 && pos <= 62 && t < 65536) *(u32x4*)(G_ + (size_t)t * 2816 + chb) = (u32x4){wv[0], wv[1], wv[2], wv[3]};
            }
        }
    }
};
template <class Epi, class Sched, bool ALIGN_EPI = false, bool SP2 = false, bool APERM = false>
__device__ __forceinline__ void gemm_phase(PG8_LAS unsigned char* lds, const Gemm g, const Sched& S, const Epi& E) {
    int tid_l = threadIdx.x; asm volatile("" : "+v"(tid_l));
    const int tid = tid_l, wid = __builtin_amdgcn_readfirstlane(tid >> 6), lane = tid & 63, wr = wid >> 2, wc = wid & 3, fr = lane & 15, fq = lane >> 4;
    const int K = g.K, nt = K / BK;
    unsigned voffA[2], voffB[2];
#pragma unroll
    for (int i = 0; i < 2; ++i) { int R, C; stage_rc(tid * 16 + i * 8192, R, C); const int Rb = Epi::PERM ? ((R & ~31) + perm32(R & 31)) : R;
        const int Ra = APERM ? (62 * (R >> 6) + 4 * (R & 15) + ((R >> 4) & 3)) : R;
        voffA[i] = (unsigned)(Ra * K + C) * 2u; voffB[i] = (unsigned)(Rb * K + C) * 2u; }
    const size_t kstep = (size_t)(BK * 2);
    const size_t hstep = (size_t)HALF * K * 2;
    const size_t tstep = 2 * hstep;
    const size_t hstepA = APERM ? (size_t)124 * K * 2 : hstep, tstepA = 2 * hstepA;
    const unsigned ldsw = (unsigned)wid * 1024u;
    const int aoff = lds_byte(wr * 64 + fr, fq * 8), boff = lds_byte(wc * 32 + fr, fq * 8);
#define PG8_SA(b, h) (((b) * 2 + (h)) * HTB)
#define PG8_SB(b, h) ((4 + (b) * 2 + (h)) * HTB)
#define PG8_STAGE(bufoff, gbase, voff) do { _Pragma("unroll") for (int _i = 0; _i < 2; ++_i) \
        __builtin_amdgcn_global_load_lds((const unsigned*)((const char*)(gbase) + (voff)[_i]), (PG8_LAS unsigned*)(lds + (bufoff) + ldsw + _i * 8192), 16, 0, 0); } while (0)
#define PG8_LDA(dst, b, h) do { _Pragma("unroll") for (int m = 0; m < 4; ++m) _Pragma("unroll") for (int k = 0; k < 2; ++k) dst[m][k] = *(const PG8_LAS bf16x8*)(lds + PG8_SA(b, h) + aoff + m * 2048 + k * 1024); } while (0)
#define PG8_LDB(dst, b, h) do { _Pragma("unroll") for (int n = 0; n < 2; ++n) _Pragma("unroll") for (int k = 0; k < 2; ++k) dst[n][k] = *(const PG8_LAS bf16x8*)(lds + PG8_SB(b, h) + boff + n * 2048 + k * 1024); } while (0)
#define PG8_MMA(ai, bj, At, Bt) do { __builtin_amdgcn_s_setprio(1); _Pragma("unroll") for (int m = 0; m < 4; ++m) _Pragma("unroll") for (int n = 0; n < 2; ++n) _Pragma("unroll") for (int k = 0; k < 2; ++k) \
        acc[ai][bj][m][n] = __builtin_amdgcn_mfma_f32_16x16x32_bf16(Bt[n][k], At[m][k], acc[ai][bj][m][n], 0, 0, 0); __builtin_amdgcn_s_setprio(0); } while (0)
#define PG8_WAIT_V(n) asm volatile("s_waitcnt vmcnt(" #n ")" ::: "memory")
#define PG8_WAIT_L(n) asm volatile("s_waitcnt lgkmcnt(" #n ")" ::: "memory")
#define PG8_BAR __builtin_amdgcn_s_barrier()
#define PG8_SCHED __builtin_amdgcn_sched_barrier(0)
    Unit cur, nxt; int ui = 0;
    if (!S.next(0, cur)) return;
    f32x4 acc[2][2][4][2];
#pragma unroll
    for (int a = 0; a < 2; ++a)
#pragma unroll
        for (int b = 0; b < 2; ++b)
#pragma unroll
            for (int m = 0; m < 4; ++m)
#pragma unroll
                for (int n = 0; n < 2; ++n) acc[a][b][m][n] = (f32x4){0.f, 0.f, 0.f, 0.f};
    bf16x8 At[4][2], B0[2][2], B1[2][2];
    const char* cA = (const char*)g.A + (size_t)cur.pm * tstepA; const char* cB = (const char*)g.Bt + (size_t)cur.pn * tstep;
    S.a_ready(cur);
    if constexpr (SP2) {
        PG8_STAGE(PG8_SB(0, 0), cB, voffB); PG8_STAGE(PG8_SB(0, 1), cB + hstep, voffB); PG8_STAGE(PG8_SA(0, 0), cA, voffA); PG8_STAGE(PG8_SA(0, 1), cA + hstepA, voffA);
        if (wr == 1) PG8_BAR;
        PG8_WAIT_V(2); PG8_BAR;
        PG8_STAGE(PG8_SB(1, 0), cB + kstep, voffB); PG8_STAGE(PG8_SA(1, 0), cA + kstep, voffA); PG8_STAGE(PG8_SB(1, 1), cB + hstep + kstep, voffB);
        PG8_WAIT_V(6); PG8_BAR;
    } else {
        PG8_STAGE(PG8_SB(0, 0), cB, voffB); PG8_STAGE(PG8_SA(0, 0), cA, voffA); PG8_STAGE(PG8_SB(0, 1), cB + hstep, voffB); PG8_STAGE(PG8_SA(0, 1), cA + hstepA, voffA);
        if (wr == 1) PG8_BAR;
        PG8_WAIT_V(4); PG8_BAR;
        PG8_STAGE(PG8_SB(1, 0), cB + kstep, voffB); PG8_STAGE(PG8_SA(1, 0), cA + kstep, voffA); PG8_STAGE(PG8_SB(1, 1), cB + hstep + kstep, voffB);
        PG8_WAIT_V(6); PG8_BAR;
    }
    for (;;) {
        const bool has_next = S.next(ui + 1, nxt);
        const char* nA = has_next ? (const char*)g.A + (size_t)nxt.pm * tstepA : cA; const char* nB = has_next ? (const char*)g.Bt + (size_t)nxt.pn * tstep : cB;
        for (int t = 0; t < nt; t += 2) {
            const bool last = (t == nt - 2);
            const char* a1 = cA + (size_t)(t + 1) * kstep;
            const char* a2 = last ? nA : cA + (size_t)(t + 2) * kstep; const char* b2 = last ? nB : cB + (size_t)(t + 2) * kstep;
            const char* a3 = a2 + kstep; const char* b3 = b2 + kstep;
            if (last && has_next) S.a_ready(nxt);
            if constexpr (SP2) {
            PG8_LDB(B0, 0, 0); PG8_LDB(B1, 0, 1); PG8_SCHED; PG8_LDA(At, 0, 0); PG8_STAGE(PG8_SA(1, 1), a1 + hstepA, voffA);
            PG8_WAIT_V(8); PG8_WAIT_L(0); PG8_BAR; PG8_MMA(0, 0, At, B0); PG8_MMA(0, 1, At, B1); PG8_BAR; PG8_SCHED;
            PG8_LDA(At, 0, 1); PG8_STAGE(PG8_SB(0, 0), b2, voffB); PG8_STAGE(PG8_SB(0, 1), b2 + hstep, voffB); PG8_STAGE(PG8_SA(0, 0), a2, voffA);
            PG8_WAIT_V(8); PG8_WAIT_L(0); PG8_BAR; PG8_MMA(1, 0, At, B0); PG8_MMA(1, 1, At, B1); PG8_BAR; PG8_SCHED;
            PG8_LDB(B0, 1, 0); PG8_LDB(B1, 1, 1); PG8_SCHED; PG8_LDA(At, 1, 0); PG8_STAGE(PG8_SA(0, 1), a2 + hstepA, voffA);
            PG8_WAIT_V(8); PG8_WAIT_L(0); PG8_BAR; PG8_MMA(0, 0, At, B0); PG8_MMA(0, 1, At, B1); PG8_BAR; PG8_SCHED;
            PG8_LDA(At, 1, 1); PG8_STAGE(PG8_SB(1, 0), b3, voffB); PG8_STAGE(PG8_SB(1, 1), b3 + hstep, voffB); PG8_STAGE(PG8_SA(1, 0), a3, voffA);
            PG8_WAIT_V(8); PG8_WAIT_L(0); PG8_BAR; PG8_MMA(1, 0, At, B0); PG8_MMA(1, 1, At, B1); PG8_BAR; PG8_SCHED;
            } else {
            PG8_LDB(B0, 0, 0); PG8_SCHED; PG8_LDA(At, 0, 0); PG8_STAGE(PG8_SA(1, 1), a1 + hstepA, voffA);
            PG8_WAIT_L(8); PG8_BAR; PG8_WAIT_L(0); PG8_MMA(0, 0, At, B0); PG8_BAR; PG8_SCHED;
            PG8_LDB(B1, 0, 1); PG8_STAGE(PG8_SB(0, 0), b2, voffB);
            PG8_BAR; PG8_WAIT_L(0); PG8_MMA(0, 1, At, B1); PG8_BAR;
            PG8_LDA(At, 0, 1); PG8_STAGE(PG8_SA(0, 0), a2, voffA);
            PG8_BAR; PG8_WAIT_L(0); PG8_MMA(1, 0, At, B0); PG8_BAR; PG8_SCHED;
            PG8_STAGE(PG8_SB(0, 1), b2 + hstep, voffB);
            PG8_WAIT_V(6); PG8_BAR; PG8_MMA(1, 1, At, B1); PG8_BAR;
            PG8_LDB(B0, 1, 0); PG8_SCHED; PG8_LDA(At, 1, 0); PG8_STAGE(PG8_SA(0, 1), a2 + hstepA, voffA);
            PG8_WAIT_L(8); PG8_BAR; PG8_WAIT_L(0); PG8_MMA(0, 0, At, B0); PG8_BAR; PG8_SCHED;
            PG8_LDB(B1, 1, 1); PG8_STAGE(PG8_SB(1, 0), b3, voffB);
            PG8_BAR; PG8_WAIT_L(0); PG8_MMA(0, 1, At, B1); PG8_BAR;
            PG8_LDA(At, 1, 1); PG8_STAGE(PG8_SA(1, 0), a3, voffA);
            PG8_BAR; PG8_WAIT_L(0); PG8_MMA(1, 0, At, B0); PG8_BAR; PG8_SCHED;
            PG8_STAGE(PG8_SB(1, 1), b3 + hstep, voffB);
            PG8_WAIT_V(6); PG8_BAR; PG8_MMA(1, 1, At, B1); PG8_BAR;
            }
        }
        if constexpr (ALIGN_EPI) { if (wr == 0) PG8_BAR; }
        if constexpr (!Epi::AFTER_DRAIN) { E(acc, cur, wr, wc, fr, fq); S.done(cur); }
        if (!has_next) break;
#pragma unroll
        for (int a = 0; a < 2; ++a)
#pragma unroll
            for (int b = 0; b < 2; ++b)
#pragma unroll
                for (int m = 0; m < 4; ++m)
#pragma unroll
                    for (int n = 0; n < 2; ++n) acc[a][b][m][n] = (f32x4){0.f, 0.f, 0.f, 0.f};
        cur = nxt; cA = nA; cB = nB; ++ui;
        if constexpr (ALIGN_EPI) { if (wr == 1) PG8_BAR; }
    }
    PG8_WAIT_V(0);
    if constexpr (!ALIGN_EPI) { if (wr == 0) PG8_BAR; }
    PG8_BAR;
    if constexpr (Epi::AFTER_DRAIN) { E.fused(acc, cur, wr, wc, fr, fq, lds, wid, lane); S.done(cur); }
#undef PG8_SA
#undef PG8_SB
#undef PG8_STAGE
#undef PG8_LDA
#undef PG8_LDB
#undef PG8_MMA
#undef PG8_WAIT_V
#undef PG8_WAIT_L
#undef PG8_BAR
#undef PG8_SCHED
}
}

#define LAS __attribute__((address_space(3)))
typedef unsigned short bf16_t;
typedef short bf16x8 __attribute__((ext_vector_type(8)));
typedef short s16x4 __attribute__((ext_vector_type(4)));
typedef float f32x16 __attribute__((ext_vector_type(16)));
typedef float f32x4 __attribute__((ext_vector_type(4)));
typedef float f32x2 __attribute__((ext_vector_type(2)));
typedef unsigned u32x4 __attribute__((ext_vector_type(4)));
typedef unsigned u32x2 __attribute__((ext_vector_type(2)));
typedef __bf16 bf16x2_t __attribute__((ext_vector_type(2)));
typedef LAS unsigned char* ldsp;

constexpr int M_TOK = 65536, MH = 32768, DM = 1024, DFF = 2816;
constexpr float C2 = 0.125f * 1.4426950408889634f;
constexpr size_t MiB = 1u << 20;
constexpr size_t WS_ROPE = 0;
constexpr size_t WS_OML = 512 * 1024;
constexpr size_t WS_BAR = 768 * 1024;
constexpr size_t WS_W = 1 * MiB;
constexpr size_t WS_H = 117 * MiB;
constexpr size_t WS_Y = 245 * MiB;
constexpr size_t WS_BIG = 373 * MiB;
constexpr size_t WS_END = 1013 * MiB;
constexpr size_t WE_AQKV = 0, WE_AO = WE_AQKV + 2ull * 3072 * 1024, WE_BQKV = WE_AO + 2ull * 1024 * 1024, WE_BO = WE_BQKV + 9216ull * 1024,
                 WE_CIN = WE_BO + 1024ull * 1024, WE_CO = WE_CIN + 5120ull * 1024, WE_FIN = WE_CO + 1024ull * 1024, WE_FOUT = WE_FIN + 4ull * 5632 * 1024,
                 WE_END = WE_FOUT + 4ull * 2816 * 1024;
static_assert(WE_END * 2 <= 116 * MiB, "weights fit");

struct Params { const float* in[17]; float* out; unsigned char* ws; double invf[8]; int pad0, pad1; };

__device__ __forceinline__ float bflo(unsigned u) { return __uint_as_float(u << 16); }
__device__ __forceinline__ float bfhi(unsigned u) { return __uint_as_float(u & 0xffff0000u); }
__device__ __forceinline__ unsigned pkbf(float lo, float hi) { f32x2 v = {lo, hi}; bf16x2_t b = __builtin_convertvector(v, bf16x2_t); return __builtin_bit_cast(unsigned, b); }
__device__ __forceinline__ float dppf(float v, int ctrl_xor1) { return v; }
#define DPPF(v, ctrl) __builtin_bit_cast(float, __builtin_amdgcn_update_dpp(0, __builtin_bit_cast(int, (v)), (ctrl), 0xf, 0xf, false))
__device__ __forceinline__ float swap16_sum(float m) { auto rr = __builtin_amdgcn_permlane16_swap(__float_as_uint(m), __float_as_uint(m), false, false); return __uint_as_float(rr[0]) + __uint_as_float(rr[1]); }
__device__ __forceinline__ float swap32_sum(float m) { auto rr = __builtin_amdgcn_permlane32_swap(__float_as_uint(m), __float_as_uint(m), false, false); return __uint_as_float(rr[0]) + __uint_as_float(rr[1]); }
__device__ __forceinline__ float wave_sum(float v) {
  v += DPPF(v, 0xB1); v += DPPF(v, 0x4E); v += DPPF(v, 0x124); v += DPPF(v, 0x128);
  v = swap16_sum(v); v = swap32_sum(v);
  return v;
}
__device__ __forceinline__ int fresh_tid() { int t = threadIdx.x; asm volatile("" : "+v"(t)); return t; }
typedef const Params __attribute__((address_space(4)))* CParamsPtr;
__device__ __forceinline__ CParamsPtr kargs() { CParamsPtr kp = (CParamsPtr)__builtin_amdgcn_kernarg_segment_ptr(); asm volatile("" : "+s"(kp)); return kp; }
__device__ __forceinline__ float half_swap_max(float m) { auto rr = __builtin_amdgcn_permlane32_swap(__float_as_uint(m), __float_as_uint(m), false, false); return fmaxf(__uint_as_float(rr[0]), __uint_as_float(rr[1])); }
__device__ __forceinline__ float half_swap_sum(float m) { auto rr = __builtin_amdgcn_permlane32_swap(__float_as_uint(m), __float_as_uint(m), false, false); return __uint_as_float(rr[0]) + __uint_as_float(rr[1]); }

__device__ __forceinline__ void transpose_item(const float* W, int K, int N, bf16_t* WT, LAS float* scr, int item, int lane, bool glu) {
  const int nblk = N / 32, kb = item / nblk, nb = item % nblk, k0 = 64 * kb, n0 = 32 * nb;
#pragma unroll 8
  for (int i = 0; i < 32; ++i) { const int kk = 2 * i + (lane >> 5); scr[kk * 33 + (lane & 31)] = W[(size_t)(k0 + kk) * N + n0 + (lane & 31)]; }
  asm volatile("s_waitcnt lgkmcnt(0)" ::: "memory");
  const int c = lane & 7;
#pragma unroll
  for (int j = 0; j < 4; ++j) { const int n = (lane >> 3) + 8 * j; const LAS float* s = scr + (8 * c) * 33 + n;
    u32x4 o; o.x = pkbf(s[0 * 33], s[1 * 33]); o.y = pkbf(s[2 * 33], s[3 * 33]); o.z = pkbf(s[4 * 33], s[5 * 33]); o.w = pkbf(s[6 * 33], s[7 * 33]);
    int nr = n0 + n; if (glu) { const int bj = nr >= 2816 ? 1 : 0, cc = nr - 2816 * bj; nr = 256 * (cc >> 7) + 128 * bj + (cc & 127); }
    *(u32x4*)(WT + (size_t)nr * K + k0 + 8 * c) = o; }
  asm volatile("s_waitcnt lgkmcnt(0)" ::: "memory");
}
__device__ __forceinline__ void transpose_mat(const float* W, int K, int N, bf16_t* WT, LAS float* scr, int gw, int ngw, int lane, bool glu) {
  const int items = (K / 64) * (N / 32);
  for (int it = gw; it < items; it += ngw) transpose_item(W, K, N, WT, scr, it, lane, glu);
}

__device__ __forceinline__ float row_rstd(const f32x4 (&v)[4], float eps) {
  float s = 0.f;
#pragma unroll
  for (int j = 0; j < 4; ++j) s += (v[j].x * v[j].x + v[j].y * v[j].y) + (v[j].z * v[j].z + v[j].w * v[j].w);
  return rsqrtf(wave_sum(s) * (1.f / 1024.f) + eps);
}
__device__ __forceinline__ void store_h_row(bf16_t* hrow, const f32x4 (&v)[4], float rstd, const float* g, int lane) {
#pragma unroll
  for (int j = 0; j < 4; ++j) { const f32x4 gg = *(const f32x4*)(g + 4 * lane + 256 * j);
    u32x2 w; w.x = pkbf(v[j].x * rstd * gg.x, v[j].y * rstd * gg.y); w.y = pkbf(v[j].z * rstd * gg.z, v[j].w * rstd * gg.w);
    *(u32x2*)(hrow + 4 * lane + 256 * j) = w; }
}
__device__ __forceinline__ void phase_init_norm(const float* xp, const float* xs, float* x, bf16_t* H, const float* g, int gw, int ngw, int lane) {
  for (int m = gw; m < M_TOK; m += ngw) {
    const float* src = (m < MH) ? xp + (size_t)m * DM : xs + (size_t)(m - MH) * DM;
    f32x4 v[4];
#pragma unroll
    for (int j = 0; j < 4; ++j) v[j] = *(const f32x4*)(src + 4 * lane + 256 * j);
    store_h_row(H + (size_t)m * DM, v, row_rstd(v, 1e-6f), g, lane);
  }
}
__device__ __forceinline__ void phase_res_norm(const bf16_t* Y, float* x, bf16_t* H, const float* gA, const float* gB, int gw, int ngw, int lane, const float* xp, const float* xs) {
  float ga_[2][8], gb_[2][8];
#pragma unroll
  for (int j = 0; j < 2; ++j) { const f32x4 g0 = *(const f32x4*)(gA + 8 * lane + 512 * j), g1 = *(const f32x4*)(gA + 8 * lane + 512 * j + 4);
    ga_[j][0] = g0.x; ga_[j][1] = g0.y; ga_[j][2] = g0.z; ga_[j][3] = g0.w; ga_[j][4] = g1.x; ga_[j][5] = g1.y; ga_[j][6] = g1.z; ga_[j][7] = g1.w;
    const float* gq = gB ? gB : gA; const f32x4 h0 = *(const f32x4*)(gq + 8 * lane + 512 * j), h1 = *(const f32x4*)(gq + 8 * lane + 512 * j + 4);
    gb_[j][0] = h0.x; gb_[j][1] = h0.y; gb_[j][2] = h0.z; gb_[j][3] = h0.w; gb_[j][4] = h1.x; gb_[j][5] = h1.y; gb_[j][6] = h1.z; gb_[j][7] = h1.w; }
  for (int m = gw; m < M_TOK; m += ngw) {
    bf16_t* xb = (bf16_t*)((char*)x + (size_t)m * 4096 + 2048);
    float y[2][8], v[2][8];
#pragma unroll
    for (int j = 0; j < 2; ++j) { const u32x4 w = *(const u32x4*)(Y + (size_t)m * DM + 8 * lane + 512 * j);
      y[j][0] = bflo(w.x); y[j][1] = bfhi(w.x); y[j][2] = bflo(w.y); y[j][3] = bfhi(w.y); y[j][4] = bflo(w.z); y[j][5] = bfhi(w.z); y[j][6] = bflo(w.w); y[j][7] = bfhi(w.w); }
    if (xp) { const float* xsrc = (m < MH) ? xp + (size_t)m * DM : xs + (size_t)(m - MH) * DM;
#pragma unroll
      for (int j = 0; j < 2; ++j) { const f32x4 a = *(const f32x4*)(xsrc + 8 * lane + 512 * j), c = *(const f32x4*)(xsrc + 8 * lane + 512 * j + 4);
        v[j][0] = a.x; v[j][1] = a.y; v[j][2] = a.z; v[j][3] = a.w; v[j][4] = c.x; v[j][5] = c.y; v[j][6] = c.z; v[j][7] = c.w; }
    } else {
#pragma unroll
      for (int j = 0; j < 2; ++j) { const u32x4 w = *(const u32x4*)(xb + 8 * lane + 512 * j);
        v[j][0] = bflo(w.x); v[j][1] = bfhi(w.x); v[j][2] = bflo(w.y); v[j][3] = bfhi(w.y); v[j][4] = bflo(w.z); v[j][5] = bfhi(w.z); v[j][6] = bflo(w.w); v[j][7] = bfhi(w.w); }
    }
    float sy = 0.f;
#pragma unroll
    for (int j = 0; j < 2; ++j)
#pragma unroll
      for (int e = 0; e < 8; ++e) sy += y[j][e] * y[j][e];
    const float ry = rsqrtf(wave_sum(sy) * (1.f / 1024.f) + 1e-6f);
    float sv = 0.f;
#pragma unroll
    for (int j = 0; j < 2; ++j)
#pragma unroll
      for (int e = 0; e < 8; ++e) { v[j][e] += y[j][e] * ry * ga_[j][e]; sv += v[j][e] * v[j][e]; }
    if (gB) {
      const float rx = rsqrtf(wave_sum(sv) * (1.f / 1024.f) + 1e-6f);
#pragma unroll
      for (int j = 0; j < 2; ++j) {
        u32x4 w; w.x = pkbf(v[j][0], v[j][1]); w.y = pkbf(v[j][2], v[j][3]); w.z = pkbf(v[j][4], v[j][5]); w.w = pkbf(v[j][6], v[j][7]);
        *(u32x4*)(xb + 8 * lane + 512 * j) = w;
        u32x4 h; h.x = pkbf(v[j][0] * rx * gb_[j][0], v[j][1] * rx * gb_[j][1]); h.y = pkbf(v[j][2] * rx * gb_[j][2], v[j][3] * rx * gb_[j][3]); h.z = pkbf(v[j][4] * rx * gb_[j][4], v[j][5] * rx * gb_[j][5]); h.w = pkbf(v[j][6] * rx * gb_[j][6], v[j][7] * rx * gb_[j][7]);
        *(u32x4*)(H + (size_t)m * DM + 8 * lane + 512 * j) = h; }
    } else {
#pragma unroll
      for (int j = 0; j < 2; ++j) { *(f32x4*)(x + (size_t)m * DM + 8 * lane + 512 * j) = (f32x4){v[j][0], v[j][1], v[j][2], v[j][3]}; *(f32x4*)(x + (size_t)m * DM + 8 * lane + 512 * j + 4) = (f32x4){v[j][4], v[j][5], v[j][6], v[j][7]}; }
    }
  }
}

__device__ __forceinline__ void rope_seg(bf16_t* pp, int pos, float sc, const float* rope, int lane) {
  u32x4 a = *(const u32x4*)pp, b = *(const u32x4*)(pp + 8);
  float x1[8] = {bflo(a.x), bfhi(a.x), bflo(a.y), bfhi(a.y), bflo(a.z), bfhi(a.z), bflo(a.w), bfhi(a.w)};
  float x2[8] = {bflo(b.x), bfhi(b.x), bflo(b.y), bfhi(b.y), bflo(b.z), bfhi(b.z), bflo(b.w), bfhi(b.w)};
  if ((lane & 3) == 0) { const float* cs = rope + (size_t)pos * 16;
#pragma unroll
    for (int i = 0; i < 8; ++i) { const float c = cs[i], s = cs[8 + i]; const float u = x1[i] * c - x2[i] * s, w = x2[i] * c + x1[i] * s; x1[i] = u; x2[i] = w; } }
  a.x = pkbf(x1[0] * sc, x1[1] * sc); a.y = pkbf(x1[2] * sc, x1[3] * sc); a.z = pkbf(x1[4] * sc, x1[5] * sc); a.w = pkbf(x1[6] * sc, x1[7] * sc);
  b.x = pkbf(x2[0] * sc, x2[1] * sc); b.y = pkbf(x2[2] * sc, x2[3] * sc); b.z = pkbf(x2[4] * sc, x2[5] * sc); b.w = pkbf(x2[6] * sc, x2[7] * sc);
  *(u32x4*)pp = a; *(u32x4*)(pp + 8) = b;
}

__device__ __forceinline__ s16x4 vtr(ldsp p) { typedef short v4i16_t __attribute__((ext_vector_type(4))); return __builtin_bit_cast(s16x4, __builtin_amdgcn_ds_read_tr16_b64_v4i16((LAS v4i16_t*)p)); }
__device__ __forceinline__ int voffa(int row, int ch) { return 2048 * (row >> 3) + 512 * (ch >> 2) + 64 * (row & 7) + 16 * ((ch & 3) ^ ((row >> 2) & 3)); }
__device__ __forceinline__ int koff(int row, int ch) { return 128 * row + ((ch ^ ((row >> 1) & 7)) << 4); }
__device__ __forceinline__ f32x16 qk_block(ldsp Kt, const int (&ko)[4], const bf16x8 (&qf)[4]) {
  f32x16 acc = {0.f, 0.f, 0.f, 0.f, 0.f, 0.f, 0.f, 0.f, 0.f, 0.f, 0.f, 0.f, 0.f, 0.f, 0.f, 0.f};
#pragma unroll
  for (int ds = 0; ds < 4; ++ds) { const bf16x8 kf = *(const LAS bf16x8*)(Kt + ko[ds]); acc = __builtin_amdgcn_mfma_f32_32x32x16_bf16(kf, qf[ds], acc, 0, 0, 0); }
  return acc;
}
__device__ __forceinline__ void k_load(bf16x8 (&kf)[4], ldsp Kt, const int (&ko)[4]) {
#pragma unroll
  for (int ds = 0; ds < 4; ++ds) kf[ds] = *(const LAS bf16x8*)(Kt + ko[ds]);
}
__device__ __forceinline__ f32x16 qk_frag(const bf16x8 (&kf)[4], const bf16x8 (&qf)[4]) {
  f32x16 acc = {0.f, 0.f, 0.f, 0.f, 0.f, 0.f, 0.f, 0.f, 0.f, 0.f, 0.f, 0.f, 0.f, 0.f, 0.f, 0.f};
#pragma unroll
  for (int ds = 0; ds < 4; ++ds) acc = __builtin_amdgcn_mfma_f32_32x32x16_bf16(kf[ds], qf[ds], acc, 0, 0, 0);
  return acc;
}
constexpr float BIGSUM = 1.0995116e12f;
template <int NDB> __device__ __forceinline__ void softmax_block(f32x16& s, float& m, float& l, f32x16 (&o)[NDB], bf16x8 (&p)[2]) {
  if (__all(m == 0.f)) {
#pragma unroll
    for (int r = 0; r < 16; ++r) s[r] = __builtin_amdgcn_exp2f(s[r]);
  } else {
#pragma unroll
    for (int r = 0; r < 16; ++r) s[r] = __builtin_amdgcn_exp2f(s[r] - m);
  }
  float sum = 0.f;
#pragma unroll
  for (int r = 0; r < 16; ++r) sum += s[r];
  const float tot = half_swap_sum(sum);
  if (__any(!(tot <= BIGSUM))) {
    float mx = s[0];
#pragma unroll
    for (int r = 1; r < 16; ++r) mx = fmaxf(mx, s[r]);
    mx = half_swap_max(mx);
    const float dl = (tot <= BIGSUM) ? 0.f : __log2f(fminf(mx, 3.0e38f)); m += dl;
    const float f = __builtin_amdgcn_exp2f(-dl); l *= f; sum *= f;
#pragma unroll
    for (int r = 0; r < 16; ++r) s[r] *= f;
#pragma unroll
    for (int d = 0; d < NDB; ++d)
#pragma unroll
      for (int r = 0; r < 16; ++r) o[d][r] *= f;
  }
  l += sum;
  u32x4 w0, w1;
  w0.x = pkbf(s[0], s[1]); w0.y = pkbf(s[2], s[3]); w0.z = pkbf(s[4], s[5]); w0.w = pkbf(s[6], s[7]);
  w1.x = pkbf(s[8], s[9]); w1.y = pkbf(s[10], s[11]); w1.z = pkbf(s[12], s[13]); w1.w = pkbf(s[14], s[15]);
  p[0] = __builtin_bit_cast(bf16x8, w0); p[1] = __builtin_bit_cast(bf16x8, w1);
}
template <int DV, bool TWO> __device__ __forceinline__ void pv_block(ldsp Vt, int vb0, int vb1, const bf16x8 (&p0)[2], const bf16x8 (&p1)[2], f32x16 (&o0)[DV / 32], f32x16 (&o1)[DV / 32]) {
  constexpr int NDB = DV / 32, NST = 2 * NDB;
#define PV_I0(i) ((DV == 128) ? 2048 * (2 * ((i) / NDB)) + 512 * ((i) % NDB) : 128 * (16 * ((i) / NDB)) + 64 * ((i) % NDB))
#define PV_I1(i) ((DV == 128) ? 2048 * (2 * ((i) / NDB) + 1) + 512 * ((i) % NDB) : 128 * (16 * ((i) / NDB) + 8) + 64 * ((i) % NDB))
#define PV_RD(dl, dh, i) do { asm volatile("ds_read_b64_tr_b16 %0, %1 offset:%c2" : "=&v"(dl) : "v"(a0), "i"(PV_I0(i)) : "memory"); \
                              asm volatile("ds_read_b64_tr_b16 %0, %1 offset:%c2" : "=&v"(dh) : "v"(a1), "i"(PV_I1(i)) : "memory"); } while (0)
  const unsigned a0 = (unsigned)(unsigned long)(Vt + vb0), a1 = (unsigned)(unsigned long)(Vt + vb1);
  s16x4 lo[2], hh[2];
  PV_RD(lo[0], hh[0], 0);
#pragma unroll
  for (int i = 0; i < NST; ++i) {
    if (i + 1 < NST) { PV_RD(lo[(i + 1) & 1], hh[(i + 1) & 1], i + 1); asm volatile("s_waitcnt lgkmcnt(2)" ::: "memory"); }
    else asm volatile("s_waitcnt lgkmcnt(0)" ::: "memory");
    __builtin_amdgcn_sched_barrier(0);
    const s16x4 l_ = lo[i & 1], h_ = hh[i & 1];
    const bf16x8 a = {l_[0], l_[1], l_[2], l_[3], h_[0], h_[1], h_[2], h_[3]};
    const int s = i / NDB, db = i % NDB;
    o0[db] = __builtin_amdgcn_mfma_f32_32x32x16_bf16(a, p0[s], o0[db], 0, 0, 0);
    if (TWO) o1[db] = __builtin_amdgcn_mfma_f32_32x32x16_bf16(a, p1[s], o1[db], 0, 0, 0);
    __builtin_amdgcn_sched_barrier(0);
  }
#undef PV_I0
#undef PV_I1
#undef PV_RD
}

__device__ __forceinline__ void sm_pv(f32x16& s, float& m, float& l, f32x16 (&oself)[4], bf16x8 (&pout)[2], ldsp Vt, int vb0, int vb1, const bf16x8 (&pin)[2], f32x16 (&oacc)[4]) {
  if (!__all(m == 0.f)) {
#pragma unroll
    for (int r = 0; r < 16; ++r) s[r] -= m;
  }
#define SP_I0(i) (2048 * (2 * ((i) / 4)) + 512 * ((i) % 4))
#define SP_I1(i) (2048 * (2 * ((i) / 4) + 1) + 512 * ((i) % 4))
#define SP_RD(dl, dh, i) do { asm volatile("ds_read_b64_tr_b16 %0, %1 offset:%c2" : "=&v"(dl) : "v"(a0), "i"(SP_I0(i)) : "memory"); \
                              asm volatile("ds_read_b64_tr_b16 %0, %1 offset:%c2" : "=&v"(dh) : "v"(a1), "i"(SP_I1(i)) : "memory"); } while (0)
  const unsigned a0 = (unsigned)(unsigned long)(Vt + vb0), a1 = (unsigned)(unsigned long)(Vt + vb1);
  s16x4 lo[2], hh[2];
  SP_RD(lo[0], hh[0], 0);
#pragma unroll
  for (int i = 0; i < 8; ++i) {
    if (i + 1 < 8) { SP_RD(lo[(i + 1) & 1], hh[(i + 1) & 1], i + 1); asm volatile("s_waitcnt lgkmcnt(2)" ::: "memory"); }
    else asm volatile("s_waitcnt lgkmcnt(0)" ::: "memory");
    __builtin_amdgcn_sched_barrier(0);
    const s16x4 l_ = lo[i & 1], h_ = hh[i & 1];
    const bf16x8 a = {l_[0], l_[1], l_[2], l_[3], h_[0], h_[1], h_[2], h_[3]};
    oacc[i % 4] = __builtin_amdgcn_mfma_f32_32x32x16_bf16(a, pin[i / 4], oacc[i % 4], 0, 0, 0);
    s[2 * i] = __builtin_amdgcn_exp2f(s[2 * i]); s[2 * i + 1] = __builtin_amdgcn_exp2f(s[2 * i + 1]);
    __builtin_amdgcn_sched_barrier(0);
  }
#undef SP_I0
#undef SP_I1
#undef SP_RD
  float sum = 0.f;
#pragma unroll
  for (int r = 0; r < 16; ++r) sum += s[r];
  const float tot = half_swap_sum(sum);
  if (__any(!(tot <= BIGSUM))) {
    float mx = s[0];
#pragma unroll
    for (int r = 1; r < 16; ++r) mx = fmaxf(mx, s[r]);
    mx = half_swap_max(mx);
    const float dl = (tot <= BIGSUM) ? 0.f : __log2f(fminf(mx, 3.0e38f)); m += dl;
    const float f = __builtin_amdgcn_exp2f(-dl); l *= f; sum *= f;
#pragma unroll
    for (int r = 0; r < 16; ++r) s[r] *= f;
#pragma unroll
    for (int d = 0; d < 4; ++d)
#pragma unroll
      for (int r = 0; r < 16; ++r) oself[d][r] *= f;
  }
  l += sum;
  u32x4 w0, w1;
  w0.x = pkbf(s[0], s[1]); w0.y = pkbf(s[2], s[3]); w0.z = pkbf(s[4], s[5]); w0.w = pkbf(s[6], s[7]);
  w1.x = pkbf(s[8], s[9]); w1.y = pkbf(s[10], s[11]); w1.z = pkbf(s[12], s[13]); w1.w = pkbf(s[14], s[15]);
  pout[0] = __builtin_bit_cast(bf16x8, w0); pout[1] = __builtin_bit_cast(bf16x8, w1);
}

__device__ __forceinline__ void sm_finish(f32x16& s, float& m, float& l, f32x16 (&oself)[4], bf16x8 (&pout)[2]) {
  float sum = 0.f;
#pragma unroll
  for (int r = 0; r < 16; ++r) sum += s[r];
  const float tot = half_swap_sum(sum);
  if (__any(!(tot <= BIGSUM))) {
    float mx = s[0];
#pragma unroll
    for (int r = 1; r < 16; ++r) mx = fmaxf(mx, s[r]);
    mx = half_swap_max(mx);
    const float dl = (tot <= BIGSUM) ? 0.f : __log2f(fminf(mx, 3.0e38f)); m += dl;
    const float f = __builtin_amdgcn_exp2f(-dl); l *= f; sum *= f;
#pragma unroll
    for (int r = 0; r < 16; ++r) s[r] *= f;
#pragma unroll
    for (int d = 0; d < 4; ++d)
#pragma unroll
      for (int r = 0; r < 16; ++r) oself[d][r] *= f;
  }
  l += sum;
  u32x4 w0, w1;
  w0.x = pkbf(s[0], s[1]); w0.y = pkbf(s[2], s[3]); w0.z = pkbf(s[4], s[5]); w0.w = pkbf(s[6], s[7]);
  w1.x = pkbf(s[8], s[9]); w1.y = pkbf(s[10], s[11]); w1.z = pkbf(s[12], s[13]); w1.w = pkbf(s[14], s[15]);
  pout[0] = __builtin_bit_cast(bf16x8, w0); pout[1] = __builtin_bit_cast(bf16x8, w1);
}
__device__ __forceinline__ void pv2_sm2(f32x16& s0, f32x16& s1, float m0, float m1, ldsp Vt, int vb0, int vb1, const bf16x8 (&p0)[2], const bf16x8 (&p1)[2], f32x16 (&o0)[4], f32x16 (&o1)[4]) {
  if (!__all((m0 == 0.f) && (m1 == 0.f))) {
#pragma unroll
    for (int r = 0; r < 16; ++r) { s0[r] -= m0; s1[r] -= m1; }
  }
#define SP_I0(i) (2048 * (2 * ((i) / 4)) + 512 * ((i) % 4))
#define SP_I1(i) (2048 * (2 * ((i) / 4) + 1) + 512 * ((i) % 4))
#define SP_RD(dl, dh, i) do { asm volatile("ds_read_b64_tr_b16 %0, %1 offset:%c2" : "=&v"(dl) : "v"(a0), "i"(SP_I0(i)) : "memory"); \
                              asm volatile("ds_read_b64_tr_b16 %0, %1 offset:%c2" : "=&v"(dh) : "v"(a1), "i"(SP_I1(i)) : "memory"); } while (0)
  const unsigned a0 = (unsigned)(unsigned long)(Vt + vb0), a1 = (unsigned)(unsigned long)(Vt + vb1);
  s16x4 lo[2], hh[2];
  SP_RD(lo[0], hh[0], 0);
#pragma unroll
  for (int i = 0; i < 8; ++i) {
    if (i + 1 < 8) { SP_RD(lo[(i + 1) & 1], hh[(i + 1) & 1], i + 1); asm volatile("s_waitcnt lgkmcnt(2)" ::: "memory"); }
    else asm volatile("s_waitcnt lgkmcnt(0)" ::: "memory");
    __builtin_amdgcn_sched_barrier(0);
    const s16x4 l_ = lo[i & 1], h_ = hh[i & 1];
    const bf16x8 a = {l_[0], l_[1], l_[2], l_[3], h_[0], h_[1], h_[2], h_[3]};
    o0[i % 4] = __builtin_amdgcn_mfma_f32_32x32x16_bf16(a, p0[i / 4], o0[i % 4], 0, 0, 0);
    s0[2 * i] = __builtin_amdgcn_exp2f(s0[2 * i]); s0[2 * i + 1] = __builtin_amdgcn_exp2f(s0[2 * i + 1]);
    __builtin_amdgcn_sched_barrier(0);
    o1[i % 4] = __builtin_amdgcn_mfma_f32_32x32x16_bf16(a, p1[i / 4], o1[i % 4], 0, 0, 0);
    s1[2 * i] = __builtin_amdgcn_exp2f(s1[2 * i]); s1[2 * i + 1] = __builtin_amdgcn_exp2f(s1[2 * i + 1]);
    __builtin_amdgcn_sched_barrier(0);
  }
#undef SP_I0
#undef SP_I1
#undef SP_RD
}

__device__ __forceinline__ void pv2_sm2p(f32x16& s0, f32x16& s1, float& m0, float& l0, float& m1, float& l1, ldsp Vt, int vb0, int vb1,
                                         const bf16x8 (&p0)[2], const bf16x8 (&p1)[2], f32x16 (&o0)[4], f32x16 (&o1)[4], bf16x8 (&q0)[2], bf16x8 (&q1)[2]) {
  if (!__all((m0 == 0.f) && (m1 == 0.f))) {
#pragma unroll
    for (int r = 0; r < 16; ++r) { s0[r] -= m0; s1[r] -= m1; }
  }
#define SP_I0(i) (2048 * (2 * ((i) / 4)) + 512 * ((i) % 4))
#define SP_I1(i) (2048 * (2 * ((i) / 4) + 1) + 512 * ((i) % 4))
#define SP_RD(dl, dh, i) do { asm volatile("ds_read_b64_tr_b16 %0, %1 offset:%c2" : "=&v"(dl) : "v"(a0), "i"(SP_I0(i)) : "memory"); \
                              asm volatile("ds_read_b64_tr_b16 %0, %1 offset:%c2" : "=&v"(dh) : "v"(a1), "i"(SP_I1(i)) : "memory"); } while (0)
  const unsigned a0 = (unsigned)(unsigned long)(Vt + vb0), a1 = (unsigned)(unsigned long)(Vt + vb1);
  s16x4 lo[2], hh[2];
  unsigned w0[8], w1[8];
  float sum0 = 0.f, sum1 = 0.f;
  SP_RD(lo[0], hh[0], 0);
#pragma unroll
  for (int i = 0; i < 8; ++i) {
    if (i + 1 < 8) { SP_RD(lo[(i + 1) & 1], hh[(i + 1) & 1], i + 1); asm volatile("s_waitcnt lgkmcnt(2)" ::: "memory"); }
    else asm volatile("s_waitcnt lgkmcnt(0)" ::: "memory");
    __builtin_amdgcn_sched_barrier(0);
    const s16x4 l_ = lo[i & 1], h_ = hh[i & 1];
    const bf16x8 a = {l_[0], l_[1], l_[2], l_[3], h_[0], h_[1], h_[2], h_[3]};
    o0[i % 4] = __builtin_amdgcn_mfma_f32_32x32x16_bf16(a, p0[i / 4], o0[i % 4], 0, 0, 0);
    { const float e0 = __builtin_amdgcn_exp2f(s0[2 * i]), e1 = __builtin_amdgcn_exp2f(s0[2 * i + 1]); sum0 += e0; sum0 += e1; w0[i] = pkbf(e0, e1); }
    __builtin_amdgcn_sched_barrier(0);
    o1[i % 4] = __builtin_amdgcn_mfma_f32_32x32x16_bf16(a, p1[i / 4], o1[i % 4], 0, 0, 0);
    { const float e0 = __builtin_amdgcn_exp2f(s1[2 * i]), e1 = __builtin_amdgcn_exp2f(s1[2 * i + 1]); sum1 += e0; sum1 += e1; w1[i] = pkbf(e0, e1); }
    __builtin_amdgcn_sched_barrier(0);
  }
#undef SP_I0
#undef SP_I1
#undef SP_RD
  const float tot0 = half_swap_sum(sum0), tot1 = half_swap_sum(sum1);
  if (__any(!(tot0 <= BIGSUM) || !(tot1 <= BIGSUM))) {
    float mx0 = 0.f, mx1 = 0.f;
#pragma unroll
    for (int i = 0; i < 8; ++i) { mx0 = fmaxf(mx0, fmaxf(bflo(w0[i]), bfhi(w0[i]))); mx1 = fmaxf(mx1, fmaxf(bflo(w1[i]), bfhi(w1[i]))); }
    mx0 = half_swap_max(mx0); mx1 = half_swap_max(mx1);
    const float d0 = (tot0 <= BIGSUM) ? 0.f : __log2f(fminf(mx0, 3.0e38f)), d1 = (tot1 <= BIGSUM) ? 0.f : __log2f(fminf(mx1, 3.0e38f));
    m0 += d0; m1 += d1;
    const float f0 = __builtin_amdgcn_exp2f(-d0), f1 = __builtin_amdgcn_exp2f(-d1); l0 *= f0; l1 *= f1; sum0 *= f0; sum1 *= f1;
#pragma unroll
    for (int i = 0; i < 8; ++i) { w0[i] = pkbf(bflo(w0[i]) * f0, bfhi(w0[i]) * f0); w1[i] = pkbf(bflo(w1[i]) * f1, bfhi(w1[i]) * f1); }
#pragma unroll
    for (int d = 0; d < 4; ++d)
#pragma unroll
      for (int r = 0; r < 16; ++r) { o0[d][r] *= f0; o1[d][r] *= f1; }
  }
  l0 += sum0; l1 += sum1;
  q0[0] = __builtin_bit_cast(bf16x8, (u32x4){w0[0], w0[1], w0[2], w0[3]}); q0[1] = __builtin_bit_cast(bf16x8, (u32x4){w0[4], w0[5], w0[6], w0[7]});
  q1[0] = __builtin_bit_cast(bf16x8, (u32x4){w1[0], w1[1], w1[2], w1[3]}); q1[1] = __builtin_bit_cast(bf16x8, (u32x4){w1[4], w1[5], w1[6], w1[7]});
}

__device__ __forceinline__ void diff_unit(ldsp lds, const bf16_t* Q, const bf16_t* K, const bf16_t* V, bf16_t* O, int tok0, int S, int h, int qb, float lam, float osc, const float* subg) {
  const int tid = fresh_tid(), lane = tid & 63, wid = tid >> 6, r32 = lane & 31, hi = lane >> 5;
  const int NT = S / 64;
  const bf16_t* kbase = K + (size_t)tok0 * DM + 128 * h; const bf16_t* vbase = V + (size_t)tok0 * DM + 128 * h;
#define DIFF_DMA(t, bo) do { const int ln_ = fresh_tid() & 63, wv_ = __builtin_amdgcn_readfirstlane(fresh_tid() >> 6); \
    { const int row_ = 8 * wv_ + (ln_ >> 3), ch_ = (ln_ & 7) ^ ((row_ >> 1) & 7); const bf16_t* g_ = kbase + (size_t)((t) * 64 + row_) * DM + 8 * ch_; \
      __builtin_amdgcn_global_load_lds((const unsigned*)g_, (LAS unsigned*)(lds + (bo) + 1024 * wv_), 16, 0, 0); \
      __builtin_amdgcn_global_load_lds((const unsigned*)(g_ + 64), (LAS unsigned*)(lds + (bo) + 8192 + 1024 * wv_), 16, 0, 0); } \
    _Pragma("unroll") for (int hq_ = 0; hq_ < 2; ++hq_) { const int o_ = 1024 * hq_ + 16 * ln_, row_ = 8 * wv_ + ((o_ >> 6) & 7), ch_ = 4 * (o_ >> 9) + (((o_ >> 4) & 3) ^ ((row_ >> 2) & 3)); \
      __builtin_amdgcn_global_load_lds((const unsigned*)(vbase + (size_t)((t) * 64 + row_) * DM + 8 * ch_), (LAS unsigned*)(lds + (bo) + 16384 + 2048 * wv_ + 1024 * hq_), 16, 0, 0); } } while (0)
  DIFF_DMA(0, 0);
  const size_t qrow = (size_t)(tok0 + 256 * qb + 32 * wid + r32) * DM;
  bf16x8 q0[4], q1[4];
#pragma unroll
  for (int ds = 0; ds < 4; ++ds) { q0[ds] = *(const bf16x8*)(Q + qrow + (2 * h) * 64 + 16 * ds + 8 * hi); q1[ds] = *(const bf16x8*)(Q + qrow + (2 * h + 1) * 64 + 16 * ds + 8 * hi); }
  f32x16 o0[4], o1[4];
#pragma unroll
  for (int d = 0; d < 4; ++d)
#pragma unroll
    for (int r = 0; r < 16; ++r) { o0[d][r] = 0.f; o1[d][r] = 0.f; }
  float m0 = 0.f, l0 = 0.f, m1 = 0.f, l1 = 0.f;
  int ko[4];
#pragma unroll
  for (int ds = 0; ds < 4; ++ds) ko[ds] = 128 * r32 + (((2 * ds + hi) ^ ((r32 >> 1) & 7)) << 4);
  const int q4 = (lane & 15) >> 2, p4 = lane & 3, gi = (lane >> 4) & 1;
  int vb0 = 64 * (4 * hi + q4) + 16 * ((2 * gi + (p4 >> 1)) ^ hi) + 8 * (p4 & 1);
  int vb1 = 64 * (4 * hi + q4) + 16 * ((2 * gi + (p4 >> 1)) ^ (2 + hi)) + 8 * (p4 & 1);
  __syncthreads();
  bf16x8 pa[2], pb[2];
  pb[0] = (bf16x8){0, 0, 0, 0, 0, 0, 0, 0}; pb[1] = pb[0]; pa[0] = pb[0]; pa[1] = pb[0];
  int bcur = 0, bnext = 32768;
  ldsp prevV = lds + 16384;
#pragma unroll 1
  for (int t = 0; t < NT; ++t) {
    asm volatile("" : "+v"(ko[0]), "+v"(ko[1]), "+v"(ko[2]), "+v"(ko[3]), "+v"(vb0), "+v"(vb1));
    if (t + 1 < NT) DIFF_DMA(t + 1, bnext);
    ldsp base = lds + bcur;
    {
      f32x16 sc0 = qk_block(base, ko, q0);
      __builtin_amdgcn_sched_barrier(0);
      f32x16 sc1 = qk_block(base + 8192, ko, q1);
      __builtin_amdgcn_sched_barrier(0);
      bf16x8 pc[2], pd[2];
      pv2_sm2p(sc0, sc1, m0, l0, m1, l1, prevV, vb0, vb1, pa, pb, o0, o1, pc, pd);
      sc0 = qk_block(base + 4096, ko, q0);
      __builtin_amdgcn_sched_barrier(0);
      sc1 = qk_block(base + 8192 + 4096, ko, q1);
      __builtin_amdgcn_sched_barrier(0);
      pv2_sm2p(sc0, sc1, m0, l0, m1, l1, base + 16384, vb0, vb1, pc, pd, o0, o1, pa, pb);
      prevV = base + 16384 + 8192;
    }
    __syncthreads();
    bcur = bnext; bnext = (bnext == 65536) ? 0 : bnext + 32768;
  }
  pv_block<128, true>(prevV, vb0, vb1, pa, pb, o0, o1);
  __syncthreads();
#undef DIFF_DMA
  l0 = half_swap_sum(l0); l1 = half_swap_sum(l1);
  const float i0 = 1.f / l0, i1 = lam / l1;
  float ssq = 0.f;
#pragma unroll
  for (int d = 0; d < 4; ++d)
#pragma unroll
    for (int r = 0; r < 16; ++r) { const float v = o0[d][r] * i0 - o1[d][r] * i1; o0[d][r] = v; ssq += v * v; }
  ssq = half_swap_sum(ssq);
  const float rs = rsqrtf(ssq * (1.f / 128.f) + 1e-5f) * osc;
  bf16_t* orow = O + (size_t)(tok0 + 256 * qb + 32 * (fresh_tid() >> 6) + (fresh_tid() & 31)) * DM + 128 * h;
#pragma unroll
  for (int d = 0; d < 4; ++d)
#pragma unroll
    for (int g4 = 0; g4 < 4; ++g4) { const int dd = 32 * d + 8 * g4 + 4 * hi; const f32x4 gg = *(const f32x4*)(subg + dd);
      u32x2 w; w.x = pkbf(o0[d][4 * g4] * rs * gg.x, o0[d][4 * g4 + 1] * rs * gg.y); w.y = pkbf(o0[d][4 * g4 + 2] * rs * gg.z, o0[d][4 * g4 + 3] * rs * gg.w);
      *(u32x2*)(orow + dd) = w; }
}
__device__ __forceinline__ void phase_diff_attn(ldsp lds, const bf16_t* Q, const bf16_t* K, const bf16_t* V, bf16_t* O, const float* lamv, const float* subg, float lam_init, float osc_l) {
  const int lane = fresh_tid() & 63;
  const float t0 = wave_sum(lamv[lane] * lamv[64 + lane]), t1 = wave_sum(lamv[128 + lane] * lamv[192 + lane]);
  const float lam = __expf(t0) - __expf(t1) + lam_init;
  const int G = gridDim.x, bx = blockIdx.x;
  const bool xmap = (G == 256); const int x = bx & 7, c = bx >> 3;
  const int nu = xmap ? 8 : (2048 - bx + G - 1) / G;
#pragma unroll 1
  for (int i = 0; i < nu; ++i) {
    int bh, qb, S, tok0;
    if (xmap) { if (i < 4) { bh = 4 * x + i; qb = c; S = 8192; tok0 = (bh >> 3) * 8192; } else { bh = 8 * x + 2 * (i - 4) + (c >> 4); qb = c & 15; S = 4096; tok0 = MH + (bh >> 3) * 4096; } }
    else { const int u = bx + i * G; if (u < 1024) { bh = u >> 5; qb = u & 31; S = 8192; tok0 = (bh >> 3) * 8192; } else { const int v = u - 1024; bh = v >> 4; qb = v & 15; S = 4096; tok0 = MH + (bh >> 3) * 4096; } }
    diff_unit(lds, Q, K, V, O, tok0, S, bh & 7, qb, lam, osc_l, subg);
  }
}

__device__ __forceinline__ void dil_unit(ldsp lds, bf16_t* QKV, float* LSE, int half, int u) {
  const int tid = fresh_tid(), lane = tid & 63, wid = tid >> 6, r32 = lane & 31, hi = lane >> 5;
  const int g = u / 2048, rem = u % 2048, head = rem & 15, blk = rem >> 4;
  const int S = half ? 4096 : 8192, nbs = S / 256, seq = blk / nbs, wi = blk % nbs;
  const int dsh = 2 * g, dil = 1 << dsh, L = S >> dsh, nq = L / 256, r = wi / nq, qb = wi % nq, m0 = 256 * qb;
  const int seqrow = seq * S;
  const int colq = g * 3072 + head * 64, colk = colq + 1024, colv = colq + 2048;
  ldsp Kt = lds, Vt = lds + 49152;
#pragma unroll
  for (int i = 0; i < 6; ++i) { const int idx = tid + 512 * i, j = idx >> 3, ch = idx & 7, mk = m0 - 64 + j;
    u32x4 kv = {0u, 0u, 0u, 0u}, vv = {0u, 0u, 0u, 0u};
    if (mk >= 0 && mk < L) { const size_t rowo = (size_t)(seqrow + mk * dil + r) * 9216; kv = *(const u32x4*)(QKV + rowo + colk + 8 * ch); vv = *(const u32x4*)(QKV + rowo + colv + 8 * ch); }
    *(LAS u32x4*)(Kt + koff(j, ch)) = kv; *(LAS u32x4*)(Vt + 128 * j + 16 * ch) = vv; }
  const int mq = m0 + 32 * wid + r32; const size_t qrowo = (size_t)(seqrow + mq * dil + r) * 9216 + colq;
  bf16x8 qf[4];
#pragma unroll
  for (int ds = 0; ds < 4; ++ds) qf[ds] = *(const bf16x8*)(QKV + qrowo + 16 * ds + 8 * hi);
  f32x16 o[2];
#pragma unroll
  for (int d = 0; d < 2; ++d)
#pragma unroll
    for (int rr = 0; rr < 16; ++rr) o[d][rr] = 0.f;
  float m = 0.f, l = 0.f;
  int ko[4];
#pragma unroll
  for (int ds = 0; ds < 4; ++ds) ko[ds] = 128 * r32 + (((2 * ds + hi) ^ ((r32 >> 1) & 7)) << 4);
  const int q4 = (lane & 15) >> 2, p4 = lane & 3, gi = (lane >> 4) & 1;
  const int vb = 128 * (4 * hi + q4) + 32 * gi + 8 * p4;
  __syncthreads();
#pragma unroll 1
  for (int b = 0; b < 5; ++b) {
    const int kr0 = 32 * wid + 32 * b;
    f32x16 s = qk_block(Kt + 128 * kr0, ko, qf);
#pragma unroll
    for (int rr = 0; rr < 16; ++rr) { const int kvr = (rr & 3) + 8 * (rr >> 2) + 4 * hi; const int mk = m0 - 64 + kr0 + kvr; const int dlt = mk - mq;
      const bool ok = (dlt >= -64) && (dlt <= 64) && (mk >= 0) && (mk < L); s[rr] = ok ? s[rr] : -INFINITY; }
    bf16x8 p[2];
    softmax_block<2>(s, m, l, o, p);
    pv_block<64, false>(Vt + 128 * kr0, vb, vb, p, p, o, o);
  }
  l = half_swap_sum(l);
  const float il = 1.f / l;
  bf16_t* orow = QKV + qrowo;
#pragma unroll
  for (int d = 0; d < 2; ++d)
#pragma unroll
    for (int g4 = 0; g4 < 4; ++g4) { const int dd = 32 * d + 8 * g4 + 4 * hi;
      u32x2 w; w.x = pkbf(o[d][4 * g4] * il, o[d][4 * g4 + 1] * il); w.y = pkbf(o[d][4 * g4 + 2] * il, o[d][4 * g4 + 3] * il);
      *(u32x2*)(orow + dd) = w; }
  if (hi == 0) LSE[((size_t)g * MH + (seqrow + mq * dil + r)) * 16 + head] = m + __log2f(l);
  __syncthreads();
}
__device__ __forceinline__ void phase_dil_combine(const bf16_t* QKV, const float* LSE, bf16_t* O  , int gw, int ngw, int lane) {
  for (int t = gw; t < MH; t += ngw) {
    const int head = lane >> 2, d0 = 16 * (lane & 3);
    float ls[3], mx = -INFINITY;
#pragma unroll
    for (int g = 0; g < 3; ++g) { ls[g] = LSE[((size_t)g * MH + t) * 16 + head]; mx = fmaxf(mx, ls[g]); }
    float w[3], ws = 0.f;
#pragma unroll
    for (int g = 0; g < 3; ++g) { w[g] = __builtin_amdgcn_exp2f(ls[g] - mx); ws += w[g]; }
    const float iw = 1.f / ws; float acc[16];
#pragma unroll
    for (int i = 0; i < 16; ++i) acc[i] = 0.f;
#pragma unroll
    for (int g = 0; g < 3; ++g) { const bf16_t* p = QKV + (size_t)t * 9216 + g * 3072 + head * 64 + d0; const u32x4 a = *(const u32x4*)p, b = *(const u32x4*)(p + 8); const float wg = w[g] * iw;
      acc[0] += wg * bflo(a.x); acc[1] += wg * bfhi(a.x); acc[2] += wg * bflo(a.y); acc[3] += wg * bfhi(a.y); acc[4] += wg * bflo(a.z); acc[5] += wg * bfhi(a.z); acc[6] += wg * bflo(a.w); acc[7] += wg * bfhi(a.w);
      acc[8] += wg * bflo(b.x); acc[9] += wg * bfhi(b.x); acc[10] += wg * bflo(b.y); acc[11] += wg * bfhi(b.y); acc[12] += wg * bflo(b.z); acc[13] += wg * bfhi(b.z); acc[14] += wg * bflo(b.w); acc[15] += wg * bfhi(b.w); }
    u32x4 a, b; a.x = pkbf(acc[0], acc[1]); a.y = pkbf(acc[2], acc[3]); a.z = pkbf(acc[4], acc[5]); a.w = pkbf(acc[6], acc[7]);
    b.x = pkbf(acc[8], acc[9]); b.y = pkbf(acc[10], acc[11]); b.z = pkbf(acc[12], acc[13]); b.w = pkbf(acc[14], acc[15]);
    bf16_t* op = O + (size_t)t * DM + head * 64 + d0; *(u32x4*)op = a; *(u32x4*)(op + 8) = b;
  }
}

__device__ __forceinline__ void phase_hgrn_gates(bf16_t* QF, int gt, int ngt) {
  const size_t total = (size_t)M_TOK * 384;
  for (size_t it = gt; it < total; it += ngt) {
    const int row = (int)(it / 384), c8 = (int)(it % 384); bf16_t* p = QF + (size_t)row * 5120 + 8 * c8; const bool isq = c8 < 128;
    u32x4 a = *(const u32x4*)p; float v[8] = {bflo(a.x), bfhi(a.x), bflo(a.y), bfhi(a.y), bflo(a.z), bfhi(a.z), bflo(a.w), bfhi(a.w)};
#pragma unroll
    for (int i = 0; i < 8; ++i) { const float z = v[i]; v[i] = isq ? z / (1.f + __expf(-z)) * 0.08838834764831845f : 1.f / (1.f + __expf(z)); }
    a.x = pkbf(v[0], v[1]); a.y = pkbf(v[2], v[3]); a.z = pkbf(v[4], v[5]); a.w = pkbf(v[6], v[7]); *(u32x4*)p = a;
  }
}
__device__ __forceinline__ int rowimg(int row, int ch) { return 256 * row + ((ch ^ (row & 15)) << 4); }
__device__ __forceinline__ void hgrn_chain(ldsp lds, const bf16_t* QF, bf16_t* Ofw, bf16_t* Obw, const float* oml, int c) {
  const int tid = fresh_tid(), lane = tid & 63, wid = tid >> 6, r32 = lane & 31, hi = lane >> 5;
  const int dir = c & 1, head = (c >> 1) & 7, sq = c >> 4;
  const int T = (sq < 4) ? 8192 : 4096, NC = T / 64; const int seqrow = (sq < 4) ? sq * 8192 : MH + (sq - 4) * 4096;
  bf16_t* Od = dir ? Obw : Ofw;
  constexpr int RAWQ = 0, RAWS = 16384, IMG_V = 32768, IMG_QT = 49152, IMG_KT = 65536, IMG_KH = 81920, OUTB = 98304, TOT = 114688, DEC = 118784;
  const int vblk = wid & 3, tblk = wid >> 2;
  const int kp = tid & 63, e8 = tid >> 6;
  const float om0 = oml[head * 128 + 2 * kp], om1 = oml[head * 128 + 2 * kp + 1];
  f32x16 Sacc[4];
#pragma unroll
  for (int kb = 0; kb < 4; ++kb)
#pragma unroll
    for (int r = 0; r < 16; ++r) Sacc[kb][r] = 0.f;
  const int lrow = tid >> 4, c16 = tid & 15;
  const int qcol = head * 128 + 8 * c16, fcol = 1024 + dir * 1024 + head * 128 + 8 * c16, vcol = 3072 + head * 128 + 8 * c16;
  u32x4 pq0, pq1, ps0, ps1, pv0, pv1;
#define HG_LOAD(n) do { const int t0_ = dir ? T - 64 * ((n) + 1) : 64 * (n); const int ra_ = dir ? 63 - lrow : lrow, rb_ = dir ? 31 - lrow : lrow + 32; \
    const bf16_t* pa_ = QF + (size_t)(seqrow + t0_ + ra_) * 5120; const bf16_t* pb_ = QF + (size_t)(seqrow + t0_ + rb_) * 5120; \
    pq0 = *(const u32x4*)(pa_ + qcol); pq1 = *(const u32x4*)(pb_ + qcol); ps0 = *(const u32x4*)(pa_ + fcol); ps1 = *(const u32x4*)(pb_ + fcol); pv0 = *(const u32x4*)(pa_ + vcol); pv1 = *(const u32x4*)(pb_ + vcol); } while (0)
#define HG_STORE() do { *(LAS u32x4*)(lds + RAWQ + 256 * lrow + 16 * c16) = pq0; *(LAS u32x4*)(lds + RAWQ + 256 * (lrow + 32) + 16 * c16) = pq1; \
    *(LAS u32x4*)(lds + RAWS + 256 * lrow + 16 * c16) = ps0; *(LAS u32x4*)(lds + RAWS + 256 * (lrow + 32) + 16 * c16) = ps1; \
    *(LAS u32x4*)(lds + IMG_V + voffa(lrow, c16)) = pv0; *(LAS u32x4*)(lds + IMG_V + voffa(lrow + 32, c16)) = pv1; } while (0)
  const int q4 = (lane & 15) >> 2, p4 = lane & 3, gi = (lane >> 4) & 1;
  const int vbp0 = 64 * (4 * hi + q4) + 16 * ((2 * gi + (p4 >> 1)) ^ hi) + 8 * (p4 & 1), vbp1 = 64 * (4 * hi + q4) + 16 * ((2 * gi + (p4 >> 1)) ^ (2 + hi)) + 8 * (p4 & 1);
  const int nb0 = 2048 * hi + 64 * q4 + 16 * ((2 * gi + (p4 >> 1)) ^ (2 * hi)) + 8 * (p4 & 1), nb1 = 2048 * hi + 64 * q4 + 16 * ((2 * gi + (p4 >> 1)) ^ (2 * hi + 1)) + 8 * (p4 & 1);
  HG_LOAD(0); HG_STORE(); __syncthreads();
#pragma unroll 1
  for (int n = 0; n < NC; ++n) {
    if (n + 1 < NC) HG_LOAD(n + 1);
    float kk0[8], kk1[8], g0[8], g1[8]; float c0 = 0.f, c1 = 0.f;
#pragma unroll
    for (int i = 0; i < 8; ++i) { const int row = 8 * e8 + i; const unsigned sw = *(const LAS unsigned*)(lds + RAWS + 256 * row + 4 * kp);
      kk0[i] = om0 * bflo(sw); kk1[i] = om1 * bfhi(sw); c0 += __log2f(1.f - kk0[i]); c1 += __log2f(1.f - kk1[i]); g0[i] = c0; g1[i] = c1; }
    *(LAS f32x2*)(lds + TOT + (e8 * 128 + 2 * kp) * 4) = (f32x2){c0, c1};
    __syncthreads();
    float off0 = 0.f, off1 = 0.f, ge0 = 0.f, ge1 = 0.f;
#pragma unroll
    for (int e = 0; e < 8; ++e) { const f32x2 t = *(const LAS f32x2*)(lds + TOT + (e * 128 + 2 * kp) * 4); ge0 += t.x; ge1 += t.y; if (e < e8) { off0 += t.x; off1 += t.y; } }
#pragma unroll
    for (int i = 0; i < 8; ++i) { const int row = 8 * e8 + i; const float G0 = off0 + g0[i], G1 = off1 + g1[i];
      const unsigned qw = *(const LAS unsigned*)(lds + RAWQ + 256 * row + 4 * kp);
      const float eq0 = __builtin_amdgcn_exp2f(G0), eq1 = __builtin_amdgcn_exp2f(G1), ek0 = __builtin_amdgcn_exp2f(-G0), ek1 = __builtin_amdgcn_exp2f(-G1);
      const float eh0 = __builtin_amdgcn_exp2f(ge0 - G0), eh1 = __builtin_amdgcn_exp2f(ge1 - G1);
      const int ro = rowimg(row, kp >> 2) + 4 * (kp & 3);
      *(LAS unsigned*)(lds + IMG_QT + ro) = pkbf(bflo(qw) * eq0, bfhi(qw) * eq1);
      *(LAS unsigned*)(lds + IMG_KT + ro) = pkbf(kk0[i] * ek0, kk1[i] * ek1);
      *(LAS unsigned*)(lds + IMG_KH + voffa(row, kp >> 2) + 4 * (kp & 3)) = pkbf(kk0[i] * eh0, kk1[i] * eh1); }
    if (e8 == 7) *(LAS f32x2*)(lds + DEC + 8 * kp) = (f32x2){__builtin_amdgcn_exp2f(ge0), __builtin_amdgcn_exp2f(ge1)};
    __syncthreads();
    bf16x8 px[2][2];
#pragma unroll
    for (int sb = 0; sb < 2; ++sb) {
      if (sb <= tblk) {
        f32x16 X;
#pragma unroll
        for (int r = 0; r < 16; ++r) X[r] = 0.f;
#pragma unroll
        for (int ds = 0; ds < 8; ++ds) { const bf16x8 a = *(const LAS bf16x8*)(lds + IMG_KT + rowimg(32 * sb + r32, 2 * ds + hi)), bq = *(const LAS bf16x8*)(lds + IMG_QT + rowimg(32 * tblk + r32, 2 * ds + hi));
          X = __builtin_amdgcn_mfma_f32_32x32x16_bf16(a, bq, X, 0, 0, 0); }
        if (sb == tblk) {
#pragma unroll
          for (int r = 0; r < 16; ++r) { const int sl = (r & 3) + 8 * (r >> 2) + 4 * hi; X[r] = (sl <= r32) ? X[r] : 0.f; } }
        u32x4 w0, w1;
        w0.x = pkbf(X[0], X[1]); w0.y = pkbf(X[2], X[3]); w0.z = pkbf(X[4], X[5]); w0.w = pkbf(X[6], X[7]);
        w1.x = pkbf(X[8], X[9]); w1.y = pkbf(X[10], X[11]); w1.z = pkbf(X[12], X[13]); w1.w = pkbf(X[14], X[15]);
        px[sb][0] = __builtin_bit_cast(bf16x8, w0); px[sb][1] = __builtin_bit_cast(bf16x8, w1);
      } else { px[sb][0] = (bf16x8){0, 0, 0, 0, 0, 0, 0, 0}; px[sb][1] = px[sb][0]; }
    }
    f32x16 acc;
#pragma unroll
    for (int r = 0; r < 16; ++r) acc[r] = 0.f;
#pragma unroll
    for (int sb = 0; sb < 2; ++sb)
#pragma unroll
      for (int s2 = 0; s2 < 2; ++s2) {
        const s16x4 lo = vtr(lds + IMG_V + vbp0 + 2048 * (4 * sb + 2 * s2) + 512 * vblk), hh = vtr(lds + IMG_V + vbp1 + 2048 * (4 * sb + 2 * s2 + 1) + 512 * vblk);
        const bf16x8 a = {lo[0], lo[1], lo[2], lo[3], hh[0], hh[1], hh[2], hh[3]};
        acc = __builtin_amdgcn_mfma_f32_32x32x16_bf16(a, px[sb][s2], acc, 0, 0, 0);
      }
#pragma unroll
    for (int kb = 0; kb < 4; ++kb)
#pragma unroll
      for (int s2 = 0; s2 < 2; ++s2) {
        u32x4 w; w.x = pkbf(Sacc[kb][8 * s2 + 0], Sacc[kb][8 * s2 + 1]); w.y = pkbf(Sacc[kb][8 * s2 + 2], Sacc[kb][8 * s2 + 3]); w.z = pkbf(Sacc[kb][8 * s2 + 4], Sacc[kb][8 * s2 + 5]); w.w = pkbf(Sacc[kb][8 * s2 + 6], Sacc[kb][8 * s2 + 7]);
        const u32x2 b0 = *(const LAS u32x2*)(lds + IMG_QT + rowimg(32 * tblk + r32, 4 * kb + 2 * s2) + 8 * hi), b1 = *(const LAS u32x2*)(lds + IMG_QT + rowimg(32 * tblk + r32, 4 * kb + 2 * s2 + 1) + 8 * hi);
        const u32x4 bw = {b0.x, b0.y, b1.x, b1.y};
        acc = __builtin_amdgcn_mfma_f32_32x32x16_bf16(__builtin_bit_cast(bf16x8, w), __builtin_bit_cast(bf16x8, bw), acc, 0, 0, 0);
      }
#pragma unroll
    for (int g4 = 0; g4 < 4; ++g4) { u32x2 w; w.x = pkbf(acc[4 * g4], acc[4 * g4 + 1]); w.y = pkbf(acc[4 * g4 + 2], acc[4 * g4 + 3]);
      *(LAS u32x2*)(lds + OUTB + rowimg(32 * tblk + r32, 4 * vblk + g4) + 8 * hi) = w; }
#pragma unroll
    for (int kb = 0; kb < 4; ++kb) {
#pragma unroll
      for (int g4 = 0; g4 < 4; ++g4) { const f32x4 d = *(const LAS f32x4*)(lds + DEC + 4 * (32 * kb + 8 * g4 + 4 * hi));
        Sacc[kb][4 * g4] *= d.x; Sacc[kb][4 * g4 + 1] *= d.y; Sacc[kb][4 * g4 + 2] *= d.z; Sacc[kb][4 * g4 + 3] *= d.w; }
#pragma unroll
      for (int s4 = 0; s4 < 4; ++s4) {
        const s16x4 a0 = vtr(lds + IMG_KH + nb0 + 4096 * s4 + 512 * kb), a1 = vtr(lds + IMG_KH + nb1 + 4096 * s4 + 256 + 512 * kb);
        const s16x4 b0 = vtr(lds + IMG_V + nb0 + 4096 * s4 + 512 * vblk), b1 = vtr(lds + IMG_V + nb1 + 4096 * s4 + 256 + 512 * vblk);
        const bf16x8 a = {a0[0], a0[1], a0[2], a0[3], a1[0], a1[1], a1[2], a1[3]}, bb = {b0[0], b0[1], b0[2], b0[3], b1[0], b1[1], b1[2], b1[3]};
        Sacc[kb] = __builtin_amdgcn_mfma_f32_32x32x16_bf16(a, bb, Sacc[kb], 0, 0, 0);
      }
    }
    __syncthreads();
    { const int t0_ = dir ? T - 64 * (n + 1) : 64 * n;
#pragma unroll
      for (int i = 0; i < 2; ++i) { const int tau = lrow + 32 * i; const int grow = dir ? 63 - tau : tau;
        *(u32x4*)(Od + (size_t)(seqrow + t0_ + grow) * 1024 + head * 128 + 8 * c16) = *(const LAS u32x4*)(lds + OUTB + rowimg(tau, c16)); } }
    if (n + 1 < NC) HG_STORE();
    __syncthreads();
  }
#undef HG_LOAD
#undef HG_STORE
}
__device__ __forceinline__ void phase_hgrn_combine(const bf16_t* QF, const bf16_t* Ofw, const bf16_t* Obw, bf16_t* O, const float* gn, int gw, int ngw, int lane) {
  float gnv[16];
#pragma unroll
  for (int i = 0; i < 16; ++i) gnv[i] = gn[((16 * lane) & 127) + i];
  for (int t = gw; t < M_TOK; t += ngw) {
    const int c0 = 16 * lane;
    float v[16], gv[16];
    { const bf16_t* a = Ofw + (size_t)t * 1024 + c0; const bf16_t* b = Obw + (size_t)t * 1024 + c0; const bf16_t* gp = QF + (size_t)t * 5120 + 4096 + c0;
#pragma unroll
      for (int j = 0; j < 2; ++j) { const u32x4 x = *(const u32x4*)(a + 8 * j), y = *(const u32x4*)(b + 8 * j), z = *(const u32x4*)(gp + 8 * j);
        v[8 * j + 0] = bflo(x.x) + bflo(y.x); v[8 * j + 1] = bfhi(x.x) + bfhi(y.x); v[8 * j + 2] = bflo(x.y) + bflo(y.y); v[8 * j + 3] = bfhi(x.y) + bfhi(y.y);
        v[8 * j + 4] = bflo(x.z) + bflo(y.z); v[8 * j + 5] = bfhi(x.z) + bfhi(y.z); v[8 * j + 6] = bflo(x.w) + bflo(y.w); v[8 * j + 7] = bfhi(x.w) + bfhi(y.w);
        gv[8 * j + 0] = bflo(z.x); gv[8 * j + 1] = bfhi(z.x); gv[8 * j + 2] = bflo(z.y); gv[8 * j + 3] = bfhi(z.y); gv[8 * j + 4] = bflo(z.z); gv[8 * j + 5] = bfhi(z.z); gv[8 * j + 6] = bflo(z.w); gv[8 * j + 7] = bfhi(z.w); } }
    float ss = 0.f;
#pragma unroll
    for (int i = 0; i < 16; ++i) ss += v[i] * v[i];
    ss += DPPF(ss, 0xB1); ss += DPPF(ss, 0x4E); ss += DPPF(ss, 0x141);
    const float rs = rsqrtf(ss * (1.f / 128.f) + 1e-6f);
    unsigned w[8];
#pragma unroll
    for (int i = 0; i < 8; ++i) { const int d = (c0 & 127) + 2 * i; const float g0 = gv[2 * i], g1 = gv[2 * i + 1];
      (void)d; w[i] = pkbf(v[2 * i] * rs * gnv[2 * i] * (g0 / (1.f + __expf(-g0))), v[2 * i + 1] * rs * gnv[2 * i + 1] * (g1 / (1.f + __expf(-g1)))); }
    bf16_t* op = O + (size_t)t * DM + c0; *(u32x4*)op = (u32x4){w[0], w[1], w[2], w[3]}; *(u32x4*)(op + 8) = (u32x4){w[4], w[5], w[6], w[7]};
  }
}

__device__ __forceinline__ void phase_convglu(const bf16_t* U, bf16_t* G, const float* cw  , const float* cb  , int half, int gt, int ngt) {
  const size_t total = (size_t)MH * 352; const int S = half ? 4096 : 8192;
  for (size_t it = gt; it < total; it += ngt) {
    const int row = (int)(it / 352), c8 = (int)(it % 352), c = 8 * c8; const int pos = row & (S - 1);
    float a[8], b[8];
#pragma unroll
    for (int i = 0; i < 8; ++i) { a[i] = cb[c + i]; b[i] = cb[2816 + c + i]; }
#pragma unroll
    for (int tap = 0; tap < 3; ++tap) { const int pp = pos + tap - 1; if (pp < 0 || pp >= S) continue;
      const bf16_t* ur = U + (size_t)(row + tap - 1) * 5632; const u32x4 ua = *(const u32x4*)(ur + c), ub = *(const u32x4*)(ur + 2816 + c);
      const float fa[8] = {bflo(ua.x), bfhi(ua.x), bflo(ua.y), bfhi(ua.y), bflo(ua.z), bfhi(ua.z), bflo(ua.w), bfhi(ua.w)};
      const float fb[8] = {bflo(ub.x), bfhi(ub.x), bflo(ub.y), bfhi(ub.y), bflo(ub.z), bfhi(ub.z), bflo(ub.w), bfhi(ub.w)};
#pragma unroll
      for (int i = 0; i < 8; ++i) { a[i] += fa[i] * cw[tap * 5632 + c + i]; b[i] += fb[i] * cw[tap * 5632 + 2816 + c + i]; } }
    float o[8];
#pragma unroll
    for (int i = 0; i < 8; ++i) { const float x = a[i], z = 1.5957691216057308f * (x + 0.044715f * x * x * x); o[i] = x / (1.f + __expf(-z)) * b[i]; }
    u32x4 w; w.x = pkbf(o[0], o[1]); w.y = pkbf(o[2], o[3]); w.z = pkbf(o[4], o[5]); w.w = pkbf(o[6], o[7]);
    *(u32x4*)(G + (size_t)row * DFF + c) = w;
  }
}

#define XB_TMO      128
#define XB_XCNT(j)  (256  + 64 * (j))
#define XB_XSUB(j)  (1280 + 64 * (j))
#define XB_XGEN(j)  (2304 + 64 * (j))
#define XB_TOP      3328
#define XB_TOPGEN   3392
#define XCD_BAR_WORDS 3456
#define XB_SPIN_CAP (1u << 18)

__device__ __forceinline__ unsigned xb_ld(unsigned* p)              { return __hip_atomic_load(p, __ATOMIC_RELAXED, __HIP_MEMORY_SCOPE_AGENT); }
__device__ __forceinline__ unsigned xb_add(unsigned* p, unsigned v) { return __hip_atomic_fetch_add(p, v, __ATOMIC_RELAXED, __HIP_MEMORY_SCOPE_AGENT); }
__device__ __forceinline__ unsigned xb_xcc_id() { return (unsigned)__builtin_amdgcn_s_getreg((3 << 11) | 20) & 0xFu; }
#define XB_SPIN(cond, bar) do { unsigned _sp = 0; while (cond) { __builtin_amdgcn_s_sleep(1); \
    if ((++_sp & 255u) == 0u) { if (xb_ld(&(bar)[XB_TMO])) break; if (_sp > XB_SPIN_CAP) { atomicAdd(&(bar)[XB_TMO], 1u); break; } } } } while (0)

struct XcdBarrier {
    unsigned* bar; unsigned x;
    volatile LAS unsigned* st;
};

__device__ __forceinline__ XcdBarrier xcd_barrier_post(unsigned* bar, volatile LAS unsigned* st) {
    XcdBarrier b; b.bar = bar; b.x = xb_xcc_id(); b.st = st;
    if (threadIdx.x == 0) (void)xb_add(&bar[XB_XCNT(b.x)], 1u);
    return b;
}
__device__ __forceinline__ void xcd_barrier_complete(unsigned* bar, unsigned x, unsigned& nloc, unsigned& nx) {
    const unsigned G = gridDim.x * gridDim.y * gridDim.z;
    unsigned sum, cnt, mine, sp = 0u;
    for (;;) {
        sum = 0u; cnt = 0u; mine = 0u;
#pragma unroll
        for (unsigned j = 0; j < 16; ++j) { const unsigned c = xb_ld(&bar[XB_XCNT(j)]); sum += c; cnt += (c > 0u) ? 1u : 0u; mine = (j == x) ? c : mine; }
        if (sum == G) break;
        __builtin_amdgcn_s_sleep(1);
        if ((++sp & 255u) == 0u) { if (xb_ld(&bar[XB_TMO])) break; if (sp > XB_SPIN_CAP) { atomicAdd(&bar[XB_TMO], 1u); break; } }
    }
    nloc = mine > 0u ? mine : 1u; nx = cnt > 0u ? cnt : 1u;
}

__device__ __forceinline__ void xcd_barrier(const XcdBarrier& b) {
    asm volatile("s_waitcnt vmcnt(0)" ::: "memory");
    __syncthreads();
    if (threadIdx.x == 0) {
        unsigned* bar = b.bar;
        __builtin_amdgcn_s_waitcnt(0);
        unsigned nloc = b.st[0], nx = b.st[1];
        if (nloc == 0u) { xcd_barrier_complete(bar, b.x, nloc, nx); b.st[0] = nloc; b.st[1] = nx; }
        const unsigned old = xb_add(&bar[XB_XSUB(b.x)], 1u);
        const unsigned gen = old / nloc;
        if (old + 1u == (gen + 1u) * nloc) {
            __builtin_amdgcn_fence(__ATOMIC_RELEASE, "agent");
            asm volatile("s_waitcnt vmcnt(0)" ::: "memory");
            const unsigned og = xb_add(&bar[XB_TOP], 1u);
            const unsigned tg = og / nx;
            if (og + 1u == (tg + 1u) * nx) xb_add(&bar[XB_TOPGEN], 1u);
            else XB_SPIN(xb_ld(&bar[XB_TOPGEN]) == tg, bar);
            __builtin_amdgcn_fence(__ATOMIC_ACQUIRE, "agent");
            xb_add(&bar[XB_XGEN(b.x)], 1u);
            asm volatile("s_waitcnt vmcnt(0)" ::: "memory");
        } else {
            XB_SPIN(xb_ld(&bar[XB_XGEN(b.x)]) == gen, bar);
            __builtin_amdgcn_fence(__ATOMIC_ACQUIRE, "agent");
            asm volatile("s_waitcnt vmcnt(0)" ::: "memory");
        }
    }
    __syncthreads();
}

typedef pg8::EpiBf16<0> EpiP;
enum { OP_GEMM = 0, OP_ROPE_DIFF, OP_DIFF_ATTN, OP_RES_NORM, OP_ROPE_DIL, OP_DIL_ATTN, OP_DIL_COMB, OP_HG_GATES, OP_HG_SCAN, OP_HG_COMB, OP_CONVGLU, OP_GEMM_FFN, OP_END };
struct Step { int op; int half; const bf16_t* A; const bf16_t* Bt; bf16_t* O; int M, N, K, ldc, split; const bf16_t* Yin; int gA, gB; int mode, tok0; };
__device__ __forceinline__ Step get_step(int layer, int s, unsigned char* ws) {
  bf16_t* W = (bf16_t*)(ws + WS_W); bf16_t* H = (bf16_t*)(ws + WS_H); bf16_t* Y = (bf16_t*)(ws + WS_Y); bf16_t* BIG = (bf16_t*)(ws + WS_BIG);
  const int kind = layer % 3, j = layer / 3;
  Step st; st.op = OP_END; st.half = 0; st.A = H; st.Bt = W; st.O = Y; st.M = M_TOK; st.N = 1024; st.K = 1024; st.ldc = 1024; st.split = 0; st.Yin = Y; st.gA = 0; st.gB = -1; st.mode = 0; st.tok0 = 0;
  const int nmix = (kind == 0) ? 3 : (kind == 1) ? 7 : 4;
  if (s < nmix) {
    if (kind == 2) {
      if (s == 0) { st.op = OP_GEMM; st.A = H; st.Bt = W + WE_CIN; st.O = BIG; st.N = 5120; st.ldc = 5120; st.mode = 2; }
      else if (s == 1) st.op = OP_HG_SCAN;
      else if (s == 2) st.op = OP_HG_COMB;
      else { st.op = OP_GEMM; st.A = Y; st.Bt = W + WE_CO; st.O = H; }
    } else if (kind == 0) {
      if (s == 0) { st.op = OP_GEMM; st.A = H; st.Bt = W + WE_AQKV + (size_t)j * 3072 * 1024; st.O = BIG; st.N = 3072; st.split = 1024; st.mode = 1; }
      else if (s == 1) st.op = OP_DIFF_ATTN;
      else { st.op = OP_GEMM; st.A = H; st.Bt = W + WE_AO + (size_t)j * 1024 * 1024; st.O = Y; }
    } else {
      if (s == 6) { st.op = OP_GEMM; st.A = Y; st.Bt = W + WE_BO; st.O = H; }
      else { const int half = s / 3, q = s % 3; st.half = half;
        if (q == 0) { st.op = OP_GEMM; st.A = H + (size_t)half * MH * DM; st.Bt = W + WE_BQKV; st.O = BIG; st.M = MH; st.N = 9216; st.ldc = 9216; st.mode = 1; st.tok0 = half * MH; }
        else st.op = (q == 1) ? OP_DIL_ATTN : OP_DIL_COMB; }
    }
    return st;
  }
  const int f = s - nmix;
  bf16_t* U = Y; bf16_t* Gb = Y + 352ull * MiB / 2;
  if (f == 0) { st.op = OP_RES_NORM; st.Yin = (kind == 0) ? Y : H; st.gA = layer * 4 + 1; st.gB = layer * 4 + 2; }
  else if (f == 1) { st.op = OP_GEMM_FFN; st.A = H - 1024; st.Bt = W + WE_FIN + (size_t)layer * 5632 * 1024; st.O = Gb; st.M = 265 * 256; st.N = 5632; }
  else if (f == 2) { st.op = OP_GEMM; st.A = Gb; st.Bt = W + WE_FOUT + (size_t)layer * 1024 * 2816; st.O = Y; st.K = 2816; }
  else if (f == 3) { st.op = OP_RES_NORM; st.Yin = Y; st.gA = layer * 4 + 3; st.gB = (layer < 3) ? (layer + 1) * 4 : -1; }
  return st;
}

__global__ void __launch_bounds__(512) fwd_megakernel(Params p) {
  extern __shared__ __attribute__((aligned(16))) unsigned char lds_raw[];
  cg::grid_group grid = cg::this_grid();
  ldsp lds = (ldsp)lds_raw;
  const int G = gridDim.x, ngw = G * 8, ngt = G * 512;
  if (threadIdx.x < 2) *(LAS unsigned*)(lds + 131072 + 256 + 4 * threadIdx.x) = 0u;
  __syncthreads();
#define FRESH() const int tid = fresh_tid(), lane = tid & 63, wave = tid >> 6, gw = blockIdx.x * 8 + wave, gt = blockIdx.x * 512 + tid; (void)lane; (void)wave; (void)gw; (void)gt
  unsigned char* ws = kargs()->ws;
  float* x = kargs()->out;
  float* rope = (float*)(ws + WS_ROPE); float* oml = (float*)(ws + WS_OML);
  bf16_t* W = (bf16_t*)(ws + WS_W); bf16_t* H = (bf16_t*)(ws + WS_H); bf16_t* Y = (bf16_t*)(ws + WS_Y); bf16_t* BIG = (bf16_t*)(ws + WS_BIG);
#define norm_g (kargs()->in[2])

  {
    FRESH();
    LAS float* scr = (LAS float*)(lds + wave * 16384);
#pragma unroll 1
    for (int mi = 0; mi < 16; ++mi) {
      const float* src; bf16_t* dst; int K = 1024, N = 1024;
      if (mi < 2) { src = kargs()->in[3] + (size_t)mi * 1024 * 3072; dst = W + WE_AQKV + (size_t)mi * 3072 * 1024; N = 3072; }
      else if (mi < 4) { src = kargs()->in[6] + (size_t)(mi - 2) * 1024 * 1024; dst = W + WE_AO + (size_t)(mi - 2) * 1024 * 1024; }
      else if (mi == 4) { src = kargs()->in[7]; dst = W + WE_BQKV; N = 9216; }
      else if (mi == 5) { src = kargs()->in[8]; dst = W + WE_BO; }
      else if (mi == 6) { src = kargs()->in[9]; dst = W + WE_CIN; N = 5120; }
      else if (mi == 7) { src = kargs()->in[12]; dst = W + WE_CO; }
      else if (mi < 12) { src = kargs()->in[13] + (size_t)(mi - 8) * 1024 * 5632; dst = W + WE_FIN + (size_t)(mi - 8) * 5632 * 1024; N = 5632; }
      else { src = kargs()->in[16] + (size_t)(mi - 12) * 2816 * 1024; dst = W + WE_FOUT + (size_t)(mi - 12) * 1024 * 2816; K = 2816; }
      transpose_mat(src, K, N, dst, scr, gw, ngw, lane, mi >= 8 && mi < 12);
    }
    for (int i = gt; i < 8192 * 8; i += ngt) { const int pos = i >> 3, f = i & 7; const double rev = (double)pos * kargs()->invf[f] * 0.15915494309189535; const float fr = (float)(rev - floor(rev));
      rope[pos * 16 + f] = __builtin_amdgcn_cosf(fr); rope[pos * 16 + 8 + f] = __builtin_amdgcn_sinf(fr); }
    for (int i = gt; i < 1024; i += ngt) { const float* lg = kargs()->in[10]; const float a0 = lg[i], a1 = lg[1024 + i], a2 = lg[2048 + i], a3 = lg[3072 + i]; const float mx = fmaxf(fmaxf(a0, a1), fmaxf(a2, a3));
      const float e0 = __expf(a0 - mx), e1 = __expf(a1 - mx), e2 = __expf(a2 - mx), e3 = __expf(a3 - mx); oml[i] = 1.f - (e1 + e2) / (e0 + e1 + e2 + e3); }
    phase_init_norm(kargs()->in[0], kargs()->in[1], x, H, norm_g, gw, ngw, lane);
  }
  grid.sync();
  XcdBarrier xbar = xcd_barrier_post((unsigned*)(ws + WS_BAR), (volatile LAS unsigned*)(lds + 131072 + 256));

#pragma unroll 1
  for (int layer = 0; layer < 4; ++layer) {
#pragma unroll 1
#ifdef PROBE_DUP_OP
    for (int s = 0, rep_ = 0; s < 16; ) {
#else
    for (int s = 0; s < 16; ++s) {
#endif
      const Step st = get_step(layer, s, ws);
      if (st.op == OP_END) break;
#ifdef PROBE_REPEAT_OP
      for (int rep_ = 0; rep_ < ((st.op == PROBE_REPEAT_OP) ? 2 : 1); ++rep_) {
#endif
      switch (st.op) {
        case OP_GEMM: {
          pg8::EpiAct E{st.O, st.ldc, st.split, (size_t)M_TOK * DM, st.mode, rope, st.tok0, C2};
          int gM = st.M, gN = st.N, gK = st.K, gG = G, gB = (int)blockIdx.x; asm volatile("" : "+s"(gM), "+s"(gN), "+s"(gK), "+s"(gG), "+s"(gB));
          pg8::Gemm g{st.A, st.Bt, gM, gN, gK}; pg8::StaticOrder S; S.init(gM, gN, gG, gB);
          pg8::gemm_phase<pg8::EpiAct, pg8::StaticOrder, true, true>(lds, g, S, E);
        } break;
        case OP_GEMM_FFN: {
          int ly = layer; asm volatile("" : "+s"(ly));
          pg8::EpiConvGlu E{st.O, kargs()->in[14] + (size_t)ly * 3 * 5632, kargs()->in[15] + (size_t)ly * 5632};
          int gM = st.M, gN = st.N, gK = st.K, gG = G, gB = (int)blockIdx.x; asm volatile("" : "+s"(gM), "+s"(gN), "+s"(gK), "+s"(gG), "+s"(gB));
          pg8::Gemm g{st.A, st.Bt, gM, gN, gK}; pg8::StaticOrder S; S.init(gM, gN, gG, gB);
          pg8::gemm_phase<pg8::EpiConvGlu, pg8::StaticOrder, true, true, true>(lds, g, S, E);
        } break;
        case OP_ROPE_DIFF: { FRESH(); bf16_t* Qb = BIG; bf16_t* Kb = BIG + (size_t)M_TOK * DM;
          for (int it = gw; it < M_TOK * 2; it += ngw) { const int row = it >> 1, sg = it & 1; const int pos = (row < MH) ? (row & 8191) : (row & 4095);
            rope_seg((sg ? Kb : Qb) + (size_t)row * DM + 16 * lane, pos, sg ? 1.f : C2, rope, lane); } } break;
        case OP_DIFF_ATTN: { int ly = layer; asm volatile("" : "+s"(ly)); const int j = ly / 3; const float lam_init = __builtin_bit_cast(float, (ly == 0) ? 0x3e4ccccd : 0x3f0e59d5), osc_l = __builtin_bit_cast(float, (ly == 0) ? 0x3f4ccccd : 0x3ee34c57);
          phase_diff_attn(lds, BIG, BIG + (size_t)M_TOK * DM, BIG + 2 * (size_t)M_TOK * DM, H, kargs()->in[4] + j * 256, kargs()->in[5] + j * 128, lam_init, osc_l); } break;
        case OP_RES_NORM: { FRESH(); const bool first_ = (st.gA == 1); phase_res_norm(st.Yin, x, H, norm_g + st.gA * 1024, st.gB >= 0 ? norm_g + st.gB * 1024 : nullptr, gw, ngw, lane, first_ ? kargs()->in[0] : nullptr, first_ ? kargs()->in[1] : nullptr); } break;
        case OP_ROPE_DIL: { FRESH();
          for (int it = gw; it < MH * 6; it += ngw) { const int row = it / 6, sg = it % 6; const int tok = st.half * MH + row; const int pos = (tok < MH) ? (tok & 8191) : (tok & 4095);
            rope_seg(BIG + (size_t)row * 9216 + (sg >> 1) * 3072 + (sg & 1) * 1024 + 16 * lane, pos, (sg & 1) ? 1.f : C2, rope, lane); } } break;
        case OP_DIL_ATTN: { float* LSE = (float*)(BIG + (size_t)MH * 9216);
#pragma unroll 1
          for (int u = blockIdx.x; u < 6144; u += G) dil_unit(lds, BIG, LSE, st.half, u); } break;
        case OP_DIL_COMB: { FRESH(); phase_dil_combine(BIG, (const float*)(BIG + (size_t)MH * 9216), Y + (size_t)st.half * MH * DM, gw, ngw, lane); } break;
        case OP_HG_GATES: { FRESH(); phase_hgrn_gates(BIG, gt, ngt); } break;
        case OP_HG_SCAN: {
#pragma unroll 1
          for (int c = blockIdx.x; c < 192; c += G) hgrn_chain(lds, BIG, Y, H, oml, c); } break;
        case OP_HG_COMB: { FRESH(); phase_hgrn_combine(BIG, Y, H, Y, kargs()->in[11], gw, ngw, lane); } break;
        case OP_CONVGLU: { FRESH(); phase_convglu(Y, Y + 352ull * MiB / 2 + (size_t)st.half * MH * DFF, kargs()->in[14] + (size_t)layer * 3 * 5632, kargs()->in[15] + (size_t)layer * 5632, st.half, gt, ngt); } break;
        default: break;
      }
      xcd_barrier(xbar);
#ifdef PROBE_DUP_OP
      if (st.op == PROBE_DUP_OP && rep_ == 0) rep_ = 1; else { rep_ = 0; ++s; }
#endif
#ifdef PROBE_REPEAT_OP
      }
#endif
    }
  }
}

constexpr int LDS_BYTES = 147456;
extern "C" void kernel_launch(void* const* d_in, const int* in_sizes, int n_in, void* d_out, int out_size, void* d_ws, size_t ws_size, hipStream_t stream) {
  static int grid = 0;
  if (grid == 0) {
    if (n_in != 17 || ws_size < WS_END) { fprintf(stderr, "kernel_launch: unexpected n_in %d / ws %zu\n", n_in, ws_size); grid = -1; return; }
    int dev = 0, cus = 0;
    if (hipGetDevice(&dev) != hipSuccess || hipDeviceGetAttribute(&cus, hipDeviceAttributeMultiprocessorCount, dev) != hipSuccess) { grid = -1; return; }
    if (hipFuncSetAttribute((const void*)fwd_megakernel, hipFuncAttributeMaxDynamicSharedMemorySize, LDS_BYTES) != hipSuccess) { fprintf(stderr, "hipFuncSetAttribute failed\n"); grid = -1; return; }
    grid = cus;
  }
  if (grid < 0) return;
  if (hipMemsetAsync((char*)d_ws + WS_BAR, 0, XCD_BAR_WORDS * 4, stream) != hipSuccess) { fprintf(stderr, "kernel_launch: memset of the barrier words failed\n"); return; }
  Params p{};
  for (int i = 0; i < 17; ++i) p.in[i] = (const float*)d_in[i];
  p.out = (float*)d_out; p.ws = (unsigned char*)d_ws;
  for (int i = 0; i < 8; ++i) p.invf[i] = pow(500000.0, -(double)i / 8.0);
  void* args[] = {&p};
  hipError_t e = hipLaunchCooperativeKernel((void*)fwd_megakernel, dim3(grid), dim3(512), args, LDS_BYTES, stream);
  if (e != hipSuccess) fprintf(stderr, "cooperative launch failed: %s (grid %d)\n", hipGetErrorString(e), grid);
}
```

```cpp
#include <hip/hip_runtime.h>
#include <hip/hip_cooperative_groups.h>
#include <cstdio>
#include <cstdint>
#include <cmath>
namespace cg = cooperative_groups;
namespace pg8 {
#define PG8_LAS __attribute__((address_space(3)))
typedef unsigned short bf16_t;
typedef short bf16x8 __attribute__((ext_vector_type(8)));
typedef float f32x4 __attribute__((ext_vector_type(4)));
typedef unsigned u32x4 __attribute__((ext_vector_type(4)));
constexpr int BM = 256, BK = 64, HALF = 128, HTB = HALF * BK * 2  , STAGE_BYTES = 8 * HTB, NXCD = 8, WGM = 8;

__host__ __device__ __forceinline__ int lds_byte(int r, int c) { const int st = (r >> 4) * 2 + (c >> 5), rr = r & 15, cc = c & 31, ob = rr * 64 + cc * 2; return st * 1024 + (ob ^ (((ob >> 9) & 1) << 5)); }
__host__ __device__ __forceinline__ void stage_rc(int b, int& R, int& C) { const int st = b / 1024, sb = b % 1024, swz = sb ^ (((sb >> 9) & 1) << 5); R = (st >> 1) * 16 + swz / 64; C = (st & 1) * 32 + (swz % 64) / 2; }
__host__ __device__ __forceinline__ int perm32(int rho) { const int n = rho >> 4, i = rho & 15; return 8 * (i >> 2) + 4 * n + (i & 3); }

struct Unit { int pm, pn; };
struct Gemm { const bf16_t* A; const bf16_t* Bt; int M, N, K; };

struct StaticOrder {
    int nM, nN, nwg, G, c;
    __host__ __device__ void init(int M, int N, int G_, int c_) { nM = M / BM; nN = N / BM; nwg = nM * nN; G = G_; c = c_; }
    __host__ __device__ bool next(int i, Unit& u) const {
        const int L = i * G + c; if (L >= nwg) return false;
        int wgid = L; { const int q = nwg / NXCD, r = nwg % NXCD, xcd = wgid % NXCD, off = wgid / NXCD; wgid = (xcd < r ? xcd * (q + 1) : r * (q + 1) + (xcd - r) * q) + off; }
        const int nig = WGM * nN, gid = wgid / nig, fm = gid * WGM, gsz = (nM - fm) < WGM ? (nM - fm) : WGM;
        u.pm = fm + ((wgid % nig) % gsz); u.pn = (wgid % nig) / gsz; return true;
    }
    __device__ __forceinline__ void a_ready(const Unit&) const {}
    __device__ __forceinline__ void done(const Unit&) const {}
};

__device__ __forceinline__ unsigned cvt_pk_bf16(float lo, float hi) { unsigned r; asm volatile("v_cvt_pk_bf16_f32 %0, %1, %2" : "=v"(r) : "v"(lo), "v"(hi)); return r; }
typedef float f32x2 __attribute__((ext_vector_type(2)));
__device__ __forceinline__ f32x2 gelu_pk(f32x2 v) {
    const f32x2 av = __builtin_elementwise_abs(v), d = av * 0.2316418882f + 1.0f;
    f32x2 t; t.x = __builtin_amdgcn_rcpf(d.x); t.y = __builtin_amdgcn_rcpf(d.y);
    f32x2 q = t * 0.5307027145f + (-0.7265760135f); q = q * t + 0.7107068705f; q = q * t + (-0.142248368f); q = q * t + 0.127414796f; q = q * t;
    const f32x2 s = (v * v) * (-0.72134752044f);
    f32x2 e; e.x = __builtin_amdgcn_exp2f(s.x); e.y = __builtin_amdgcn_exp2f(s.y);
    const f32x2 m = v * (q * e), r = v - m;
    f32x2 o; o.x = v.x < 0.f ? m.x : r.x; o.y = v.y < 0.f ? m.y : r.y; return o;
}

template <int ACT  > struct EpiBf16 {
    static constexpr bool PERM = true, AFTER_DRAIN = false; static_assert(ACT == 0 || ACT == 1, "EpiBf16: ACT is 0 (none) or 1 (gelu_pk)");
    bf16_t* O; int ldc; const float* bias; int split_cols; size_t split_stride; float scale0;
    __device__ __forceinline__ void operator()(const f32x4 (&acc)[2][2][4][2], const Unit& u, int wr, int wc, int fr, int fq) const {
        const int row0 = u.pm * BM + wr * 64 + fr; int colt = u.pn * BM; bf16_t* base = O;
        float sc = 1.f; if (split_cols) { const int t = colt / split_cols; base += (size_t)t * split_stride; colt -= t * split_cols; if (t == 0) sc = scale0; }
        const int col0 = colt + wc * 32 + 8 * fq, bcol0 = u.pn * BM + wc * 32 + 8 * fq;
        f32x4 bv[2][2];
#pragma unroll
        for (int bj = 0; bj < 2; ++bj)
#pragma unroll
            for (int n = 0; n < 2; ++n) bv[bj][n] = bias ? *(const f32x4*)(bias + bcol0 + bj * HALF + 4 * n) : (f32x4){0.f, 0.f, 0.f, 0.f};
#pragma unroll
        for (int ai = 0; ai < 2; ++ai)
#pragma unroll
            for (int m = 0; m < 4; ++m) { bf16_t* rowp = base + (size_t)(row0 + ai * HALF + m * 16) * ldc + col0;
#pragma unroll
                for (int bj = 0; bj < 2; ++bj) { f32x4 v0 = acc[ai][bj][m][0] + bv[bj][0], v1 = acc[ai][bj][m][1] + bv[bj][1];
                    if (ACT == 1) { f32x2 a = gelu_pk((f32x2){v0[0], v0[1]}), b = gelu_pk((f32x2){v0[2], v0[3]}), c = gelu_pk((f32x2){v1[0], v1[1]}), d = gelu_pk((f32x2){v1[2], v1[3]});
                        v0 = (f32x4){a.x, a.y, b.x, b.y}; v1 = (f32x4){c.x, c.y, d.x, d.y}; }
                    v0 = v0 * sc; v1 = v1 * sc; u32x4 w; w.x = cvt_pk_bf16(v0[0], v0[1]); w.y = cvt_pk_bf16(v0[2], v0[3]); w.z = cvt_pk_bf16(v1[0], v1[1]); w.w = cvt_pk_bf16(v1[2], v1[3]);
                    *(u32x4*)(rowp + bj * HALF) = w; } }
    }
};


struct EpiAct {
    static constexpr bool PERM = true, AFTER_DRAIN = false;
    bf16_t* O; int ldc; int split_cols; size_t split_stride; int mode; const float* rope; int tok0; float qscale;
    __device__ __forceinline__ void operator()(const f32x4 (&acc)[2][2][4][2], const Unit& u, int wr, int wc, int fr, int fq) const {
        const int row0 = u.pm * BM + wr * 64 + fr; int colt = u.pn * BM; bf16_t* base = O; asm volatile("" : "+s"(base));
        const float* rope_ = rope; asm volatile("" : "+s"(rope_));
        int act = 0;
        if (mode == 1) { const int seg = colt % 3072; act = seg < 1024 ? 1 : (seg < 2048 ? 2 : 0); }
        else if (mode == 2) { act = colt < 1024 ? 3 : (colt < 3072 ? 4 : 0); }
        if (split_cols) { const int t = colt / split_cols; base += (size_t)t * split_stride; colt -= t * split_cols; }
        const int col0 = colt + wc * 32 + 8 * fq;
        const bool rope_wave = (act == 1 || act == 2) && ((wc & 1) == 0);
        const float sc = (act == 1) ? qscale : 1.f;
        const float sgn = (fq == 0) ? -1.f : 1.f; const bool rot = fq < 2;
#pragma unroll
        for (int ai = 0; ai < 2; ++ai)
#pragma unroll
            for (int m = 0; m < 4; ++m) {
                const int row = row0 + ai * HALF + m * 16; bf16_t* rowp = base + (size_t)row * ldc + col0;
                f32x4 c0 = {1.f, 1.f, 1.f, 1.f}, c1 = c0, s0 = {0.f, 0.f, 0.f, 0.f}, s1 = s0;
                if (rope_wave) { const int tok = tok0 + row; const int pos = (tok < 32768) ? (tok & 8191) : (tok & 4095); const float* cs = rope_ + (size_t)pos * 16;
                    c0 = *(const f32x4*)cs; c1 = *(const f32x4*)(cs + 4); s0 = *(const f32x4*)(cs + 8) * sgn; s1 = *(const f32x4*)(cs + 12) * sgn; }
#pragma unroll
                for (int bj = 0; bj < 2; ++bj) {
                    f32x4 v0 = acc[ai][bj][m][0], v1 = acc[ai][bj][m][1];
                    if (rope_wave) {
                        f32x4 p0, p1;
#pragma unroll
                        for (int e = 0; e < 4; ++e) { float a0 = v0[e], b0 = v0[e], a1 = v1[e], b1 = v1[e];
                            asm volatile("s_nop 1\n\tv_permlane16_swap_b32 %0, %1" : "+v"(a0), "+v"(b0));
                            asm volatile("s_nop 1\n\tv_permlane16_swap_b32 %0, %1" : "+v"(a1), "+v"(b1));
                            p0[e] = (fq & 1) ? a0 : b0; p1[e] = (fq & 1) ? a1 : b1; }
                        const f32x4 r0 = v0 * c0 + p0 * s0, r1 = v1 * c1 + p1 * s1;
                        if (rot) { v0 = r0; v1 = r1; }
                    }
                    if (act == 3) {
#pragma unroll
                        for (int e = 0; e < 4; ++e) { v0[e] = v0[e] * __builtin_amdgcn_rcpf(1.f + __builtin_amdgcn_exp2f(-1.4426950409f * v0[e])) * 0.08838834764831845f;
                                                       v1[e] = v1[e] * __builtin_amdgcn_rcpf(1.f + __builtin_amdgcn_exp2f(-1.4426950409f * v1[e])) * 0.08838834764831845f; }
                    } else if (act == 4) {
#pragma unroll
                        for (int e = 0; e < 4; ++e) { v0[e] = __builtin_amdgcn_rcpf(1.f + __builtin_amdgcn_exp2f(1.4426950409f * v0[e])); v1[e] = __builtin_amdgcn_rcpf(1.f + __builtin_amdgcn_exp2f(1.4426950409f * v1[e])); }
                    }
                    v0 = v0 * sc; v1 = v1 * sc;
                    u32x4 w; w.x = cvt_pk_bf16(v0[0], v0[1]); w.y = cvt_pk_bf16(v0[2], v0[3]); w.z = cvt_pk_bf16(v1[0], v1[1]); w.w = cvt_pk_bf16(v1[2], v1[3]);
                    *(u32x4*)(rowp + bj * HALF) = w;
                }
            }
    }
};

struct EpiConvGlu {
    static constexpr bool PERM = true, AFTER_DRAIN = false;
    bf16_t* G; const float* cw; const float* cb;
    __device__ __forceinline__ void operator()(f32x4 (&acc)[2][2][4][2], const Unit& u, int wr, int wc, int fr, int fq) const {
        const int chb = u.pn * 128 + wc * 32 + 8 * fq;
        bf16_t* G_ = G; const float* cw_ = cw; const float* cb_ = cb; asm volatile("" : "+s"(G_), "+s"(cw_), "+s"(cb_));
        f32x4 w0[2][2], w1[2][2], w2[2][2], bb[2][2];
#pragma unroll
        for (int bj = 0; bj < 2; ++bj)
#pragma unroll
            for (int n = 0; n < 2; ++n) { const int col = bj * 2816 + chb + 4 * n;
                w0[bj][n] = *(const f32x4*)(cw_ + col); w1[bj][n] = *(const f32x4*)(cw_ + 5632 + col); w2[bj][n] = *(const f32x4*)(cw_ + 2 * 5632 + col); bb[bj][n] = *(const f32x4*)(cb_ + col); }
#pragma unroll
        for (int ai = 0; ai < 2; ++ai) {
            const int tokb = 62 * (4 * u.pm + 2 * ai + wr) - 1 + 4 * fr;
            float pm_[4], nm_[4];
#pragma unroll
            for (int m = 0; m < 4; ++m) { const int t = tokb + m; const int msk = (t < 32768) ? 8191 : 4095; pm_[m] = ((t & msk) == 0) ? 0.f : 1.f; nm_[m] = ((t & msk) == msk) ? 0.f : 1.f; }
#pragma unroll
            for (int bj = 0; bj < 2; ++bj)
#pragma unroll
                for (int n = 0; n < 2; ++n) {
                    const f32x4 x0 = acc[ai][bj][0][n], x1 = acc[ai][bj][1][n], x2 = acc[ai][bj][2][n], x3 = acc[ai][bj][3][n];
                    f32x4 pv, nx;
#pragma unroll
                    for (int e = 0; e < 4; ++e) { float a_, b_;
                        asm volatile("s_nop 1\n\tv_mov_b32_dpp %0, %1 row_shr:1 row_mask:0xf bank_mask:0xf bound_ctrl:1" : "=&v"(a_) : "v"(x3[e]));
                        asm volatile("s_nop 1\n\tv_mov_b32_dpp %0, %1 row_shl:1 row_mask:0xf bank_mask:0xf bound_ctrl:1" : "=&v"(b_) : "v"(x0[e]));
                        pv[e] = a_; nx[e] = b_; }
                    acc[ai][bj][0][n] = bb[bj][n] + w0[bj][n] * (pv * pm_[0]) + w1[bj][n] * x0 + w2[bj][n] * (x1 * nm_[0]);
                    acc[ai][bj][1][n] = bb[bj][n] + w0[bj][n] * (x0 * pm_[1]) + w1[bj][n] * x1 + w2[bj][n] * (x2 * nm_[1]);
                    acc[ai][bj][2][n] = bb[bj][n] + w0[bj][n] * (x1 * pm_[2]) + w1[bj][n] * x2 + w2[bj][n] * (x3 * nm_[2]);
                    acc[ai][bj][3][n] = bb[bj][n] + w0[bj][n] * (x2 * pm_[3]) + w1[bj][n] * x3 + w2[bj][n] * (nx * nm_[3]);
                }
#pragma unroll
            for (int m = 0; m < 4; ++m) {
                const int pos = 4 * fr + m, t = tokb + m;
                unsigned wv[4];
#pragma unroll
                for (int n = 0; n < 2; ++n) { float o[4];
#pragma unroll
                    for (int e = 0; e < 4; ++e) { const float x = acc[ai][0][m][n][e]; const float z = -2.302208198f * (x + 0.044715f * x * x * x);
                        o[e] = x * __builtin_amdgcn_rcpf(1.f + __builtin_amdgcn_exp2f(z)) * acc[ai][1][m][n][e]; }
                    wv[2 * n] = cvt_pk_bf16(o[0], o[1]); wv[2 * n + 1] = cvt_pk_bf16(o[2], o[3]); }
                if (pos >= 1 && pos <= 62 && t < 65536) *(u32x4*)(G_ + (size_t)t * 2816 + chb) = (u32x4){wv[0], wv[1], wv[2], wv[3]};
            }
        }
    }
};
template <class Epi, class Sched, bool ALIGN_EPI = false, bool SP2 = false, bool APERM = false>
__device__ __forceinline__ void gemm_phase(PG8_LAS unsigned char* lds, const Gemm g, const Sched& S, const Epi& E) {
    int tid_l = threadIdx.x; asm volatile("" : "+v"(tid_l));
    const int tid = tid_l, wid = __builtin_amdgcn_readfirstlane(tid >> 6), lane = tid & 63, wr = wid >> 2, wc = wid & 3, fr = lane & 15, fq = lane >> 4;
    const int K = g.K, nt = K / BK;
    unsigned voffA[2], voffB[2];
#pragma unroll
    for (int i = 0; i < 2; ++i) { int R, C; stage_rc(tid * 16 + i * 8192, R, C); const int Rb = Epi::PERM ? ((R & ~31) + perm32(R & 31)) : R;
        const int Ra = APERM ? (62 * (R >> 6) + 4 * (R & 15) + ((R >> 4) & 3)) : R;
        voffA[i] = (unsigned)(Ra * K + C) * 2u; voffB[i] = (unsigned)(Rb * K + C) * 2u; }
    const size_t kstep = (size_t)(BK * 2);
    const size_t hstep = (size_t)HALF * K * 2;
    const size_t tstep = 2 * hstep;
    const size_t hstepA = APERM ? (size_t)124 * K * 2 : hstep, tstepA = 2 * hstepA;
    const unsigned ldsw = (unsigned)wid * 1024u;
    const int aoff = lds_byte(wr * 64 + fr, fq * 8), boff = lds_byte(wc * 32 + fr, fq * 8);
#define PG8_SA(b, h) (((b) * 2 + (h)) * HTB)
#define PG8_SB(b, h) ((4 + (b) * 2 + (h)) * HTB)
#define PG8_STAGE(bufoff, gbase, voff) do { _Pragma("unroll") for (int _i = 0; _i < 2; ++_i) \
        __builtin_amdgcn_global_load_lds((const unsigned*)((const char*)(gbase) + (voff)[_i]), (PG8_LAS unsigned*)(lds + (bufoff) + ldsw + _i * 8192), 16, 0, 0); } while (0)
#define PG8_LDA(dst, b, h) do { _Pragma("unroll") for (int m = 0; m < 4; ++m) _Pragma("unroll") for (int k = 0; k < 2; ++k) dst[m][k] = *(const PG8_LAS bf16x8*)(lds + PG8_SA(b, h) + aoff + m * 2048 + k * 1024); } while (0)
#define PG8_LDB(dst, b, h) do { _Pragma("unroll") for (int n = 0; n < 2; ++n) _Pragma("unroll") for (int k = 0; k < 2; ++k) dst[n][k] = *(const PG8_LAS bf16x8*)(lds + PG8_SB(b, h) + boff + n * 2048 + k * 1024); } while (0)
#define PG8_MMA(ai, bj, At, Bt) do { __builtin_amdgcn_s_setprio(1); _Pragma("unroll") for (int m = 0; m < 4; ++m) _Pragma("unroll") for (int n = 0; n < 2; ++n) _Pragma("unroll") for (int k = 0; k < 2; ++k) \
        acc[ai][bj][m][n] = __builtin_amdgcn_mfma_f32_16x16x32_bf16(Bt[n][k], At[m][k], acc[ai][bj][m][n], 0, 0, 0); __builtin_amdgcn_s_setprio(0); } while (0)
#define PG8_WAIT_V(n) asm volatile("s_waitcnt vmcnt(" #n ")" ::: "memory")
#define PG8_WAIT_L(n) asm volatile("s_waitcnt lgkmcnt(" #n ")" ::: "memory")
#define PG8_BAR __builtin_amdgcn_s_barrier()
#define PG8_SCHED __builtin_amdgcn_sched_barrier(0)
    Unit cur, nxt; int ui = 0;
    if (!S.next(0, cur)) return;
    f32x4 acc[2][2][4][2];
#pragma unroll
    for (int a = 0; a < 2; ++a)
#pragma unroll
        for (int b = 0; b < 2; ++b)
#pragma unroll
            for (int m = 0; m < 4; ++m)
#pragma unroll
                for (int n = 0; n < 2; ++n) acc[a][b][m][n] = (f32x4){0.f, 0.f, 0.f, 0.f};
    bf16x8 At[4][2], B0[2][2], B1[2][2];
    const char* cA = (const char*)g.A + (size_t)cur.pm * tstepA; const char* cB = (const char*)g.Bt + (size_t)cur.pn * tstep;
    S.a_ready(cur);
    if constexpr (SP2) {
        PG8_STAGE(PG8_SB(0, 0), cB, voffB); PG8_STAGE(PG8_SB(0, 1), cB + hstep, voffB); PG8_STAGE(PG8_SA(0, 0), cA, voffA); PG8_STAGE(PG8_SA(0, 1), cA + hstepA, voffA);
        if (wr == 1) PG8_BAR;
        PG8_WAIT_V(2); PG8_BAR;
        PG8_STAGE(PG8_SB(1, 0), cB + kstep, voffB); PG8_STAGE(PG8_SA(1, 0), cA + kstep, voffA); PG8_STAGE(PG8_SB(1, 1), cB + hstep + kstep, voffB);
        PG8_WAIT_V(6); PG8_BAR;
    } else {
        PG8_STAGE(PG8_SB(0, 0), cB, voffB); PG8_STAGE(PG8_SA(0, 0), cA, voffA); PG8_STAGE(PG8_SB(0, 1), cB + hstep, voffB); PG8_STAGE(PG8_SA(0, 1), cA + hstepA, voffA);
        if (wr == 1) PG8_BAR;
        PG8_WAIT_V(4); PG8_BAR;
        PG8_STAGE(PG8_SB(1, 0), cB + kstep, voffB); PG8_STAGE(PG8_SA(1, 0), cA + kstep, voffA); PG8_STAGE(PG8_SB(1, 1), cB + hstep + kstep, voffB);
        PG8_WAIT_V(6); PG8_BAR;
    }
    for (;;) {
        const bool has_next = S.next(ui + 1, nxt);
        const char* nA = has_next ? (const char*)g.A + (size_t)nxt.pm * tstepA : cA; const char* nB = has_next ? (const char*)g.Bt + (size_t)nxt.pn * tstep : cB;
        for (int t = 0; t < nt; t += 2) {
            const bool last = (t == nt - 2);
            const char* a1 = cA + (size_t)(t + 1) * kstep;
            const char* a2 = last ? nA : cA + (size_t)(t + 2) * kstep; const char* b2 = last ? nB : cB + (size_t)(t + 2) * kstep;
            const char* a3 = a2 + kstep; const char* b3 = b2 + kstep;
            if (last && has_next) S.a_ready(nxt);
            if constexpr (SP2) {
            PG8_LDB(B0, 0, 0); PG8_LDB(B1, 0, 1); PG8_SCHED; PG8_LDA(At, 0, 0); PG8_STAGE(PG8_SA(1, 1), a1 + hstepA, voffA);
            PG8_WAIT_V(8); PG8_WAIT_L(0); PG8_BAR; PG8_MMA(0, 0, At, B0); PG8_MMA(0, 1, At, B1); PG8_BAR; PG8_SCHED;
            PG8_LDA(At, 0, 1); PG8_STAGE(PG8_SB(0, 0), b2, voffB); PG8_STAGE(PG8_SB(0, 1), b2 + hstep, voffB); PG8_STAGE(PG8_SA(0, 0), a2, voffA);
            PG8_WAIT_V(8); PG8_WAIT_L(0); PG8_BAR; PG8_MMA(1, 0, At, B0); PG8_MMA(1, 1, At, B1); PG8_BAR; PG8_SCHED;
            PG8_LDB(B0, 1, 0); PG8_LDB(B1, 1, 1); PG8_SCHED; PG8_LDA(At, 1, 0); PG8_STAGE(PG8_SA(0, 1), a2 + hstepA, voffA);
            PG8_WAIT_V(8); PG8_WAIT_L(0); PG8_BAR; PG8_MMA(0, 0, At, B0); PG8_MMA(0, 1, At, B1); PG8_BAR; PG8_SCHED;
            PG8_LDA(At, 1, 1); PG8_STAGE(PG8_SB(1, 0), b3, voffB); PG8_STAGE(PG8_SB(1, 1), b3 + hstep, voffB); PG8_STAGE(PG8_SA(1, 0), a3, voffA);
            PG8_WAIT_V(8); PG8_WAIT_L(0); PG8_BAR; PG8_MMA(1, 0, At, B0); PG8_MMA(1, 1, At, B1); PG8_BAR; PG8_SCHED;
            } else {
            PG8_LDB(B0, 0, 0); PG8_SCHED; PG8_LDA(At, 0, 0); PG8_STAGE(PG8_SA(1, 1), a1 + hstepA, voffA);
            PG8_WAIT_L(8); PG8_BAR; PG8_WAIT_L(0); PG8_MMA(0, 0, At, B0); PG8_BAR; PG8_SCHED;
            PG8_LDB(B1, 0, 1); PG8_STAGE(PG8_SB(0, 0), b2, voffB);
            PG8_BAR; PG8_WAIT_L(0); PG8_MMA(0, 1, At, B1); PG8_BAR;
            PG8_LDA(At, 0, 1); PG8_STAGE(PG8_SA(0, 0), a2, voffA);
            PG8_BAR; PG8_WAIT_L(0); PG8_MMA(1, 0, At, B0); PG8_BAR; PG8_SCHED;
            PG8_STAGE(PG8_SB(0, 1), b2 + hstep, voffB);
            PG8_WAIT_V(6); PG8_BAR; PG8_MMA(1, 1, At, B1); PG8_BAR;
            PG8_LDB(B0, 1, 0); PG8_SCHED; PG8_LDA(At, 1, 0); PG8_STAGE(PG8_SA(0, 1), a2 + hstepA, voffA);
            PG8_WAIT_L(8); PG8_BAR; PG8_WAIT_L(0); PG8_MMA(0, 0, At, B0); PG8_BAR; PG8_SCHED;
            PG8_LDB(B1, 1, 1); PG8_STAGE(PG8_SB(1, 0), b3, voffB);
            PG8_BAR; PG8_WAIT_L(0); PG8_MMA(0, 1, At, B1); PG8_BAR;
            PG8_LDA(At, 1, 1); PG8_STAGE(PG8_SA(1, 0), a3, voffA);
            PG8_BAR; PG8_WAIT_L(0); PG8_MMA(1, 0, At, B0); PG8_BAR; PG8_SCHED;
            PG8_STAGE(PG8_SB(1, 1), b3 + hstep, voffB);
            PG8_WAIT_V(6); PG8_BAR; PG8_MMA(1, 1, At, B1); PG8_BAR;
            }
        }
        if constexpr (ALIGN_EPI) { if (wr == 0) PG8_BAR; }
        if constexpr (!Epi::AFTER_DRAIN) { E(acc, cur, wr, wc, fr, fq); S.done(cur); }
        if (!has_next) break;
#pragma unroll
        for (int a = 0; a < 2; ++a)
#pragma unroll
            for (int b = 0; b < 2; ++b)
#pragma unroll
                for (int m = 0; m < 4; ++m)
#pragma unroll
                    for (int n = 0; n < 2; ++n) acc[a][b][m][n] = (f32x4){0.f, 0.f, 0.f, 0.f};
        cur = nxt; cA = nA; cB = nB; ++ui;
        if constexpr (ALIGN_EPI) { if (wr == 1) PG8_BAR; }
    }
    PG8_WAIT_V(0);
    if constexpr (!ALIGN_EPI) { if (wr == 0) PG8_BAR; }
    PG8_BAR;
    if constexpr (Epi::AFTER_DRAIN) { E.fused(acc, cur, wr, wc, fr, fq, lds, wid, lane); S.done(cur); }
#undef PG8_SA
#undef PG8_SB
#undef PG8_STAGE
#undef PG8_LDA
#undef PG8_LDB
#undef PG8_MMA
#undef PG8_WAIT_V
#undef PG8_WAIT_L
#undef PG8_BAR
#undef PG8_SCHED
}
}

#define LAS __attribute__((address_space(3)))
typedef unsigned short bf16_t;
typedef short bf16x8 __attribute__((ext_vector_type(8)));
typedef short s16x4 __attribute__((ext_vector_type(4)));
typedef float f32x16 __attribute__((ext_vector_type(16)));
typedef float f32x4 __attribute__((ext_vector_type(4)));
typedef float f32x2 __attribute__((ext_vector_type(2)));
typedef unsigned u32x4 __attribute__((ext_vector_type(4)));
typedef unsigned u32x2 __attribute__((ext_vector_type(2)));
typedef __bf16 bf16x2_t __attribute__((ext_vector_type(2)));
typedef LAS unsigned char* ldsp;

constexpr int M_TOK = 65536, MH = 32768, DM = 1024, DFF = 2816;
constexpr float C2 = 0.125f * 1.4426950408889634f;
constexpr size_t MiB = 1u << 20;
constexpr size_t WS_ROPE = 0;
constexpr size_t WS_OML = 512 * 1024;
constexpr size_t WS_BAR = 768 * 1024;
constexpr size_t WS_W = 1 * MiB;
constexpr size_t WS_H = 117 * MiB;
constexpr size_t WS_Y = 245 * MiB;
constexpr size_t WS_BIG = 373 * MiB;
constexpr size_t WS_END = 1013 * MiB;
constexpr size_t WE_AQKV = 0, WE_AO = WE_AQKV + 2ull * 3072 * 1024, WE_BQKV = WE_AO + 2ull * 1024 * 1024, WE_BO = WE_BQKV + 9216ull * 1024,
                 WE_CIN = WE_BO + 1024ull * 1024, WE_CO = WE_CIN + 5120ull * 1024, WE_FIN = WE_CO + 1024ull * 1024, WE_FOUT = WE_FIN + 4ull * 5632 * 1024,
                 WE_END = WE_FOUT + 4ull * 2816 * 1024;
static_assert(WE_END * 2 <= 116 * MiB, "weights fit");

struct Params { const float* in[17]; float* out; unsigned char* ws; double invf[8]; int pad0, pad1; };

__device__ __forceinline__ float bflo(unsigned u) { return __uint_as_float(u << 16); }
__device__ __forceinline__ float bfhi(unsigned u) { return __uint_as_float(u & 0xffff0000u); }
__device__ __forceinline__ unsigned pkbf(float lo, float hi) { f32x2 v = {lo, hi}; bf16x2_t b = __builtin_convertvector(v, bf16x2_t); return __builtin_bit_cast(unsigned, b); }
__device__ __forceinline__ float dppf(float v, int ctrl_xor1) { return v; }
#define DPPF(v, ctrl) __builtin_bit_cast(float, __builtin_amdgcn_update_dpp(0, __builtin_bit_cast(int, (v)), (ctrl), 0xf, 0xf, false))
__device__ __forceinline__ float swap16_sum(float m) { auto rr = __builtin_amdgcn_permlane16_swap(__float_as_uint(m), __float_as_uint(m), false, false); return __uint_as_float(rr[0]) + __uint_as_float(rr[1]); }
__device__ __forceinline__ float swap32_sum(float m) { auto rr = __builtin_amdgcn_permlane32_swap(__float_as_uint(m), __float_as_uint(m), false, false); return __uint_as_float(rr[0]) + __uint_as_float(rr[1]); }
__device__ __forceinline__ float wave_sum(float v) {
  v += DPPF(v, 0xB1); v += DPPF(v, 0x4E); v += DPPF(v, 0x124); v += DPPF(v, 0x128);
  v = swap16_sum(v); v = swap32_sum(v);
  return v;
}
__device__ __forceinline__ int fresh_tid() { int t = threadIdx.x; asm volatile("" : "+v"(t)); return t; }
typedef const Params __attribute__((address_space(4)))* CParamsPtr;
__device__ __forceinline__ CParamsPtr kargs() { CParamsPtr kp = (CParamsPtr)__builtin_amdgcn_kernarg_segment_ptr(); asm volatile("" : "+s"(kp)); return kp; }
__device__ __forceinline__ float half_swap_max(float m) { auto rr = __builtin_amdgcn_permlane32_swap(__float_as_uint(m), __float_as_uint(m), false, false); return fmaxf(__uint_as_float(rr[0]), __uint_as_float(rr[1])); }
__device__ __forceinline__ float half_swap_sum(float m) { auto rr = __builtin_amdgcn_permlane32_swap(__float_as_uint(m), __float_as_uint(m), false, false); return __uint_as_float(rr[0]) + __uint_as_float(rr[1]); }

__device__ __forceinline__ void transpose_item(const float* W, int K, int N, bf16_t* WT, LAS float* scr, int item, int lane, bool glu) {
  const int nblk = N / 32, kb = item / nblk, nb = item % nblk, k0 = 64 * kb, n0 = 32 * nb;
#pragma unroll 8
  for (int i = 0; i < 32; ++i) { const int kk = 2 * i + (lane >> 5); scr[kk * 33 + (lane & 31)] = W[(size_t)(k0 + kk) * N + n0 + (lane & 31)]; }
  asm volatile("s_waitcnt lgkmcnt(0)" ::: "memory");
  const int c = lane & 7;
#pragma unroll
  for (int j = 0; j < 4; ++j) { const int n = (lane >> 3) + 8 * j; const LAS float* s = scr + (8 * c) * 33 + n;
    u32x4 o; o.x = pkbf(s[0 * 33], s[1 * 33]); o.y = pkbf(s[2 * 33], s[3 * 33]); o.z = pkbf(s[4 * 33], s[5 * 33]); o.w = pkbf(s[6 * 33], s[7 * 33]);
    int nr = n0 + n; if (glu) { const int bj = nr >= 2816 ? 1 : 0, cc = nr - 2816 * bj; nr = 256 * (cc >> 7) + 128 * bj + (cc & 127); }
    *(u32x4*)(WT + (size_t)nr * K + k0 + 8 * c) = o; }
  asm volatile("s_waitcnt lgkmcnt(0)" ::: "memory");
}
__device__ __forceinline__ void transpose_mat(const float* W, int K, int N, bf16_t* WT, LAS float* scr, int gw, int ngw, int lane, bool glu) {
  const int items = (K / 64) * (N / 32);
  for (int it = gw; it < items; it += ngw) transpose_item(W, K, N, WT, scr, it, lane, glu);
}

__device__ __forceinline__ float row_rstd(const f32x4 (&v)[4], float eps) {
  float s = 0.f;
#pragma unroll
  for (int j = 0; j < 4; ++j) s += (v[j].x * v[j].x + v[j].y * v[j].y) + (v[j].z * v[j].z + v[j].w * v[j].w);
  return rsqrtf(wave_sum(s) * (1.f / 1024.f) + eps);
}
__device__ __forceinline__ void store_h_row(bf16_t* hrow, const f32x4 (&v)[4], float rstd, const float* g, int lane) {
#pragma unroll
  for (int j = 0; j < 4; ++j) { const f32x4 gg = *(const f32x4*)(g + 4 * lane + 256 * j);
    u32x2 w; w.x = pkbf(v[j].x * rstd * gg.x, v[j].y * rstd * gg.y); w.y = pkbf(v[j].z * rstd * gg.z, v[j].w * rstd * gg.w);
    *(u32x2*)(hrow + 4 * lane + 256 * j) = w; }
}
__device__ __forceinline__ void phase_init_norm(const float* xp, const float* xs, float* x, bf16_t* H, const float* g, int gw, int ngw, int lane) {
  float gv[2][8];
#pragma unroll
  for (int j = 0; j < 2; ++j) { const f32x4 g0 = *(const f32x4*)(g + 8 * lane + 512 * j), g1 = *(const f32x4*)(g + 8 * lane + 512 * j + 4);
    gv[j][0] = g0.x; gv[j][1] = g0.y; gv[j][2] = g0.z; gv[j][3] = g0.w; gv[j][4] = g1.x; gv[j][5] = g1.y; gv[j][6] = g1.z; gv[j][7] = g1.w; }
  for (int m = gw; m < M_TOK; m += ngw) {
    const float* src = (m < MH) ? xp + (size_t)m * DM : xs + (size_t)(m - MH) * DM;
    float v[2][8]; float ss = 0.f;
#pragma unroll
    for (int j = 0; j < 2; ++j) { const f32x4 a = *(const f32x4*)(src + 8 * lane + 512 * j), c = *(const f32x4*)(src + 8 * lane + 512 * j + 4);
      v[j][0] = a.x; v[j][1] = a.y; v[j][2] = a.z; v[j][3] = a.w; v[j][4] = c.x; v[j][5] = c.y; v[j][6] = c.z; v[j][7] = c.w;
#pragma unroll
      for (int e = 0; e < 8; ++e) ss += v[j][e] * v[j][e]; }
    const float r = rsqrtf(wave_sum(ss) * (1.f / 1024.f) + 1e-6f);
#pragma unroll
    for (int j = 0; j < 2; ++j) { u32x4 h; h.x = pkbf(v[j][0] * r * gv[j][0], v[j][1] * r * gv[j][1]); h.y = pkbf(v[j][2] * r * gv[j][2], v[j][3] * r * gv[j][3]);
      h.z = pkbf(v[j][4] * r * gv[j][4], v[j][5] * r * gv[j][5]); h.w = pkbf(v[j][6] * r * gv[j][6], v[j][7] * r * gv[j][7]);
      *(u32x4*)(H + (size_t)m * DM + 8 * lane + 512 * j) = h; }
  }
}
__device__ __forceinline__ void phase_res_norm(const bf16_t* Y, float* x, bf16_t* H, const float* gA, const float* gB, int gw, int ngw, int lane, const float* xp, const float* xs) {
  float ga_[2][8], gb_[2][8];
#pragma unroll
  for (int j = 0; j < 2; ++j) { const f32x4 g0 = *(const f32x4*)(gA + 8 * lane + 512 * j), g1 = *(const f32x4*)(gA + 8 * lane + 512 * j + 4);
    ga_[j][0] = g0.x; ga_[j][1] = g0.y; ga_[j][2] = g0.z; ga_[j][3] = g0.w; ga_[j][4] = g1.x; ga_[j][5] = g1.y; ga_[j][6] = g1.z; ga_[j][7] = g1.w;
    const float* gq = gB ? gB : gA; const f32x4 h0 = *(const f32x4*)(gq + 8 * lane + 512 * j), h1 = *(const f32x4*)(gq + 8 * lane + 512 * j + 4);
    gb_[j][0] = h0.x; gb_[j][1] = h0.y; gb_[j][2] = h0.z; gb_[j][3] = h0.w; gb_[j][4] = h1.x; gb_[j][5] = h1.y; gb_[j][6] = h1.z; gb_[j][7] = h1.w; }
  for (int m = gw; m < M_TOK; m += ngw) {
    bf16_t* xb = (bf16_t*)((char*)x + (size_t)m * 4096 + 2048);
    float y[2][8], v[2][8];
#pragma unroll
    for (int j = 0; j < 2; ++j) { const u32x4 w = *(const u32x4*)(Y + (size_t)m * DM + 8 * lane + 512 * j);
      y[j][0] = bflo(w.x); y[j][1] = bfhi(w.x); y[j][2] = bflo(w.y); y[j][3] = bfhi(w.y); y[j][4] = bflo(w.z); y[j][5] = bfhi(w.z); y[j][6] = bflo(w.w); y[j][7] = bfhi(w.w); }
    if (xp) { const float* xsrc = (m < MH) ? xp + (size_t)m * DM : xs + (size_t)(m - MH) * DM;
#pragma unroll
      for (int j = 0; j < 2; ++j) { const f32x4 a = *(const f32x4*)(xsrc + 8 * lane + 512 * j), c = *(const f32x4*)(xsrc + 8 * lane + 512 * j + 4);
        v[j][0] = a.x; v[j][1] = a.y; v[j][2] = a.z; v[j][3] = a.w; v[j][4] = c.x; v[j][5] = c.y; v[j][6] = c.z; v[j][7] = c.w; }
    } else {
#pragma unroll
      for (int j = 0; j < 2; ++j) { const u32x4 w = *(const u32x4*)(xb + 8 * lane + 512 * j);
        v[j][0] = bflo(w.x); v[j][1] = bfhi(w.x); v[j][2] = bflo(w.y); v[j][3] = bfhi(w.y); v[j][4] = bflo(w.z); v[j][5] = bfhi(w.z); v[j][6] = bflo(w.w); v[j][7] = bfhi(w.w); }
    }
    float sy = 0.f;
#pragma unroll
    for (int j = 0; j < 2; ++j)
#pragma unroll
      for (int e = 0; e < 8; ++e) sy += y[j][e] * y[j][e];
    const float ry = rsqrtf(wave_sum(sy) * (1.f / 1024.f) + 1e-6f);
    float sv = 0.f;
#pragma unroll
    for (int j = 0; j < 2; ++j)
#pragma unroll
      for (int e = 0; e < 8; ++e) { v[j][e] += y[j][e] * ry * ga_[j][e]; sv += v[j][e] * v[j][e]; }
    if (gB) {
      const float rx = rsqrtf(wave_sum(sv) * (1.f / 1024.f) + 1e-6f);
#pragma unroll
      for (int j = 0; j < 2; ++j) {
        u32x4 w; w.x = pkbf(v[j][0], v[j][1]); w.y = pkbf(v[j][2], v[j][3]); w.z = pkbf(v[j][4], v[j][5]); w.w = pkbf(v[j][6], v[j][7]);
        *(u32x4*)(xb + 8 * lane + 512 * j) = w;
        u32x4 h; h.x = pkbf(v[j][0] * rx * gb_[j][0], v[j][1] * rx * gb_[j][1]); h.y = pkbf(v[j][2] * rx * gb_[j][2], v[j][3] * rx * gb_[j][3]); h.z = pkbf(v[j][4] * rx * gb_[j][4], v[j][5] * rx * gb_[j][5]); h.w = pkbf(v[j][6] * rx * gb_[j][6], v[j][7] * rx * gb_[j][7]);
        *(u32x4*)(H + (size_t)m * DM + 8 * lane + 512 * j) = h; }
    } else {
#pragma unroll
      for (int j = 0; j < 2; ++j) { *(f32x4*)(x + (size_t)m * DM + 8 * lane + 512 * j) = (f32x4){v[j][0], v[j][1], v[j][2], v[j][3]}; *(f32x4*)(x + (size_t)m * DM + 8 * lane + 512 * j + 4) = (f32x4){v[j][4], v[j][5], v[j][6], v[j][7]}; }
    }
  }
}

__device__ __forceinline__ void rope_seg(bf16_t* pp, int pos, float sc, const float* rope, int lane) {
  u32x4 a = *(const u32x4*)pp, b = *(const u32x4*)(pp + 8);
  float x1[8] = {bflo(a.x), bfhi(a.x), bflo(a.y), bfhi(a.y), bflo(a.z), bfhi(a.z), bflo(a.w), bfhi(a.w)};
  float x2[8] = {bflo(b.x), bfhi(b.x), bflo(b.y), bfhi(b.y), bflo(b.z), bfhi(b.z), bflo(b.w), bfhi(b.w)};
  if ((lane & 3) == 0) { const float* cs = rope + (size_t)pos * 16;
#pragma unroll
    for (int i = 0; i < 8; ++i) { const float c = cs[i], s = cs[8 + i]; const float u = x1[i] * c - x2[i] * s, w = x2[i] * c + x1[i] * s; x1[i] = u; x2[i] = w; } }
  a.x = pkbf(x1[0] * sc, x1[1] * sc); a.y = pkbf(x1[2] * sc, x1[3] * sc); a.z = pkbf(x1[4] * sc, x1[5] * sc); a.w = pkbf(x1[6] * sc, x1[7] * sc);
  b.x = pkbf(x2[0] * sc, x2[1] * sc); b.y = pkbf(x2[2] * sc, x2[3] * sc); b.z = pkbf(x2[4] * sc, x2[5] * sc); b.w = pkbf(x2[6] * sc, x2[7] * sc);
  *(u32x4*)pp = a; *(u32x4*)(pp + 8) = b;
}

__device__ __forceinline__ s16x4 vtr(ldsp p) { typedef short v4i16_t __attribute__((ext_vector_type(4))); return __builtin_bit_cast(s16x4, __builtin_amdgcn_ds_read_tr16_b64_v4i16((LAS v4i16_t*)p)); }
__device__ __forceinline__ int voffa(int row, int ch) { return 2048 * (row >> 3) + 512 * (ch >> 2) + 64 * (row & 7) + 16 * ((ch & 3) ^ ((row >> 2) & 3)); }
__device__ __forceinline__ int koff(int row, int ch) { return 128 * row + ((ch ^ ((row >> 1) & 7)) << 4); }
__device__ __forceinline__ f32x16 qk_block(ldsp Kt, const int (&ko)[4], const bf16x8 (&qf)[4]) {
  f32x16 acc = {0.f, 0.f, 0.f, 0.f, 0.f, 0.f, 0.f, 0.f, 0.f, 0.f, 0.f, 0.f, 0.f, 0.f, 0.f, 0.f};
#pragma unroll
  for (int ds = 0; ds < 4; ++ds) { const bf16x8 kf = *(const LAS bf16x8*)(Kt + ko[ds]); acc = __builtin_amdgcn_mfma_f32_32x32x16_bf16(kf, qf[ds], acc, 0, 0, 0); }
  return acc;
}
__device__ __forceinline__ void k_load(bf16x8 (&kf)[4], ldsp Kt, const int (&ko)[4]) {
#pragma unroll
  for (int ds = 0; ds < 4; ++ds) kf[ds] = *(const LAS bf16x8*)(Kt + ko[ds]);
}
__device__ __forceinline__ f32x16 qk_frag(const bf16x8 (&kf)[4], const bf16x8 (&qf)[4]) {
  f32x16 acc = {0.f, 0.f, 0.f, 0.f, 0.f, 0.f, 0.f, 0.f, 0.f, 0.f, 0.f, 0.f, 0.f, 0.f, 0.f, 0.f};
#pragma unroll
  for (int ds = 0; ds < 4; ++ds) acc = __builtin_amdgcn_mfma_f32_32x32x16_bf16(kf[ds], qf[ds], acc, 0, 0, 0);
  return acc;
}
constexpr float BIGSUM = 1.0995116e12f;
template <int NDB> __device__ __forceinline__ void softmax_block(f32x16& s, float& m, float& l, f32x16 (&o)[NDB], bf16x8 (&p)[2]) {
  if (__all(m == 0.f)) {
#pragma unroll
    for (int r = 0; r < 16; ++r) s[r] = __builtin_amdgcn_exp2f(s[r]);
  } else {
#pragma unroll
    for (int r = 0; r < 16; ++r) s[r] = __builtin_amdgcn_exp2f(s[r] - m);
  }
  float sum = 0.f;
#pragma unroll
  for (int r = 0; r < 16; ++r) sum += s[r];
  const float tot = half_swap_sum(sum);
  if (__any(!(tot <= BIGSUM))) {
    float mx = s[0];
#pragma unroll
    for (int r = 1; r < 16; ++r) mx = fmaxf(mx, s[r]);
    mx = half_swap_max(mx);
    const float dl = (tot <= BIGSUM) ? 0.f : __log2f(fminf(mx, 3.0e38f)); m += dl;
    const float f = __builtin_amdgcn_exp2f(-dl); l *= f; sum *= f;
#pragma unroll
    for (int r = 0; r < 16; ++r) s[r] *= f;
#pragma unroll
    for (int d = 0; d < NDB; ++d)
#pragma unroll
      for (int r = 0; r < 16; ++r) o[d][r] *= f;
  }
  l += sum;
  u32x4 w0, w1;
  w0.x = pkbf(s[0], s[1]); w0.y = pkbf(s[2], s[3]); w0.z = pkbf(s[4], s[5]); w0.w = pkbf(s[6], s[7]);
  w1.x = pkbf(s[8], s[9]); w1.y = pkbf(s[10], s[11]); w1.z = pkbf(s[12], s[13]); w1.w = pkbf(s[14], s[15]);
  p[0] = __builtin_bit_cast(bf16x8, w0); p[1] = __builtin_bit_cast(bf16x8, w1);
}
template <int DV, bool TWO> __device__ __forceinline__ void pv_block(ldsp Vt, int vb0, int vb1, const bf16x8 (&p0)[2], const bf16x8 (&p1)[2], f32x16 (&o0)[DV / 32], f32x16 (&o1)[DV / 32]) {
  constexpr int NDB = DV / 32, NST = 2 * NDB;
#define PV_I0(i) ((DV == 128) ? 2048 * (2 * ((i) / NDB)) + 512 * ((i) % NDB) : 128 * (16 * ((i) / NDB)) + 64 * ((i) % NDB))
#define PV_I1(i) ((DV == 128) ? 2048 * (2 * ((i) / NDB) + 1) + 512 * ((i) % NDB) : 128 * (16 * ((i) / NDB) + 8) + 64 * ((i) % NDB))
#define PV_RD(dl, dh, i) do { asm volatile("ds_read_b64_tr_b16 %0, %1 offset:%c2" : "=&v"(dl) : "v"(a0), "i"(PV_I0(i)) : "memory"); \
                              asm volatile("ds_read_b64_tr_b16 %0, %1 offset:%c2" : "=&v"(dh) : "v"(a1), "i"(PV_I1(i)) : "memory"); } while (0)
  const unsigned a0 = (unsigned)(unsigned long)(Vt + vb0), a1 = (unsigned)(unsigned long)(Vt + vb1);
  s16x4 lo[2], hh[2];
  PV_RD(lo[0], hh[0], 0);
#pragma unroll
  for (int i = 0; i < NST; ++i) {
    if (i + 1 < NST) { PV_RD(lo[(i + 1) & 1], hh[(i + 1) & 1], i + 1); asm volatile("s_waitcnt lgkmcnt(2)" ::: "memory"); }
    else asm volatile("s_waitcnt lgkmcnt(0)" ::: "memory");
    __builtin_amdgcn_sched_barrier(0);
    const s16x4 l_ = lo[i & 1], h_ = hh[i & 1];
    const bf16x8 a = {l_[0], l_[1], l_[2], l_[3], h_[0], h_[1], h_[2], h_[3]};
    const int s = i / NDB, db = i % NDB;
    o0[db] = __builtin_amdgcn_mfma_f32_32x32x16_bf16(a, p0[s], o0[db], 0, 0, 0);
    if (TWO) o1[db] = __builtin_amdgcn_mfma_f32_32x32x16_bf16(a, p1[s], o1[db], 0, 0, 0);
    __builtin_amdgcn_sched_barrier(0);
  }
#undef PV_I0
#undef PV_I1
#undef PV_RD
}

__device__ __forceinline__ void sm_pv(f32x16& s, float& m, float& l, f32x16 (&oself)[4], bf16x8 (&pout)[2], ldsp Vt, int vb0, int vb1, const bf16x8 (&pin)[2], f32x16 (&oacc)[4]) {
  if (!__all(m == 0.f)) {
#pragma unroll
    for (int r = 0; r < 16; ++r) s[r] -= m;
  }
#define SP_I0(i) (2048 * (2 * ((i) / 4)) + 512 * ((i) % 4))
#define SP_I1(i) (2048 * (2 * ((i) / 4) + 1) + 512 * ((i) % 4))
#define SP_RD(dl, dh, i) do { asm volatile("ds_read_b64_tr_b16 %0, %1 offset:%c2" : "=&v"(dl) : "v"(a0), "i"(SP_I0(i)) : "memory"); \
                              asm volatile("ds_read_b64_tr_b16 %0, %1 offset:%c2" : "=&v"(dh) : "v"(a1), "i"(SP_I1(i)) : "memory"); } while (0)
  const unsigned a0 = (unsigned)(unsigned long)(Vt + vb0), a1 = (unsigned)(unsigned long)(Vt + vb1);
  s16x4 lo[2], hh[2];
  SP_RD(lo[0], hh[0], 0);
#pragma unroll
  for (int i = 0; i < 8; ++i) {
    if (i + 1 < 8) { SP_RD(lo[(i + 1) & 1], hh[(i + 1) & 1], i + 1); asm volatile("s_waitcnt lgkmcnt(2)" ::: "memory"); }
    else asm volatile("s_waitcnt lgkmcnt(0)" ::: "memory");
    __builtin_amdgcn_sched_barrier(0);
    const s16x4 l_ = lo[i & 1], h_ = hh[i & 1];
    const bf16x8 a = {l_[0], l_[1], l_[2], l_[3], h_[0], h_[1], h_[2], h_[3]};
    oacc[i % 4] = __builtin_amdgcn_mfma_f32_32x32x16_bf16(a, pin[i / 4], oacc[i % 4], 0, 0, 0);
    s[2 * i] = __builtin_amdgcn_exp2f(s[2 * i]); s[2 * i + 1] = __builtin_amdgcn_exp2f(s[2 * i + 1]);
    __builtin_amdgcn_sched_barrier(0);
  }
#undef SP_I0
#undef SP_I1
#undef SP_RD
  float sum = 0.f;
#pragma unroll
  for (int r = 0; r < 16; ++r) sum += s[r];
  const float tot = half_swap_sum(sum);
  if (__any(!(tot <= BIGSUM))) {
    float mx = s[0];
#pragma unroll
    for (int r = 1; r < 16; ++r) mx = fmaxf(mx, s[r]);
    mx = half_swap_max(mx);
    const float dl = (tot <= BIGSUM) ? 0.f : __log2f(fminf(mx, 3.0e38f)); m += dl;
    const float f = __builtin_amdgcn_exp2f(-dl); l *= f; sum *= f;
#pragma unroll
    for (int r = 0; r < 16; ++r) s[r] *= f;
#pragma unroll
    for (int d = 0; d < 4; ++d)
#pragma unroll
      for (int r = 0; r < 16; ++r) oself[d][r] *= f;
  }
  l += sum;
  u32x4 w0, w1;
  w0.x = pkbf(s[0], s[1]); w0.y = pkbf(s[2], s[3]); w0.z = pkbf(s[4], s[5]); w0.w = pkbf(s[6], s[7]);
  w1.x = pkbf(s[8], s[9]); w1.y = pkbf(s[10], s[11]); w1.z = pkbf(s[12], s[13]); w1.w = pkbf(s[14], s[15]);
  pout[0] = __builtin_bit_cast(bf16x8, w0); pout[1] = __builtin_bit_cast(bf16x8, w1);
}

__device__ __forceinline__ void sm_finish(f32x16& s, float& m, float& l, f32x16 (&oself)[4], bf16x8 (&pout)[2]) {
  float sum = 0.f;
#pragma unroll
  for (int r = 0; r < 16; ++r) sum += s[r];
  const float tot = half_swap_sum(sum);
  if (__any(!(tot <= BIGSUM))) {
    float mx = s[0];
#pragma unroll
    for (int r = 1; r < 16; ++r) mx = fmaxf(mx, s[r]);
    mx = half_swap_max(mx);
    const float dl = (tot <= BIGSUM) ? 0.f : __log2f(fminf(mx, 3.0e38f)); m += dl;
    const float f = __builtin_amdgcn_exp2f(-dl); l *= f; sum *= f;
#pragma unroll
    for (int r = 0; r < 16; ++r) s[r] *= f;
#pragma unroll
    for (int d = 0; d < 4; ++d)
#pragma unroll
      for (int r = 0; r < 16; ++r) oself[d][r] *= f;
  }
  l += sum;
  u32x4 w0, w1;
  w0.x = pkbf(s[0], s[1]); w0.y = pkbf(s[2], s[3]); w0.z = pkbf(s[4], s[5]); w0.w = pkbf(s[6], s[7]);
  w1.x = pkbf(s[8], s[9]); w1.y = pkbf(s[10], s[11]); w1.z = pkbf(s[12], s[13]); w1.w = pkbf(s[14], s[15]);
  pout[0] = __builtin_bit_cast(bf16x8, w0); pout[1] = __builtin_bit_cast(bf16x8, w1);
}
__device__ __forceinline__ void pv2_sm2(f32x16& s0, f32x16& s1, float m0, float m1, ldsp Vt, int vb0, int vb1, const bf16x8 (&p0)[2], const bf16x8 (&p1)[2], f32x16 (&o0)[4], f32x16 (&o1)[4]) {
  if (!__all((m0 == 0.f) && (m1 == 0.f))) {
#pragma unroll
    for (int r = 0; r < 16; ++r) { s0[r] -= m0; s1[r] -= m1; }
  }
#define SP_I0(i) (2048 * (2 * ((i) / 4)) + 512 * ((i) % 4))
#define SP_I1(i) (2048 * (2 * ((i) / 4) + 1) + 512 * ((i) % 4))
#define SP_RD(dl, dh, i) do { asm volatile("ds_read_b64_tr_b16 %0, %1 offset:%c2" : "=&v"(dl) : "v"(a0), "i"(SP_I0(i)) : "memory"); \
                              asm volatile("ds_read_b64_tr_b16 %0, %1 offset:%c2" : "=&v"(dh) : "v"(a1), "i"(SP_I1(i)) : "memory"); } while (0)
  const unsigned a0 = (unsigned)(unsigned long)(Vt + vb0), a1 = (unsigned)(unsigned long)(Vt + vb1);
  s16x4 lo[2], hh[2];
  SP_RD(lo[0], hh[0], 0);
#pragma unroll
  for (int i = 0; i < 8; ++i) {
    if (i + 1 < 8) { SP_RD(lo[(i + 1) & 1], hh[(i + 1) & 1], i + 1); asm volatile("s_waitcnt lgkmcnt(2)" ::: "memory"); }
    else asm volatile("s_waitcnt lgkmcnt(0)" ::: "memory");
    __builtin_amdgcn_sched_barrier(0);
    const s16x4 l_ = lo[i & 1], h_ = hh[i & 1];
    const bf16x8 a = {l_[0], l_[1], l_[2], l_[3], h_[0], h_[1], h_[2], h_[3]};
    o0[i % 4] = __builtin_amdgcn_mfma_f32_32x32x16_bf16(a, p0[i / 4], o0[i % 4], 0, 0, 0);
    s0[2 * i] = __builtin_amdgcn_exp2f(s0[2 * i]); s0[2 * i + 1] = __builtin_amdgcn_exp2f(s0[2 * i + 1]);
    __builtin_amdgcn_sched_barrier(0);
    o1[i % 4] = __builtin_amdgcn_mfma_f32_32x32x16_bf16(a, p1[i / 4], o1[i % 4], 0, 0, 0);
    s1[2 * i] = __builtin_amdgcn_exp2f(s1[2 * i]); s1[2 * i + 1] = __builtin_amdgcn_exp2f(s1[2 * i + 1]);
    __builtin_amdgcn_sched_barrier(0);
  }
#undef SP_I0
#undef SP_I1
#undef SP_RD
}

__device__ __forceinline__ void pv2_sm2p(f32x16& s0, f32x16& s1, float& m0, float& l0, float& m1, float& l1, ldsp Vt, int vb0, int vb1,
                                         const bf16x8 (&p0)[2], const bf16x8 (&p1)[2], f32x16 (&o0)[4], f32x16 (&o1)[4], bf16x8 (&q0)[2], bf16x8 (&q1)[2]) {
  if (!__all((m0 == 0.f) && (m1 == 0.f))) {
#pragma unroll
    for (int r = 0; r < 16; ++r) { s0[r] -= m0; s1[r] -= m1; }
  }
#define SP_I0(i) (2048 * (2 * ((i) / 4)) + 512 * ((i) % 4))
#define SP_I1(i) (2048 * (2 * ((i) / 4) + 1) + 512 * ((i) % 4))
#define SP_RD(dl, dh, i) do { asm volatile("ds_read_b64_tr_b16 %0, %1 offset:%c2" : "=&v"(dl) : "v"(a0), "i"(SP_I0(i)) : "memory"); \
                              asm volatile("ds_read_b64_tr_b16 %0, %1 offset:%c2" : "=&v"(dh) : "v"(a1), "i"(SP_I1(i)) : "memory"); } while (0)
  const unsigned a0 = (unsigned)(unsigned long)(Vt + vb0), a1 = (unsigned)(unsigned long)(Vt + vb1);
  s16x4 lo[2], hh[2];
  unsigned w0[8], w1[8];
  float sum0 = 0.f, sum1 = 0.f;
  SP_RD(lo[0], hh[0], 0);
#pragma unroll
  for (int i = 0; i < 8; ++i) {
    if (i + 1 < 8) { SP_RD(lo[(i + 1) & 1], hh[(i + 1) & 1], i + 1); asm volatile("s_waitcnt lgkmcnt(2)" ::: "memory"); }
    else asm volatile("s_waitcnt lgkmcnt(0)" ::: "memory");
    __builtin_amdgcn_sched_barrier(0);
    const s16x4 l_ = lo[i & 1], h_ = hh[i & 1];
    const bf16x8 a = {l_[0], l_[1], l_[2], l_[3], h_[0], h_[1], h_[2], h_[3]};
    o0[i % 4] = __builtin_amdgcn_mfma_f32_32x32x16_bf16(a, p0[i / 4], o0[i % 4], 0, 0, 0);
    { const float e0 = __builtin_amdgcn_exp2f(s0[2 * i]), e1 = __builtin_amdgcn_exp2f(s0[2 * i + 1]); sum0 += e0; sum0 += e1; w0[i] = pkbf(e0, e1); }
    __builtin_amdgcn_sched_barrier(0);
    o1[i % 4] = __builtin_amdgcn_mfma_f32_32x32x16_bf16(a, p1[i / 4], o1[i % 4], 0, 0, 0);
    { const float e0 = __builtin_amdgcn_exp2f(s1[2 * i]), e1 = __builtin_amdgcn_exp2f(s1[2 * i + 1]); sum1 += e0; sum1 += e1; w1[i] = pkbf(e0, e1); }
    __builtin_amdgcn_sched_barrier(0);
  }
#undef SP_I0
#undef SP_I1
#undef SP_RD
  const float tot0 = half_swap_sum(sum0), tot1 = half_swap_sum(sum1);
  if (__any(!(tot0 <= BIGSUM) || !(tot1 <= BIGSUM))) {
    float mx0 = 0.f, mx1 = 0.f;
#pragma unroll
    for (int i = 0; i < 8; ++i) { mx0 = fmaxf(mx0, fmaxf(bflo(w0[i]), bfhi(w0[i]))); mx1 = fmaxf(mx1, fmaxf(bflo(w1[i]), bfhi(w1[i]))); }
    mx0 = half_swap_max(mx0); mx1 = half_swap_max(mx1);
    const float d0 = (tot0 <= BIGSUM) ? 0.f : __log2f(fminf(mx0, 3.0e38f)), d1 = (tot1 <= BIGSUM) ? 0.f : __log2f(fminf(mx1, 3.0e38f));
    m0 += d0; m1 += d1;
    const float f0 = __builtin_amdgcn_exp2f(-d0), f1 = __builtin_amdgcn_exp2f(-d1); l0 *= f0; l1 *= f1; sum0 *= f0; sum1 *= f1;
#pragma unroll
    for (int i = 0; i < 8; ++i) { w0[i] = pkbf(bflo(w0[i]) * f0, bfhi(w0[i]) * f0); w1[i] = pkbf(bflo(w1[i]) * f1, bfhi(w1[i]) * f1); }
#pragma unroll
    for (int d = 0; d < 4; ++d)
#pragma unroll
      for (int r = 0; r < 16; ++r) { o0[d][r] *= f0; o1[d][r] *= f1; }
  }
  l0 += sum0; l1 += sum1;
  q0[0] = __builtin_bit_cast(bf16x8, (u32x4){w0[0], w0[1], w0[2], w0[3]}); q0[1] = __builtin_bit_cast(bf16x8, (u32x4){w0[4], w0[5], w0[6], w0[7]});
  q1[0] = __builtin_bit_cast(bf16x8, (u32x4){w1[0], w1[1], w1[2], w1[3]}); q1[1] = __builtin_bit_cast(bf16x8, (u32x4){w1[4], w1[5], w1[6], w1[7]});
}

__device__ __forceinline__ void diff_unit(ldsp lds, const bf16_t* Q, const bf16_t* K, const bf16_t* V, bf16_t* O, int tok0, int S, int h, int qb, float lam, float osc, const float* subg) {
  const int tid = fresh_tid(), lane = tid & 63, wid = tid >> 6, r32 = lane & 31, hi = lane >> 5;
  const int NT = S / 64;
  const bf16_t* kbase = K + (size_t)tok0 * DM + 128 * h; const bf16_t* vbase = V + (size_t)tok0 * DM + 128 * h;
#define DIFF_DMA(t, bo) do { const int ln_ = fresh_tid() & 63, wv_ = __builtin_amdgcn_readfirstlane(fresh_tid() >> 6); \
    { const int row_ = 8 * wv_ + (ln_ >> 3), ch_ = (ln_ & 7) ^ ((row_ >> 1) & 7); const bf16_t* g_ = kbase + (size_t)((t) * 64 + row_) * DM + 8 * ch_; \
      __builtin_amdgcn_global_load_lds((const unsigned*)g_, (LAS unsigned*)(lds + (bo) + 1024 * wv_), 16, 0, 0); \
      __builtin_amdgcn_global_load_lds((const unsigned*)(g_ + 64), (LAS unsigned*)(lds + (bo) + 8192 + 1024 * wv_), 16, 0, 0); } \
    _Pragma("unroll") for (int hq_ = 0; hq_ < 2; ++hq_) { const int o_ = 1024 * hq_ + 16 * ln_, row_ = 8 * wv_ + ((o_ >> 6) & 7), ch_ = 4 * (o_ >> 9) + (((o_ >> 4) & 3) ^ ((row_ >> 2) & 3)); \
      __builtin_amdgcn_global_load_lds((const unsigned*)(vbase + (size_t)((t) * 64 + row_) * DM + 8 * ch_), (LAS unsigned*)(lds + (bo) + 16384 + 2048 * wv_ + 1024 * hq_), 16, 0, 0); } } while (0)
  DIFF_DMA(0, 0);
  const size_t qrow = (size_t)(tok0 + 256 * qb + 32 * wid + r32) * DM;
  bf16x8 q0[4], q1[4];
#pragma unroll
  for (int ds = 0; ds < 4; ++ds) { q0[ds] = *(const bf16x8*)(Q + qrow + (2 * h) * 64 + 16 * ds + 8 * hi); q1[ds] = *(const bf16x8*)(Q + qrow + (2 * h + 1) * 64 + 16 * ds + 8 * hi); }
  f32x16 o0[4], o1[4];
#pragma unroll
  for (int d = 0; d < 4; ++d)
#pragma unroll
    for (int r = 0; r < 16; ++r) { o0[d][r] = 0.f; o1[d][r] = 0.f; }
  float m0 = 0.f, l0 = 0.f, m1 = 0.f, l1 = 0.f;
  int ko[4];
#pragma unroll
  for (int ds = 0; ds < 4; ++ds) ko[ds] = 128 * r32 + (((2 * ds + hi) ^ ((r32 >> 1) & 7)) << 4);
  const int q4 = (lane & 15) >> 2, p4 = lane & 3, gi = (lane >> 4) & 1;
  int vb0 = 64 * (4 * hi + q4) + 16 * ((2 * gi + (p4 >> 1)) ^ hi) + 8 * (p4 & 1);
  int vb1 = 64 * (4 * hi + q4) + 16 * ((2 * gi + (p4 >> 1)) ^ (2 + hi)) + 8 * (p4 & 1);
  __syncthreads();
  bf16x8 pa[2], pb[2];
  pb[0] = (bf16x8){0, 0, 0, 0, 0, 0, 0, 0}; pb[1] = pb[0]; pa[0] = pb[0]; pa[1] = pb[0];
  int bcur = 0, bnext = 32768;
  ldsp prevV = lds + 16384;
#pragma unroll 1
  for (int t = 0; t < NT; ++t) {
    asm volatile("" : "+v"(ko[0]), "+v"(ko[1]), "+v"(ko[2]), "+v"(ko[3]), "+v"(vb0), "+v"(vb1));
    if (t + 1 < NT) DIFF_DMA(t + 1, bnext);
    ldsp base = lds + bcur;
    {
      f32x16 sc0 = qk_block(base, ko, q0);
      __builtin_amdgcn_sched_barrier(0);
      f32x16 sc1 = qk_block(base + 8192, ko, q1);
      __builtin_amdgcn_sched_barrier(0);
      bf16x8 pc[2], pd[2];
      pv2_sm2p(sc0, sc1, m0, l0, m1, l1, prevV, vb0, vb1, pa, pb, o0, o1, pc, pd);
      sc0 = qk_block(base + 4096, ko, q0);
      __builtin_amdgcn_sched_barrier(0);
      sc1 = qk_block(base + 8192 + 4096, ko, q1);
      __builtin_amdgcn_sched_barrier(0);
      pv2_sm2p(sc0, sc1, m0, l0, m1, l1, base + 16384, vb0, vb1, pc, pd, o0, o1, pa, pb);
      prevV = base + 16384 + 8192;
    }
    __syncthreads();
    bcur = bnext; bnext = (bnext == 65536) ? 0 : bnext + 32768;
  }
  pv_block<128, true>(prevV, vb0, vb1, pa, pb, o0, o1);
  __syncthreads();
#undef DIFF_DMA
  l0 = half_swap_sum(l0); l1 = half_swap_sum(l1);
  const float i0 = 1.f / l0, i1 = lam / l1;
  float ssq = 0.f;
#pragma unroll
  for (int d = 0; d < 4; ++d)
#pragma unroll
    for (int r = 0; r < 16; ++r) { const float v = o0[d][r] * i0 - o1[d][r] * i1; o0[d][r] = v; ssq += v * v; }
  ssq = half_swap_sum(ssq);
  const float rs = rsqrtf(ssq * (1.f / 128.f) + 1e-5f) * osc;
  bf16_t* orow = O + (size_t)(tok0 + 256 * qb + 32 * (fresh_tid() >> 6) + (fresh_tid() & 31)) * DM + 128 * h;
#pragma unroll
  for (int d = 0; d < 4; ++d)
#pragma unroll
    for (int g4 = 0; g4 < 4; ++g4) { const int dd = 32 * d + 8 * g4 + 4 * hi; const f32x4 gg = *(const f32x4*)(subg + dd);
      u32x2 w; w.x = pkbf(o0[d][4 * g4] * rs * gg.x, o0[d][4 * g4 + 1] * rs * gg.y); w.y = pkbf(o0[d][4 * g4 + 2] * rs * gg.z, o0[d][4 * g4 + 3] * rs * gg.w);
      *(u32x2*)(orow + dd) = w; }
}
__device__ __forceinline__ void phase_diff_attn(ldsp lds, const bf16_t* Q, const bf16_t* K, const bf16_t* V, bf16_t* O, const float* lamv, const float* subg, float lam_init, float osc_l) {
  const int lane = fresh_tid() & 63;
  const float t0 = wave_sum(lamv[lane] * lamv[64 + lane]), t1 = wave_sum(lamv[128 + lane] * lamv[192 + lane]);
  const float lam = __expf(t0) - __expf(t1) + lam_init;
  const int G = gridDim.x, bx = blockIdx.x;
  const bool xmap = (G == 256); const int x = bx & 7, c = bx >> 3;
  const int nu = xmap ? 8 : (2048 - bx + G - 1) / G;
#pragma unroll 1
  for (int i = 0; i < nu; ++i) {
    int bh, qb, S, tok0;
    if (xmap) { if (i < 4) { bh = 4 * x + i; qb = c; S = 8192; tok0 = (bh >> 3) * 8192; } else { bh = 8 * x + 2 * (i - 4) + (c >> 4); qb = c & 15; S = 4096; tok0 = MH + (bh >> 3) * 4096; } }
    else { const int u = bx + i * G; if (u < 1024) { bh = u >> 5; qb = u & 31; S = 8192; tok0 = (bh >> 3) * 8192; } else { const int v = u - 1024; bh = v >> 4; qb = v & 15; S = 4096; tok0 = MH + (bh >> 3) * 4096; } }
    diff_unit(lds, Q, K, V, O, tok0, S, bh & 7, qb, lam, osc_l, subg);
  }
}

__device__ __forceinline__ void dil_unit(ldsp lds, bf16_t* QKV, float* LSE, int half, int u) {
  const int tid = fresh_tid(), lane = tid & 63, wid = tid >> 6, r32 = lane & 31, hi = lane >> 5;
  const int g = u / 2048, rem = u % 2048, head = rem & 15, blk = rem >> 4;
  const int S = half ? 4096 : 8192, nbs = S / 256, seq = blk / nbs, wi = blk % nbs;
  const int dsh = 2 * g, dil = 1 << dsh, L = S >> dsh, nq = L / 256, r = wi / nq, qb = wi % nq, m0 = 256 * qb;
  const int seqrow = seq * S;
  const int colq = g * 3072 + head * 64, colk = colq + 1024, colv = colq + 2048;
  ldsp Kt = lds, Vt = lds + 49152;
#pragma unroll
  for (int i = 0; i < 6; ++i) { const int idx = tid + 512 * i, j = idx >> 3, ch = idx & 7, mk = m0 - 64 + j;
    u32x4 kv = {0u, 0u, 0u, 0u}, vv = {0u, 0u, 0u, 0u};
    if (mk >= 0 && mk < L) { const size_t rowo = (size_t)(seqrow + mk * dil + r) * 9216; kv = *(const u32x4*)(QKV + rowo + colk + 8 * ch); vv = *(const u32x4*)(QKV + rowo + colv + 8 * ch); }
    *(LAS u32x4*)(Kt + koff(j, ch)) = kv; *(LAS u32x4*)(Vt + 128 * j + 16 * ch) = vv; }
  const int mq = m0 + 32 * wid + r32; const size_t qrowo = (size_t)(seqrow + mq * dil + r) * 9216 + colq;
  bf16x8 qf[4];
#pragma unroll
  for (int ds = 0; ds < 4; ++ds) qf[ds] = *(const bf16x8*)(QKV + qrowo + 16 * ds + 8 * hi);
  f32x16 o[2];
#pragma unroll
  for (int d = 0; d < 2; ++d)
#pragma unroll
    for (int rr = 0; rr < 16; ++rr) o[d][rr] = 0.f;
  float m = 0.f, l = 0.f;
  int ko[4];
#pragma unroll
  for (int ds = 0; ds < 4; ++ds) ko[ds] = 128 * r32 + (((2 * ds + hi) ^ ((r32 >> 1) & 7)) << 4);
  const int q4 = (lane & 15) >> 2, p4 = lane & 3, gi = (lane >> 4) & 1;
  const int vb = 128 * (4 * hi + q4) + 32 * gi + 8 * p4;
  __syncthreads();
#pragma unroll 1
  for (int b = 0; b < 5; ++b) {
    const int kr0 = 32 * wid + 32 * b;
    f32x16 s = qk_block(Kt + 128 * kr0, ko, qf);
#pragma unroll
    for (int rr = 0; rr < 16; ++rr) { const int kvr = (rr & 3) + 8 * (rr >> 2) + 4 * hi; const int mk = m0 - 64 + kr0 + kvr; const int dlt = mk - mq;
      const bool ok = (dlt >= -64) && (dlt <= 64) && (mk >= 0) && (mk < L); s[rr] = ok ? s[rr] : -INFINITY; }
    bf16x8 p[2];
    softmax_block<2>(s, m, l, o, p);
    pv_block<64, false>(Vt + 128 * kr0, vb, vb, p, p, o, o);
  }
  l = half_swap_sum(l);
  const float il = 1.f / l;
  bf16_t* orow = QKV + qrowo;
#pragma unroll
  for (int d = 0; d < 2; ++d)
#pragma unroll
    for (int g4 = 0; g4 < 4; ++g4) { const int dd = 32 * d + 8 * g4 + 4 * hi;
      u32x2 w; w.x = pkbf(o[d][4 * g4] * il, o[d][4 * g4 + 1] * il); w.y = pkbf(o[d][4 * g4 + 2] * il, o[d][4 * g4 + 3] * il);
      *(u32x2*)(orow + dd) = w; }
  if (hi == 0) LSE[((size_t)g * MH + (seqrow + mq * dil + r)) * 16 + head] = m + __log2f(l);
  __syncthreads();
}
__device__ __forceinline__ void phase_dil_combine(const bf16_t* QKV, const float* LSE, bf16_t* O  , int gw, int ngw, int lane) {
  for (int t = gw; t < MH; t += ngw) {
    const int head = lane >> 2, d0 = 16 * (lane & 3);
    float ls[3], mx = -INFINITY;
#pragma unroll
    for (int g = 0; g < 3; ++g) { ls[g] = LSE[((size_t)g * MH + t) * 16 + head]; mx = fmaxf(mx, ls[g]); }
    float w[3], ws = 0.f;
#pragma unroll
    for (int g = 0; g < 3; ++g) { w[g] = __builtin_amdgcn_exp2f(ls[g] - mx); ws += w[g]; }
    const float iw = 1.f / ws; float acc[16];
#pragma unroll
    for (int i = 0; i < 16; ++i) acc[i] = 0.f;
#pragma unroll
    for (int g = 0; g < 3; ++g) { const bf16_t* p = QKV + (size_t)t * 9216 + g * 3072 + head * 64 + d0; const u32x4 a = *(const u32x4*)p, b = *(const u32x4*)(p + 8); const float wg = w[g] * iw;
      acc[0] += wg * bflo(a.x); acc[1] += wg * bfhi(a.x); acc[2] += wg * bflo(a.y); acc[3] += wg * bfhi(a.y); acc[4] += wg * bflo(a.z); acc[5] += wg * bfhi(a.z); acc[6] += wg * bflo(a.w); acc[7] += wg * bfhi(a.w);
      acc[8] += wg * bflo(b.x); acc[9] += wg * bfhi(b.x); acc[10] += wg * bflo(b.y); acc[11] += wg * bfhi(b.y); acc[12] += wg * bflo(b.z); acc[13] += wg * bfhi(b.z); acc[14] += wg * bflo(b.w); acc[15] += wg * bfhi(b.w); }
    u32x4 a, b; a.x = pkbf(acc[0], acc[1]); a.y = pkbf(acc[2], acc[3]); a.z = pkbf(acc[4], acc[5]); a.w = pkbf(acc[6], acc[7]);
    b.x = pkbf(acc[8], acc[9]); b.y = pkbf(acc[10], acc[11]); b.z = pkbf(acc[12], acc[13]); b.w = pkbf(acc[14], acc[15]);
    bf16_t* op = O + (size_t)t * DM + head * 64 + d0; *(u32x4*)op = a; *(u32x4*)(op + 8) = b;
  }
}

__device__ __forceinline__ void phase_hgrn_gates(bf16_t* QF, int gt, int ngt) {
  const size_t total = (size_t)M_TOK * 384;
  for (size_t it = gt; it < total; it += ngt) {
    const int row = (int)(it / 384), c8 = (int)(it % 384); bf16_t* p = QF + (size_t)row * 5120 + 8 * c8; const bool isq = c8 < 128;
    u32x4 a = *(const u32x4*)p; float v[8] = {bflo(a.x), bfhi(a.x), bflo(a.y), bfhi(a.y), bflo(a.z), bfhi(a.z), bflo(a.w), bfhi(a.w)};
#pragma unroll
    for (int i = 0; i < 8; ++i) { const float z = v[i]; v[i] = isq ? z / (1.f + __expf(-z)) * 0.08838834764831845f : 1.f / (1.f + __expf(z)); }
    a.x = pkbf(v[0], v[1]); a.y = pkbf(v[2], v[3]); a.z = pkbf(v[4], v[5]); a.w = pkbf(v[6], v[7]); *(u32x4*)p = a;
  }
}
__device__ __forceinline__ int rowimg(int row, int ch) { return 256 * row + ((ch ^ (row & 15)) << 4); }
__device__ __forceinline__ void hgrn_chain(ldsp lds, const bf16_t* QF, bf16_t* Ofw, bf16_t* Obw, const float* oml, int c) {
  const int tid = fresh_tid(), lane = tid & 63, wid = tid >> 6, r32 = lane & 31, hi = lane >> 5;
  const int dir = c & 1, head = (c >> 1) & 7, sq = c >> 4;
  const int T = (sq < 4) ? 8192 : 4096, NC = T / 64; const int seqrow = (sq < 4) ? sq * 8192 : MH + (sq - 4) * 4096;
  bf16_t* Od = dir ? Obw : Ofw;
  constexpr int RAWQ = 0, RAWS = 16384, IMG_V = 32768, IMG_QT = 49152, IMG_KT = 65536, IMG_KH = 81920, OUTB = 98304, TOT = 114688, DEC = 118784;
  const int vblk = wid & 3, tblk = wid >> 2;
  const int kp = tid & 63, e8 = tid >> 6;
  const float om0 = oml[head * 128 + 2 * kp], om1 = oml[head * 128 + 2 * kp + 1];
  f32x16 Sacc[4];
#pragma unroll
  for (int kb = 0; kb < 4; ++kb)
#pragma unroll
    for (int r = 0; r < 16; ++r) Sacc[kb][r] = 0.f;
  const int lrow = tid >> 4, c16 = tid & 15;
  const int qcol = head * 128 + 8 * c16, fcol = 1024 + dir * 1024 + head * 128 + 8 * c16, vcol = 3072 + head * 128 + 8 * c16;
  u32x4 pq0, pq1, ps0, ps1, pv0, pv1;
#define HG_LOAD(n) do { const int t0_ = dir ? T - 64 * ((n) + 1) : 64 * (n); const int ra_ = dir ? 63 - lrow : lrow, rb_ = dir ? 31 - lrow : lrow + 32; \
    const bf16_t* pa_ = QF + (size_t)(seqrow + t0_ + ra_) * 5120; const bf16_t* pb_ = QF + (size_t)(seqrow + t0_ + rb_) * 5120; \
    pq0 = *(const u32x4*)(pa_ + qcol); pq1 = *(const u32x4*)(pb_ + qcol); ps0 = *(const u32x4*)(pa_ + fcol); ps1 = *(const u32x4*)(pb_ + fcol); pv0 = *(const u32x4*)(pa_ + vcol); pv1 = *(const u32x4*)(pb_ + vcol); } while (0)
#define HG_STORE() do { *(LAS u32x4*)(lds + RAWQ + 256 * lrow + 16 * c16) = pq0; *(LAS u32x4*)(lds + RAWQ + 256 * (lrow + 32) + 16 * c16) = pq1; \
    *(LAS u32x4*)(lds + RAWS + 256 * lrow + 16 * c16) = ps0; *(LAS u32x4*)(lds + RAWS + 256 * (lrow + 32) + 16 * c16) = ps1; \
    *(LAS u32x4*)(lds + IMG_V + voffa(lrow, c16)) = pv0; *(LAS u32x4*)(lds + IMG_V + voffa(lrow + 32, c16)) = pv1; } while (0)
  const int q4 = (lane & 15) >> 2, p4 = lane & 3, gi = (lane >> 4) & 1;
  const int vbp0 = 64 * (4 * hi + q4) + 16 * ((2 * gi + (p4 >> 1)) ^ hi) + 8 * (p4 & 1), vbp1 = 64 * (4 * hi + q4) + 16 * ((2 * gi + (p4 >> 1)) ^ (2 + hi)) + 8 * (p4 & 1);
  const int nb0 = 2048 * hi + 64 * q4 + 16 * ((2 * gi + (p4 >> 1)) ^ (2 * hi)) + 8 * (p4 & 1), nb1 = 2048 * hi + 64 * q4 + 16 * ((2 * gi + (p4 >> 1)) ^ (2 * hi + 1)) + 8 * (p4 & 1);
  HG_LOAD(0); HG_STORE(); __syncthreads();
#pragma unroll 1
  for (int n = 0; n < NC; ++n) {
    if (n + 1 < NC) HG_LOAD(n + 1);
    float kk0[8], kk1[8], g0[8], g1[8]; float c0 = 0.f, c1 = 0.f;
#pragma unroll
    for (int i = 0; i < 8; ++i) { const int row = 8 * e8 + i; const unsigned sw = *(const LAS unsigned*)(lds + RAWS + 256 * row + 4 * kp);
      kk0[i] = om0 * bflo(sw); kk1[i] = om1 * bfhi(sw); c0 += __log2f(1.f - kk0[i]); c1 += __log2f(1.f - kk1[i]); g0[i] = c0; g1[i] = c1; }
    *(LAS f32x2*)(lds + TOT + (e8 * 128 + 2 * kp) * 4) = (f32x2){c0, c1};
    __syncthreads();
    float off0 = 0.f, off1 = 0.f, ge0 = 0.f, ge1 = 0.f;
#pragma unroll
    for (int e = 0; e < 8; ++e) { const f32x2 t = *(const LAS f32x2*)(lds + TOT + (e * 128 + 2 * kp) * 4); ge0 += t.x; ge1 += t.y; if (e < e8) { off0 += t.x; off1 += t.y; } }
#pragma unroll
    for (int i = 0; i < 8; ++i) { const int row = 8 * e8 + i; const float G0 = off0 + g0[i], G1 = off1 + g1[i];
      const unsigned qw = *(const LAS unsigned*)(lds + RAWQ + 256 * row + 4 * kp);
      const float eq0 = __builtin_amdgcn_exp2f(G0), eq1 = __builtin_amdgcn_exp2f(G1), ek0 = __builtin_amdgcn_exp2f(-G0), ek1 = __builtin_amdgcn_exp2f(-G1);
      const float eh0 = __builtin_amdgcn_exp2f(ge0 - G0), eh1 = __builtin_amdgcn_exp2f(ge1 - G1);
      const int ro = rowimg(row, kp >> 2) + 4 * (kp & 3);
      *(LAS unsigned*)(lds + IMG_QT + ro) = pkbf(bflo(qw) * eq0, bfhi(qw) * eq1);
      *(LAS unsigned*)(lds + IMG_KT + ro) = pkbf(kk0[i] * ek0, kk1[i] * ek1);
      *(LAS unsigned*)(lds + IMG_KH + voffa(row, kp >> 2) + 4 * (kp & 3)) = pkbf(kk0[i] * eh0, kk1[i] * eh1); }
    if (e8 == 7) *(LAS f32x2*)(lds + DEC + 8 * kp) = (f32x2){__builtin_amdgcn_exp2f(ge0), __builtin_amdgcn_exp2f(ge1)};
    __syncthreads();
    bf16x8 px[2][2];
#pragma unroll
    for (int sb = 0; sb < 2; ++sb) {
      if (sb <= tblk) {
        f32x16 X;
#pragma unroll
        for (int r = 0; r < 16; ++r) X[r] = 0.f;
#pragma unroll
        for (int ds = 0; ds < 8; ++ds) { const bf16x8 a = *(const LAS bf16x8*)(lds + IMG_KT + rowimg(32 * sb + r32, 2 * ds + hi)), bq = *(const LAS bf16x8*)(lds + IMG_QT + rowimg(32 * tblk + r32, 2 * ds + hi));
          X = __builtin_amdgcn_mfma_f32_32x32x16_bf16(a, bq, X, 0, 0, 0); }
        if (sb == tblk) {
#pragma unroll
          for (int r = 0; r < 16; ++r) { const int sl = (r & 3) + 8 * (r >> 2) + 4 * hi; X[r] = (sl <= r32) ? X[r] : 0.f; } }
        u32x4 w0, w1;
        w0.x = pkbf(X[0], X[1]); w0.y = pkbf(X[2], X[3]); w0.z = pkbf(X[4], X[5]); w0.w = pkbf(X[6], X[7]);
        w1.x = pkbf(X[8], X[9]); w1.y = pkbf(X[10], X[11]); w1.z = pkbf(X[12], X[13]); w1.w = pkbf(X[14], X[15]);
        px[sb][0] = __builtin_bit_cast(bf16x8, w0); px[sb][1] = __builtin_bit_cast(bf16x8, w1);
      } else { px[sb][0] = (bf16x8){0, 0, 0, 0, 0, 0, 0, 0}; px[sb][1] = px[sb][0]; }
    }
    f32x16 acc;
#pragma unroll
    for (int r = 0; r < 16; ++r) acc[r] = 0.f;
#pragma unroll
    for (int sb = 0; sb < 2; ++sb)
#pragma unroll
      for (int s2 = 0; s2 < 2; ++s2) {
        const s16x4 lo = vtr(lds + IMG_V + vbp0 + 2048 * (4 * sb + 2 * s2) + 512 * vblk), hh = vtr(lds + IMG_V + vbp1 + 2048 * (4 * sb + 2 * s2 + 1) + 512 * vblk);
        const bf16x8 a = {lo[0], lo[1], lo[2], lo[3], hh[0], hh[1], hh[2], hh[3]};
        acc = __builtin_amdgcn_mfma_f32_32x32x16_bf16(a, px[sb][s2], acc, 0, 0, 0);
      }
#pragma unroll
    for (int kb = 0; kb < 4; ++kb)
#pragma unroll
      for (int s2 = 0; s2 < 2; ++s2) {
        u32x4 w; w.x = pkbf(Sacc[kb][8 * s2 + 0], Sacc[kb][8 * s2 + 1]); w.y = pkbf(Sacc[kb][8 * s2 + 2], Sacc[kb][8 * s2 + 3]); w.z = pkbf(Sacc[kb][8 * s2 + 4], Sacc[kb][8 * s2 + 5]); w.w = pkbf(Sacc[kb][8 * s2 + 6], Sacc[kb][8 * s2 + 7]);
        const u32x2 b0 = *(const LAS u32x2*)(lds + IMG_QT + rowimg(32 * tblk + r32, 4 * kb + 2 * s2) + 8 * hi), b1 = *(const LAS u32x2*)(lds + IMG_QT + rowimg(32 * tblk + r32, 4 * kb + 2 * s2 + 1) + 8 * hi);
        const u32x4 bw = {b0.x, b0.y, b1.x, b1.y};
        acc = __builtin_amdgcn_mfma_f32_32x32x16_bf16(__builtin_bit_cast(bf16x8, w), __builtin_bit_cast(bf16x8, bw), acc, 0, 0, 0);
      }
#pragma unroll
    for (int g4 = 0; g4 < 4; ++g4) { u32x2 w; w.x = pkbf(acc[4 * g4], acc[4 * g4 + 1]); w.y = pkbf(acc[4 * g4 + 2], acc[4 * g4 + 3]);
      *(LAS u32x2*)(lds + OUTB + rowimg(32 * tblk + r32, 4 * vblk + g4) + 8 * hi) = w; }
#pragma unroll
    for (int kb = 0; kb < 4; ++kb) {
#pragma unroll
      for (int g4 = 0; g4 < 4; ++g4) { const f32x4 d = *(const LAS f32x4*)(lds + DEC + 4 * (32 * kb + 8 * g4 + 4 * hi));
        Sacc[kb][4 * g4] *= d.x; Sacc[kb][4 * g4 + 1] *= d.y; Sacc[kb][4 * g4 + 2] *= d.z; Sacc[kb][4 * g4 + 3] *= d.w; }
#pragma unroll
      for (int s4 = 0; s4 < 4; ++s4) {
        const s16x4 a0 = vtr(lds + IMG_KH + nb0 + 4096 * s4 + 512 * kb), a1 = vtr(lds + IMG_KH + nb1 + 4096 * s4 + 256 + 512 * kb);
        const s16x4 b0 = vtr(lds + IMG_V + nb0 + 4096 * s4 + 512 * vblk), b1 = vtr(lds + IMG_V + nb1 + 4096 * s4 + 256 + 512 * vblk);
        const bf16x8 a = {a0[0], a0[1], a0[2], a0[3], a1[0], a1[1], a1[2], a1[3]}, bb = {b0[0], b0[1], b0[2], b0[3], b1[0], b1[1], b1[2], b1[3]};
        Sacc[kb] = __builtin_amdgcn_mfma_f32_32x32x16_bf16(a, bb, Sacc[kb], 0, 0, 0);
      }
    }
    __syncthreads();
    { const int t0_ = dir ? T - 64 * (n + 1) : 64 * n;
#pragma unroll
      for (int i = 0; i < 2; ++i) { const int tau = lrow + 32 * i; const int grow = dir ? 63 - tau : tau;
        *(u32x4*)(Od + (size_t)(seqrow + t0_ + grow) * 1024 + head * 128 + 8 * c16) = *(const LAS u32x4*)(lds + OUTB + rowimg(tau, c16)); } }
    if (n + 1 < NC) HG_STORE();
    __syncthreads();
  }
#undef HG_LOAD
#undef HG_STORE
}
__device__ __forceinline__ void phase_hgrn_combine(const bf16_t* QF, const bf16_t* Ofw, const bf16_t* Obw, bf16_t* O, const float* gn, int gw, int ngw, int lane) {
  float gnv[16];
#pragma unroll
  for (int i = 0; i < 16; ++i) gnv[i] = gn[((16 * lane) & 127) + i];
  for (int t = gw; t < M_TOK; t += ngw) {
    const int c0 = 16 * lane;
    float v[16], gv[16];
    { const bf16_t* a = Ofw + (size_t)t * 1024 + c0; const bf16_t* b = Obw + (size_t)t * 1024 + c0; const bf16_t* gp = QF + (size_t)t * 5120 + 4096 + c0;
#pragma unroll
      for (int j = 0; j < 2; ++j) { const u32x4 x = *(const u32x4*)(a + 8 * j), y = *(const u32x4*)(b + 8 * j), z = *(const u32x4*)(gp + 8 * j);
        v[8 * j + 0] = bflo(x.x) + bflo(y.x); v[8 * j + 1] = bfhi(x.x) + bfhi(y.x); v[8 * j + 2] = bflo(x.y) + bflo(y.y); v[8 * j + 3] = bfhi(x.y) + bfhi(y.y);
        v[8 * j + 4] = bflo(x.z) + bflo(y.z); v[8 * j + 5] = bfhi(x.z) + bfhi(y.z); v[8 * j + 6] = bflo(x.w) + bflo(y.w); v[8 * j + 7] = bfhi(x.w) + bfhi(y.w);
        gv[8 * j + 0] = bflo(z.x); gv[8 * j + 1] = bfhi(z.x); gv[8 * j + 2] = bflo(z.y); gv[8 * j + 3] = bfhi(z.y); gv[8 * j + 4] = bflo(z.z); gv[8 * j + 5] = bfhi(z.z); gv[8 * j + 6] = bflo(z.w); gv[8 * j + 7] = bfhi(z.w); } }
    float ss = 0.f;
#pragma unroll
    for (int i = 0; i < 16; ++i) ss += v[i] * v[i];
    ss += DPPF(ss, 0xB1); ss += DPPF(ss, 0x4E); ss += DPPF(ss, 0x141);
    const float rs = rsqrtf(ss * (1.f / 128.f) + 1e-6f);
    unsigned w[8];
#pragma unroll
    for (int i = 0; i < 8; ++i) { const int d = (c0 & 127) + 2 * i; const float g0 = gv[2 * i], g1 = gv[2 * i + 1];
      (void)d; w[i] = pkbf(v[2 * i] * rs * gnv[2 * i] * (g0 / (1.f + __expf(-g0))), v[2 * i + 1] * rs * gnv[2 * i + 1] * (g1 / (1.f + __expf(-g1)))); }
    bf16_t* op = O + (size_t)t * DM + c0; *(u32x4*)op = (u32x4){w[0], w[1], w[2], w[3]}; *(u32x4*)(op + 8) = (u32x4){w[4], w[5], w[6], w[7]};
  }
}

__device__ __forceinline__ void phase_convglu(const bf16_t* U, bf16_t* G, const float* cw  , const float* cb  , int half, int gt, int ngt) {
  const size_t total = (size_t)MH * 352; const int S = half ? 4096 : 8192;
  for (size_t it = gt; it < total; it += ngt) {
    const int row = (int)(it / 352), c8 = (int)(it % 352), c = 8 * c8; const int pos = row & (S - 1);
    float a[8], b[8];
#pragma unroll
    for (int i = 0; i < 8; ++i) { a[i] = cb[c + i]; b[i] = cb[2816 + c + i]; }
#pragma unroll
    for (int tap = 0; tap < 3; ++tap) { const int pp = pos + tap - 1; if (pp < 0 || pp >= S) continue;
      const bf16_t* ur = U + (size_t)(row + tap - 1) * 5632; const u32x4 ua = *(const u32x4*)(ur + c), ub = *(const u32x4*)(ur + 2816 + c);
      const float fa[8] = {bflo(ua.x), bfhi(ua.x), bflo(ua.y), bfhi(ua.y), bflo(ua.z), bfhi(ua.z), bflo(ua.w), bfhi(ua.w)};
      const float fb[8] = {bflo(ub.x), bfhi(ub.x), bflo(ub.y), bfhi(ub.y), bflo(ub.z), bfhi(ub.z), bflo(ub.w), bfhi(ub.w)};
#pragma unroll
      for (int i = 0; i < 8; ++i) { a[i] += fa[i] * cw[tap * 5632 + c + i]; b[i] += fb[i] * cw[tap * 5632 + 2816 + c + i]; } }
    float o[8];
#pragma unroll
    for (int i = 0; i < 8; ++i) { const float x = a[i], z = 1.5957691216057308f * (x + 0.044715f * x * x * x); o[i] = x / (1.f + __expf(-z)) * b[i]; }
    u32x4 w; w.x = pkbf(o[0], o[1]); w.y = pkbf(o[2], o[3]); w.z = pkbf(o[4], o[5]); w.w = pkbf(o[6], o[7]);
    *(u32x4*)(G + (size_t)row * DFF + c) = w;
  }
}

#define XB_TMO      128
#define XB_XCNT(j)  (256  + 64 * (j))
#define XB_XSUB(j)  (1280 + 64 * (j))
#define XB_XGEN(j)  (2304 + 64 * (j))
#define XB_TOP      3328
#define XB_TOPGEN   3392
#define XCD_BAR_WORDS 3456
#define XB_SPIN_CAP (1u << 18)

__device__ __forceinline__ unsigned xb_ld(unsigned* p)              { return __hip_atomic_load(p, __ATOMIC_RELAXED, __HIP_MEMORY_SCOPE_AGENT); }
__device__ __forceinline__ unsigned xb_add(unsigned* p, unsigned v) { return __hip_atomic_fetch_add(p, v, __ATOMIC_RELAXED, __HIP_MEMORY_SCOPE_AGENT); }
__device__ __forceinline__ unsigned xb_xcc_id() { return (unsigned)__builtin_amdgcn_s_getreg((3 << 11) | 20) & 0xFu; }
#define XB_SPIN(cond, bar) do { unsigned _sp = 0; while (cond) { __builtin_amdgcn_s_sleep(1); \
    if ((++_sp & 255u) == 0u) { if (xb_ld(&(bar)[XB_TMO])) break; if (_sp > XB_SPIN_CAP) { atomicAdd(&(bar)[XB_TMO], 1u); break; } } } } while (0)

struct XcdBarrier {
    unsigned* bar; unsigned x;
    volatile LAS unsigned* st;
};

__device__ __forceinline__ XcdBarrier xcd_barrier_post(unsigned* bar, volatile LAS unsigned* st) {
    XcdBarrier b; b.bar = bar; b.x = xb_xcc_id(); b.st = st;
    if (threadIdx.x == 0) (void)xb_add(&bar[XB_XCNT(b.x)], 1u);
    return b;
}
__device__ __forceinline__ void xcd_barrier_complete(unsigned* bar, unsigned x, unsigned& nloc, unsigned& nx) {
    const unsigned G = gridDim.x * gridDim.y * gridDim.z;
    unsigned sum, cnt, mine, sp = 0u;
    for (;;) {
        sum = 0u; cnt = 0u; mine = 0u;
#pragma unroll
        for (unsigned j = 0; j < 16; ++j) { const unsigned c = xb_ld(&bar[XB_XCNT(j)]); sum += c; cnt += (c > 0u) ? 1u : 0u; mine = (j == x) ? c : mine; }
        if (sum == G) break;
        __builtin_amdgcn_s_sleep(1);
        if ((++sp & 255u) == 0u) { if (xb_ld(&bar[XB_TMO])) break; if (sp > XB_SPIN_CAP) { atomicAdd(&bar[XB_TMO], 1u); break; } }
    }
    nloc = mine > 0u ? mine : 1u; nx = cnt > 0u ? cnt : 1u;
}

__device__ __forceinline__ void xcd_barrier(const XcdBarrier& b) {
    asm volatile("s_waitcnt vmcnt(0)" ::: "memory");
    __syncthreads();
    if (threadIdx.x == 0) {
        unsigned* bar = b.bar;
        __builtin_amdgcn_s_waitcnt(0);
        unsigned nloc = b.st[0], nx = b.st[1];
        if (nloc == 0u) { xcd_barrier_complete(bar, b.x, nloc, nx); b.st[0] = nloc; b.st[1] = nx; }
        const unsigned old = xb_add(&bar[XB_XSUB(b.x)], 1u);
        const unsigned gen = old / nloc;
        if (old + 1u == (gen + 1u) * nloc) {
            __builtin_amdgcn_fence(__ATOMIC_RELEASE, "agent");
            asm volatile("s_waitcnt vmcnt(0)" ::: "memory");
            const unsigned og = xb_add(&bar[XB_TOP], 1u);
            const unsigned tg = og / nx;
            if (og + 1u == (tg + 1u) * nx) xb_add(&bar[XB_TOPGEN], 1u);
            else XB_SPIN(xb_ld(&bar[XB_TOPGEN]) == tg, bar);
            __builtin_amdgcn_fence(__ATOMIC_ACQUIRE, "agent");
            xb_add(&bar[XB_XGEN(b.x)], 1u);
            asm volatile("s_waitcnt vmcnt(0)" ::: "memory");
        } else {
            XB_SPIN(xb_ld(&bar[XB_XGEN(b.x)]) == gen, bar);
            __builtin_amdgcn_fence(__ATOMIC_ACQUIRE, "agent");
            asm volatile("s_waitcnt vmcnt(0)" ::: "memory");
        }
    }
    __syncthreads();
}

typedef pg8::EpiBf16<0> EpiP;
enum { OP_GEMM = 0, OP_ROPE_DIFF, OP_DIFF_ATTN, OP_RES_NORM, OP_ROPE_DIL, OP_DIL_ATTN, OP_DIL_COMB, OP_HG_GATES, OP_HG_SCAN, OP_HG_COMB, OP_CONVGLU, OP_GEMM_FFN, OP_END };
struct Step { int op; int half; const bf16_t* A; const bf16_t* Bt; bf16_t* O; int M, N, K, ldc, split; const bf16_t* Yin; int gA, gB; int mode, tok0; };
__device__ __forceinline__ Step get_step(int layer, int s, unsigned char* ws) {
  bf16_t* W = (bf16_t*)(ws + WS_W); bf16_t* H = (bf16_t*)(ws + WS_H); bf16_t* Y = (bf16_t*)(ws + WS_Y); bf16_t* BIG = (bf16_t*)(ws + WS_BIG);
  const int kind = layer % 3, j = layer / 3;
  Step st; st.op = OP_END; st.half = 0; st.A = H; st.Bt = W; st.O = Y; st.M = M_TOK; st.N = 1024; st.K = 1024; st.ldc = 1024; st.split = 0; st.Yin = Y; st.gA = 0; st.gB = -1; st.mode = 0; st.tok0 = 0;
  const int nmix = (kind == 0) ? 3 : (kind == 1) ? 7 : 4;
  if (s < nmix) {
    if (kind == 2) {
      if (s == 0) { st.op = OP_GEMM; st.A = H; st.Bt = W + WE_CIN; st.O = BIG; st.N = 5120; st.ldc = 5120; st.mode = 2; }
      else if (s == 1) st.op = OP_HG_SCAN;
      else if (s == 2) st.op = OP_HG_COMB;
      else { st.op = OP_GEMM; st.A = Y; st.Bt = W + WE_CO; st.O = H; }
    } else if (kind == 0) {
      if (s == 0) { st.op = OP_GEMM; st.A = H; st.Bt = W + WE_AQKV + (size_t)j * 3072 * 1024; st.O = BIG; st.N = 3072; st.split = 1024; st.mode = 1; }
      else if (s == 1) st.op = OP_DIFF_ATTN;
      else { st.op = OP_GEMM; st.A = H; st.Bt = W + WE_AO + (size_t)j * 1024 * 1024; st.O = Y; }
    } else {
      if (s == 6) { st.op = OP_GEMM; st.A = Y; st.Bt = W + WE_BO; st.O = H; }
      else { const int half = s / 3, q = s % 3; st.half = half;
        if (q == 0) { st.op = OP_GEMM; st.A = H + (size_t)half * MH * DM; st.Bt = W + WE_BQKV; st.O = BIG; st.M = MH; st.N = 9216; st.ldc = 9216; st.mode = 1; st.tok0 = half * MH; }
        else st.op = (q == 1) ? OP_DIL_ATTN : OP_DIL_COMB; }
    }
    return st;
  }
  const int f = s - nmix;
  bf16_t* U = Y; bf16_t* Gb = Y + 352ull * MiB / 2;
  if (f == 0) { st.op = OP_RES_NORM; st.Yin = (kind == 0) ? Y : H; st.gA = layer * 4 + 1; st.gB = layer * 4 + 2; }
  else if (f == 1) { st.op = OP_GEMM_FFN; st.A = H - 1024; st.Bt = W + WE_FIN + (size_t)layer * 5632 * 1024; st.O = Gb; st.M = 265 * 256; st.N = 5632; }
  else if (f == 2) { st.op = OP_GEMM; st.A = Gb; st.Bt = W + WE_FOUT + (size_t)layer * 1024 * 2816; st.O = Y; st.K = 2816; }
  else if (f == 3) { st.op = OP_RES_NORM; st.Yin = Y; st.gA = layer * 4 + 3; st.gB = (layer < 3) ? (layer + 1) * 4 : -1; }
  return st;
}

__global__ void __launch_bounds__(512) fwd_megakernel(Params p) {
  extern __shared__ __attribute__((aligned(16))) unsigned char lds_raw[];
  cg::grid_group grid = cg::this_grid();
  ldsp lds = (ldsp)lds_raw;
  const int G = gridDim.x, ngw = G * 8, ngt = G * 512;
  if (threadIdx.x < 2) *(LAS unsigned*)(lds + 131072 + 256 + 4 * threadIdx.x) = 0u;
  __syncthreads();
#define FRESH() const int tid = fresh_tid(), lane = tid & 63, wave = tid >> 6, gw = blockIdx.x * 8 + wave, gt = blockIdx.x * 512 + tid; (void)lane; (void)wave; (void)gw; (void)gt
  unsigned char* ws = kargs()->ws;
  float* x = kargs()->out;
  float* rope = (float*)(ws + WS_ROPE); float* oml = (float*)(ws + WS_OML);
  bf16_t* W = (bf16_t*)(ws + WS_W); bf16_t* H = (bf16_t*)(ws + WS_H); bf16_t* Y = (bf16_t*)(ws + WS_Y); bf16_t* BIG = (bf16_t*)(ws + WS_BIG);
#define norm_g (kargs()->in[2])

  {
    FRESH();
    LAS float* scr = (LAS float*)(lds + wave * 16384);
#pragma unroll 1
    for (int mi = 0; mi < 16; ++mi) {
      const float* src; bf16_t* dst; int K = 1024, N = 1024;
      if (mi < 2) { src = kargs()->in[3] + (size_t)mi * 1024 * 3072; dst = W + WE_AQKV + (size_t)mi * 3072 * 1024; N = 3072; }
      else if (mi < 4) { src = kargs()->in[6] + (size_t)(mi - 2) * 1024 * 1024; dst = W + WE_AO + (size_t)(mi - 2) * 1024 * 1024; }
      else if (mi == 4) { src = kargs()->in[7]; dst = W + WE_BQKV; N = 9216; }
      else if (mi == 5) { src = kargs()->in[8]; dst = W + WE_BO; }
      else if (mi == 6) { src = kargs()->in[9]; dst = W + WE_CIN; N = 5120; }
      else if (mi == 7) { src = kargs()->in[12]; dst = W + WE_CO; }
      else if (mi < 12) { src = kargs()->in[13] + (size_t)(mi - 8) * 1024 * 5632; dst = W + WE_FIN + (size_t)(mi - 8) * 5632 * 1024; N = 5632; }
      else { src = kargs()->in[16] + (size_t)(mi - 12) * 2816 * 1024; dst = W + WE_FOUT + (size_t)(mi - 12) * 1024 * 2816; K = 2816; }
      transpose_mat(src, K, N, dst, scr, gw, ngw, lane, mi >= 8 && mi < 12);
    }
    for (int i = gt; i < 8192 * 8; i += ngt) { const int pos = i >> 3, f = i & 7; const double rev = (double)pos * kargs()->invf[f] * 0.15915494309189535; const float fr = (float)(rev - floor(rev));
      rope[pos * 16 + f] = __builtin_amdgcn_cosf(fr); rope[pos * 16 + 8 + f] = __builtin_amdgcn_sinf(fr); }
    for (int i = gt; i < 1024; i += ngt) { const float* lg = kargs()->in[10]; const float a0 = lg[i], a1 = lg[1024 + i], a2 = lg[2048 + i], a3 = lg[3072 + i]; const float mx = fmaxf(fmaxf(a0, a1), fmaxf(a2, a3));
      const float e0 = __expf(a0 - mx), e1 = __expf(a1 - mx), e2 = __expf(a2 - mx), e3 = __expf(a3 - mx); oml[i] = 1.f - (e1 + e2) / (e0 + e1 + e2 + e3); }
    phase_init_norm(kargs()->in[0], kargs()->in[1], x, H, norm_g, gw, ngw, lane);
  }
  grid.sync();
  XcdBarrier xbar = xcd_barrier_post((unsigned*)(ws + WS_BAR), (volatile LAS unsigned*)(lds + 131072 + 256));

#pragma unroll 1
  for (int layer = 0; layer < 4; ++layer) {
#pragma unroll 1
#ifdef PROBE_DUP_OP
    for (int s = 0, rep_ = 0; s < 16; ) {
#else
    for (int s = 0; s < 16; ++s) {
#endif
      const Step st = get_step(layer, s, ws);
      if (st.op == OP_END) break;
#ifdef PROBE_REPEAT_OP
      for (int rep_ = 0; rep_ < ((st.op == PROBE_REPEAT_OP) ? 2 : 1); ++rep_) {
#endif
      switch (st.op) {
        case OP_GEMM: {
          pg8::EpiAct E{st.O, st.ldc, st.split, (size_t)M_TOK * DM, st.mode, rope, st.tok0, C2};
          int gM = st.M, gN = st.N, gK = st.K, gG = G, gB = (int)blockIdx.x; asm volatile("" : "+s"(gM), "+s"(gN), "+s"(gK), "+s"(gG), "+s"(gB));
          pg8::Gemm g{st.A, st.Bt, gM, gN, gK}; pg8::StaticOrder S; S.init(gM, gN, gG, gB);
          pg8::gemm_phase<pg8::EpiAct, pg8::StaticOrder, true, true>(lds, g, S, E);
        } break;
        case OP_GEMM_FFN: {
          int ly = layer; asm volatile("" : "+s"(ly));
          pg8::EpiConvGlu E{st.O, kargs()->in[14] + (size_t)ly * 3 * 5632, kargs()->in[15] + (size_t)ly * 5632};
          int gM = st.M, gN = st.N, gK = st.K, gG = G, gB = (int)blockIdx.x; asm volatile("" : "+s"(gM), "+s"(gN), "+s"(gK), "+s"(gG), "+s"(gB));
          pg8::Gemm g{st.A, st.Bt, gM, gN, gK}; pg8::StaticOrder S; S.init(gM, gN, gG, gB);
          pg8::gemm_phase<pg8::EpiConvGlu, pg8::StaticOrder, true, true, true>(lds, g, S, E);
        } break;
        case OP_ROPE_DIFF: { FRESH(); bf16_t* Qb = BIG; bf16_t* Kb = BIG + (size_t)M_TOK * DM;
          for (int it = gw; it < M_TOK * 2; it += ngw) { const int row = it >> 1, sg = it & 1; const int pos = (row < MH) ? (row & 8191) : (row & 4095);
            rope_seg((sg ? Kb : Qb) + (size_t)row * DM + 16 * lane, pos, sg ? 1.f : C2, rope, lane); } } break;
        case OP_DIFF_ATTN: { int ly = layer; asm volatile("" : "+s"(ly)); const int j = ly / 3; const float lam_init = __builtin_bit_cast(float, (ly == 0) ? 0x3e4ccccd : 0x3f0e59d5), osc_l = __builtin_bit_cast(float, (ly == 0) ? 0x3f4ccccd : 0x3ee34c57);
          phase_diff_attn(lds, BIG, BIG + (size_t)M_TOK * DM, BIG + 2 * (size_t)M_TOK * DM, H, kargs()->in[4] + j * 256, kargs()->in[5] + j * 128, lam_init, osc_l); } break;
        case OP_RES_NORM: { FRESH(); const bool first_ = (st.gA == 1); phase_res_norm(st.Yin, x, H, norm_g + st.gA * 1024, st.gB >= 0 ? norm_g + st.gB * 1024 : nullptr, gw, ngw, lane, first_ ? kargs()->in[0] : nullptr, first_ ? kargs()->in[1] : nullptr); } break;
        case OP_ROPE_DIL: { FRESH();
          for (int it = gw; it < MH * 6; it += ngw) { const int row = it / 6, sg = it % 6; const int tok = st.half * MH + row; const int pos = (tok < MH) ? (tok & 8191) : (tok & 4095);
            rope_seg(BIG + (size_t)row * 9216 + (sg >> 1) * 3072 + (sg & 1) * 1024 + 16 * lane, pos, (sg & 1) ? 1.f : C2, rope, lane); } } break;
        case OP_DIL_ATTN: { float* LSE = (float*)(BIG + (size_t)MH * 9216);
#pragma unroll 1
          for (int u = blockIdx.x; u < 6144; u += G) dil_unit(lds, BIG, LSE, st.half, u); } break;
        case OP_DIL_COMB: { FRESH(); phase_dil_combine(BIG, (const float*)(BIG + (size_t)MH * 9216), Y + (size_t)st.half * MH * DM, gw, ngw, lane); } break;
        case OP_HG_GATES: { FRESH(); phase_hgrn_gates(BIG, gt, ngt); } break;
        case OP_HG_SCAN: {
#pragma unroll 1
          for (int c = blockIdx.x; c < 192; c += G) hgrn_chain(lds, BIG, Y, H, oml, c); } break;
        case OP_HG_COMB: { FRESH(); phase_hgrn_combine(BIG, Y, H, Y, kargs()->in[11], gw, ngw, lane); } break;
        case OP_CONVGLU: { FRESH(); phase_convglu(Y, Y + 352ull * MiB / 2 + (size_t)st.half * MH * DFF, kargs()->in[14] + (size_t)layer * 3 * 5632, kargs()->in[15] + (size_t)layer * 5632, st.half, gt, ngt); } break;
        default: break;
      }
      xcd_barrier(xbar);
#ifdef PROBE_DUP_OP
      if (st.op == PROBE_DUP_OP && rep_ == 0) rep_ = 1; else { rep_ = 0; ++s; }
#endif
#ifdef PROBE_REPEAT_OP
      }
#endif
    }
  }
}

constexpr int LDS_BYTES = 147456;
extern "C" void kernel_launch(void* const* d_in, const int* in_sizes, int n_in, void* d_out, int out_size, void* d_ws, size_t ws_size, hipStream_t stream) {
  static int grid = 0;
  if (grid == 0) {
    if (n_in != 17 || ws_size < WS_END) { fprintf(stderr, "kernel_launch: unexpected n_in %d / ws %zu\n", n_in, ws_size); grid = -1; return; }
    int dev = 0, cus = 0;
    if (hipGetDevice(&dev) != hipSuccess || hipDeviceGetAttribute(&cus, hipDeviceAttributeMultiprocessorCount, dev) != hipSuccess) { grid = -1; return; }
    if (hipFuncSetAttribute((const void*)fwd_megakernel, hipFuncAttributeMaxDynamicSharedMemorySize, LDS_BYTES) != hipSuccess) { fprintf(stderr, "hipFuncSetAttribute failed\n"); grid = -1; return; }
    grid = cus;
  }
  if (grid < 0) return;
  if (hipMemsetAsync((char*)d_ws + WS_BAR, 0, XCD_BAR_WORDS * 4, stream) != hipSuccess) { fprintf(stderr, "kernel_launch: memset of the barrier words failed\n"); return; }
  Params p{};
  for (int i = 0; i < 17; ++i) p.in[i] = (const float*)d_in[i];
  p.out = (float*)d_out; p.ws = (unsigned char*)d_ws;
  for (int i = 0; i < 8; ++i) p.invf[i] = pow(500000.0, -(double)i / 8.0);
  void* args[] = {&p};
  hipError_t e = hipLaunchCooperativeKernel((void*)fwd_megakernel, dim3(grid), dim3(512), args, LDS_BYTES, stream);
  if (e != hipSuccess) fprintf(stderr, "cooperative launch failed: %s (grid %d)\n", hipGetErrorString(e), grid);
}
```
